# Optimizing an MI355X kernel written in HIP

```python
import math
import jax, jax.numpy as jnp
from jax import lax
import numpy as np

D_MODEL = 1024
BATCH = 8
SEQ = 4096
DEPTH = 2

CTX_LEN = 256
GRID_W = 64
N_HEADS = 8
QK_NOPE = 64
QK_ROPE = 32
V_DIM = 64
Q_LORA = 256
KV_LORA = 256
ROPE_THETA = 10000.0
Q_BLOCK = 128
ATTN_SCALE = 1.0 / math.sqrt(QK_NOPE + QK_ROPE)
CONV_WIDTH = 512
CONV_K = 3
S5_WIDTH = 512
S5_GROUP = 16
S5_GROUPS = S5_WIDTH // S5_GROUP
S5_STATE = 64
DT_MIN = 1e-3
DT_MAX = 1e-1
N_BRANCH = 3
D_FF = 4 * D_MODEL
EPS = 1e-6
OFF_Q = 0
OFF_KV = OFF_Q + Q_LORA
OFF_PE = OFF_KV + KV_LORA
OFF_CB = OFF_PE + QK_ROPE
OFF_CC = OFF_CB + CONV_WIDTH
OFF_CX = OFF_CC + CONV_WIDTH
OFF_S5 = OFF_CX + CONV_WIDTH
OFF_G = OFF_S5 + S5_WIDTH
IN_COLS = OFF_G + N_BRANCH * D_MODEL

kernel_name = 'hybrid_mla_shortconv_s5_dit_block'


def rms_norm(x, g):
    xf = x.astype(jnp.float32)
    y = xf * lax.rsqrt(jnp.mean(xf * xf, axis=-1, keepdims=True) + EPS)
    return (y * g.astype(jnp.float32)).astype(x.dtype)


def modulate(x, shift, scale):
    return x * (1 + scale) + shift


def squared_relu_mlp(x, w1, w2):
    return jnp.square(jax.nn.relu(x @ w1)) @ w2


def axial_rope_tables(n_tokens, dtype):
    rows = n_tokens // GRID_W
    row = jnp.repeat(jnp.arange(rows), GRID_W)
    col = jnp.tile(jnp.arange(GRID_W), rows)
    pos = jnp.stack([row, col], axis=-1).astype(jnp.float32)
    n_freq = QK_ROPE // 4
    inv = ROPE_THETA ** (-jnp.arange(n_freq, dtype=jnp.float32) / n_freq)
    ang = pos[:, :, None, None] * inv[None, None, None, :]
    ang = jnp.broadcast_to(ang, (n_tokens, 2, 2, n_freq)).reshape(n_tokens, QK_ROPE)
    return jnp.cos(ang).astype(dtype), jnp.sin(ang).astype(dtype)


def apply_rope(x, cos, sin):
    xr = x.reshape(x.shape[:-1] + (2, 2, QK_ROPE // 4))
    rot = jnp.concatenate([-xr[..., 1:, :], xr[..., :1, :]], axis=-2).reshape(x.shape)
    return x * cos + rot * sin


def mla_queries(z_q, q_norm, w_uq, rope):
    b, n, _ = z_q.shape
    q = (rms_norm(z_q, q_norm) @ w_uq).reshape(b, n, N_HEADS, QK_NOPE + QK_ROPE).transpose(0, 2, 1, 3)
    q_nope, q_pe = q[..., :QK_NOPE], q[..., QK_NOPE:]
    if rope is not None:
        q_pe = apply_rope(q_pe, rope[0], rope[1])
    return jnp.concatenate([q_nope, q_pe], axis=-1)


def mla_keys_values(z_kv, z_pe, kv_norm, w_ukv, rope):
    b, n, _ = z_kv.shape
    kv = (rms_norm(z_kv, kv_norm) @ w_ukv).reshape(b, n, N_HEADS, QK_NOPE + V_DIM).transpose(0, 2, 1, 3)
    k_nope, v = kv[..., :QK_NOPE], kv[..., QK_NOPE:]
    k_pe = z_pe[:, None]
    if rope is not None:
        k_pe = apply_rope(k_pe, rope[0], rope[1])
    k = jnp.concatenate([k_nope, jnp.broadcast_to(k_pe, (b, N_HEADS, n, QK_ROPE))], axis=-1)
    return k, v


def softmax_attend(q, k, v):
    s = jnp.einsum('bhqd,bhkd->bhqk', q, k).astype(jnp.float32) * ATTN_SCALE
    p = jax.nn.softmax(s, axis=-1).astype(v.dtype)
    return jnp.einsum('bhqk,bhkd->bhqd', p, v)


def blocked_attend(q, k, v):
    b, h, n, dk = q.shape
    nb = n // Q_BLOCK
    qb = q.reshape(b, h, nb, Q_BLOCK, dk).transpose(2, 0, 1, 3, 4)
    ob = lax.map(lambda qi: softmax_attend(qi, k, v), qb)
    return ob.transpose(1, 2, 0, 3, 4).reshape(b, h, n, V_DIM)


def merge_heads(o):
    b, h, n, d = o.shape
    return o.transpose(0, 2, 1, 3).reshape(b, n, h * d)


def short_conv(z_b, z_c, z_x, conv_w, conv_w_out):
    u = z_c * z_x
    n = u.shape[1]
    pad = CONV_K // 2
    up = jnp.pad(u, ((0, 0), (pad, pad), (0, 0)))
    y = up[:, 0:n] * conv_w[0]
    for j in range(1, CONV_K):
        y = y + up[:, j:j + n] * conv_w[j]
    return (z_b * y) @ conv_w_out


def cmul(ar, ai, br, bi):
    return ar * br - ai * bi, ar * bi + ai * br


def s5_discretise(a_re, a_im, log_dt, b_re, b_im):
    dt = jnp.exp(log_dt.astype(jnp.float32))[:, None]
    a_re = a_re.astype(jnp.float32)
    a_im = a_im.astype(jnp.float32)
    mag = jnp.exp(dt * a_re)
    ab_re, ab_im = mag * jnp.cos(dt * a_im), mag * jnp.sin(dt * a_im)
    den = a_re * a_re + a_im * a_im
    nr, ni = ab_re - 1.0, ab_im
    f_re = (nr * a_re + ni * a_im) / den
    f_im = (ni * a_re - nr * a_im) / den
    bb_re, bb_im = cmul(f_re[..., None], f_im[..., None], b_re.astype(jnp.float32), b_im.astype(jnp.float32))
    return ab_re, ab_im, bb_re, bb_im


def diag_scan(ab_re, ab_im, b_re, b_im):
    n = b_re.shape[1]
    a_re = jnp.broadcast_to(ab_re, (1, n) + ab_re.shape)
    a_im = jnp.broadcast_to(ab_im, (1, n) + ab_im.shape)

    def combine(e1, e2):
        a1r, a1i, b1r, b1i = e1
        a2r, a2i, b2r, b2i = e2
        ar, ai = cmul(a2r, a2i, a1r, a1i)
        br, bi = cmul(a2r, a2i, b1r, b1i)
        return ar, ai, br + b2r, bi + b2i

    _, _, s_re, s_im = lax.associative_scan(combine, (a_re, a_im, b_re, b_im), axis=1)
    return s_re, s_im


def s5_direction(u_c, u_l, a_re, a_im, log_dt, b_re, b_im, c_re, c_im, reverse, need_ctx_out):
    ab_re, ab_im, bb_re, bb_im = s5_discretise(a_re, a_im, log_dt, b_re, b_im)
    c_re = c_re.astype(jnp.float32)
    c_im = c_im.astype(jnp.float32)

    def flip(t):
        return t[:, ::-1] if reverse else t

    def drive(u):
        return jnp.einsum('blgc,gpc->blgp', u, bb_re), jnp.einsum('blgc,gpc->blgp', u, bb_im)

    def readout(s_re, s_im):
        return jnp.einsum('gcp,blgp->blgc', c_re, s_re) - jnp.einsum('gcp,blgp->blgc', c_im, s_im)

    bc_re, bc_im = drive(flip(u_c))
    sc_re, sc_im = diag_scan(ab_re, ab_im, bc_re, bc_im)
    i_re, i_im = cmul(ab_re, ab_im, sc_re[:, -1], sc_im[:, -1])
    bl_re, bl_im = drive(flip(u_l))
    bl_re = bl_re.at[:, 0].add(i_re)
    bl_im = bl_im.at[:, 0].add(i_im)
    sl_re, sl_im = diag_scan(ab_re, ab_im, bl_re, bl_im)
    y_l = flip(readout(sl_re, sl_im))
    y_c = flip(readout(sc_re, sc_im)) if need_ctx_out else None
    return y_l, y_c


def s5_branch(u_c, u_l, a_re, a_im, log_dt, b_re, b_im, c_re, c_im, s5_d, w_glu, need_ctx_out):
    dtype = u_l.dtype

    def groups(u):
        return u.astype(jnp.float32).reshape(u.shape[0], u.shape[1], S5_GROUPS, S5_GROUP)

    gc, gl = groups(u_c), groups(u_l)
    d = s5_d.astype(jnp.float32).reshape(S5_GROUPS, S5_GROUP)
    y_l = d * gl
    y_c = d * gc if need_ctx_out else None
    for direction in range(2):
        yl_d, yc_d = s5_direction(gc, gl, a_re[direction], a_im[direction], log_dt[direction],
                                  b_re[direction], b_im[direction], c_re[direction], c_im[direction],
                                  direction == 1, need_ctx_out)
        y_l = y_l + yl_d
        if need_ctx_out:
            y_c = y_c + yc_d

    def glu(y):
        z = jax.nn.gelu(y.reshape(y.shape[0], y.shape[1], S5_WIDTH)).astype(dtype) @ w_glu
        return z[..., :D_MODEL] * jax.nn.sigmoid(z[..., D_MODEL:])

    return glu(y_l), (glu(y_c) if need_ctx_out else None)


def gated_merge(z_gate, y_att, y_conv, y_s5, w_out):
    b, n, _ = z_gate.shape
    g = jax.nn.sigmoid(z_gate).reshape(b, n, N_BRANCH, D_MODEL)
    return (g[:, :, 0] * y_att + g[:, :, 1] * y_conv + g[:, :, 2] * y_s5) @ w_out


def token_mixers(xn, hn, w_in, q_norm, w_uq, kv_norm, w_ukv, w_o, conv_w, conv_w_out,
                 a_re, a_im, log_dt, b_re, b_im, c_re, c_im, s5_d, w_glu, w_out, rope, need_ctx_out):
    zx = xn @ w_in
    if need_ctx_out:
        zh = hn @ w_in
        zh_kvpe, zh_s5 = zh[..., OFF_KV:OFF_CB], zh[..., OFF_S5:OFF_G]
    else:
        zh_kvpe = hn @ w_in[:, OFF_KV:OFF_CB]
        zh_s5 = hn @ w_in[:, OFF_S5:OFF_G]
    k_c, v_c = mla_keys_values(zh_kvpe[..., :KV_LORA], zh_kvpe[..., KV_LORA:], kv_norm, w_ukv, None)
    k_x, v_x = mla_keys_values(zx[..., OFF_KV:OFF_PE], zx[..., OFF_PE:OFF_CB], kv_norm, w_ukv, rope)
    q_x = mla_queries(zx[..., OFF_Q:OFF_KV], q_norm, w_uq, rope)
    k_all = jnp.concatenate([k_c, k_x], axis=2)
    v_all = jnp.concatenate([v_c, v_x], axis=2)
    att_x = merge_heads(blocked_attend(q_x, k_all, v_all)) @ w_o
    conv_x = short_conv(zx[..., OFF_CB:OFF_CC], zx[..., OFF_CC:OFF_CX], zx[..., OFF_CX:OFF_S5], conv_w, conv_w_out)
    s5_x, s5_h = s5_branch(zh_s5, zx[..., OFF_S5:OFF_G], a_re, a_im, log_dt, b_re, b_im, c_re, c_im,
                           s5_d, w_glu, need_ctx_out)
    y_x = gated_merge(zx[..., OFF_G:], att_x, conv_x, s5_x, w_out)
    if not need_ctx_out:
        return y_x, None
    q_h = mla_queries(zh[..., OFF_Q:OFF_KV], q_norm, w_uq, None)
    att_h = merge_heads(softmax_attend(q_h, k_c, v_c)) @ w_o
    conv_h = short_conv(zh[..., OFF_CB:OFF_CC], zh[..., OFF_CC:OFF_CX], zh[..., OFF_CX:OFF_S5], conv_w, conv_w_out)
    y_h = gated_merge(zh[..., OFF_G:], att_h, conv_h, s5_h, w_out)
    return y_x, y_h


def setup_inputs(seed: int = 0) -> dict:
    key = jax.random.key(seed)
    ks = jax.random.split(key, 32)
    f32 = jnp.float32

    def nrm(k, shape, scale):
        return jax.random.normal(k, shape, f32) * scale

    def gain(k, shape):
        return 1.0 + 0.02 * jax.random.normal(k, shape, f32)

    n_idx = jnp.arange(S5_STATE, dtype=f32)
    s5_a_re = -0.5 + 0.01 * jax.random.normal(ks[14], (DEPTH, 2, S5_GROUPS, S5_STATE), f32)
    s5_a_im = math.pi * n_idx + 0.01 * jax.random.normal(ks[15], (DEPTH, 2, S5_GROUPS, S5_STATE), f32)
    s5_log_dt = jax.random.uniform(ks[16], (DEPTH, 2, S5_GROUPS), f32, math.log(DT_MIN), math.log(DT_MAX))
    return {
        'x': nrm(ks[0], (BATCH, SEQ, D_MODEL), 1.0),
        'c': nrm(ks[1], (BATCH, D_MODEL), 1.0),
        'ctx': nrm(ks[2], (BATCH, CTX_LEN, D_MODEL), 1.0),
        'c_ctx': nrm(ks[3], (D_MODEL,), 1.0),
        'ada_w': nrm(ks[4], (DEPTH, D_MODEL, 6 * D_MODEL), 0.02),
        'ada_b': nrm(ks[5], (DEPTH, 6 * D_MODEL), 0.01),
        'norm_mix': gain(ks[6], (DEPTH, D_MODEL)),
        'w_in': nrm(ks[7], (DEPTH, D_MODEL, IN_COLS), D_MODEL ** -0.5),
        'mla_q_norm': gain(ks[8], (DEPTH, Q_LORA)),
        'mla_w_uq': nrm(ks[9], (DEPTH, Q_LORA, N_HEADS * (QK_NOPE + QK_ROPE)), Q_LORA ** -0.5),
        'mla_kv_norm': gain(ks[10], (DEPTH, KV_LORA)),
        'mla_w_ukv': nrm(ks[11], (DEPTH, KV_LORA, N_HEADS * (QK_NOPE + V_DIM)), KV_LORA ** -0.5),
        'mla_w_o': nrm(ks[12], (DEPTH, N_HEADS * V_DIM, D_MODEL), (N_HEADS * V_DIM) ** -0.5),
        'conv_w': nrm(ks[13], (DEPTH, CONV_K, CONV_WIDTH), CONV_K ** -0.5),
        'conv_w_out': nrm(ks[17], (DEPTH, CONV_WIDTH, D_MODEL), CONV_WIDTH ** -0.5),
        's5_a_re': s5_a_re,
        's5_a_im': s5_a_im,
        's5_log_dt': s5_log_dt,
        's5_b_re': nrm(ks[18], (DEPTH, 2, S5_GROUPS, S5_STATE, S5_GROUP), (2 * S5_GROUP) ** -0.5),
        's5_b_im': nrm(ks[19], (DEPTH, 2, S5_GROUPS, S5_STATE, S5_GROUP), (2 * S5_GROUP) ** -0.5),
        's5_c_re': nrm(ks[20], (DEPTH, 2, S5_GROUPS, S5_GROUP, S5_STATE), (2 * S5_STATE) ** -0.5),
        's5_c_im': nrm(ks[21], (DEPTH, 2, S5_GROUPS, S5_GROUP, S5_STATE), (2 * S5_STATE) ** -0.5),
        's5_d': nrm(ks[22], (DEPTH, S5_WIDTH), 1.0),
        's5_w_glu': nrm(ks[23], (DEPTH, S5_WIDTH, 2 * D_MODEL), S5_WIDTH ** -0.5),
        'w_out': nrm(ks[24], (DEPTH, D_MODEL, D_MODEL), D_MODEL ** -0.5),
        'norm_mlp': gain(ks[25], (DEPTH, D_MODEL)),
        'mlp_w1': nrm(ks[26], (DEPTH, D_MODEL, D_FF), D_MODEL ** -0.5),
        'mlp_w2': nrm(ks[27], (DEPTH, D_FF, D_MODEL), D_FF ** -0.5),
        'norm_final': gain(ks[28], (D_MODEL,)),
    }


def reference(x, c, ctx, c_ctx, ada_w, ada_b, norm_mix, w_in, mla_q_norm, mla_w_uq, mla_kv_norm, mla_w_ukv,
              mla_w_o, conv_w, conv_w_out, s5_a_re, s5_a_im, s5_log_dt, s5_b_re, s5_b_im, s5_c_re, s5_c_im,
              s5_d, s5_w_glu, w_out, norm_mlp, mlp_w1, mlp_w2, norm_final):
    n_tokens = x.shape[1]
    rope = axial_rope_tables(n_tokens, x.dtype)
    silu_c = jax.nn.silu(c)
    silu_cc = jax.nn.silu(c_ctx)
    h = ctx
    for i in range(DEPTH):
        need_ctx_out = i < DEPTH - 1
        mod_x = jnp.split((silu_c @ ada_w[i] + ada_b[i])[:, None, :], 6, axis=-1)
        mod_h = jnp.split((silu_cc @ ada_w[i] + ada_b[i])[None, None, :], 6, axis=-1)
        xn = modulate(rms_norm(x, norm_mix[i]), mod_x[0], mod_x[1])
        hn = modulate(rms_norm(h, norm_mix[i]), mod_h[0], mod_h[1])
        y_x, y_h = token_mixers(xn, hn, w_in[i], mla_q_norm[i], mla_w_uq[i], mla_kv_norm[i], mla_w_ukv[i],
                                mla_w_o[i], conv_w[i], conv_w_out[i], s5_a_re[i], s5_a_im[i], s5_log_dt[i],
                                s5_b_re[i], s5_b_im[i], s5_c_re[i], s5_c_im[i], s5_d[i], s5_w_glu[i], w_out[i],
                                rope, need_ctx_out)
        x = x + mod_x[2] * y_x
        x = x + mod_x[5] * squared_relu_mlp(modulate(rms_norm(x, norm_mlp[i]), mod_x[3], mod_x[4]),
                                            mlp_w1[i], mlp_w2[i])
        if need_ctx_out:
            h = h + mod_h[2] * y_h
            h = h + mod_h[5] * squared_relu_mlp(modulate(rms_norm(h, norm_mlp[i]), mod_h[3], mod_h[4]),
                                                mlp_w1[i], mlp_w2[i])
    return rms_norm(x, norm_final)
```

```cpp
#include <hip/hip_runtime.h>
#include <hip/hip_cooperative_groups.h>
#include <stdint.h>
#include <cstdio>
namespace cg = cooperative_groups;

typedef unsigned short bf16_t;
typedef short bf16x8 __attribute__((ext_vector_type(8)));
typedef float f32x4 __attribute__((ext_vector_type(4)));
typedef unsigned u32x4 __attribute__((ext_vector_type(4)));
typedef unsigned u32x2 __attribute__((ext_vector_type(2)));
#define DEV __device__ __forceinline__

constexpr int MLAT = 32768, MCTX = 2048, MALL = 34816;
constexpr int LDZ = 2816, ZQ = 0, ZKV = 256, ZCB = 512, ZCC = 1024, ZCX = 1536, ZS5 = 2048, ZPE = 2560;
constexpr int ZCV = 0, ZAO = 512, ZS5A = 1024, ZMG = 1536;
constexpr int NKEY = 4352;
constexpr int NCH = 1088;
constexpr float EPSN = 1e-6f;

constexpr size_t OFF_MOD  = 0;
constexpr size_t OFF_ROPE = OFF_MOD + 2ull * 9 * 6144 * 4;
constexpr size_t OFF_KTAB = OFF_ROPE + 4096;
constexpr size_t OFF_XC   = OFF_KTAB + 32ull * 2 * 32 * 256 * 4;
constexpr size_t OFF_S    = OFF_XC + 2048ull * 1024 * 4;
constexpr size_t OFF_WIN  = OFF_S + (size_t)NCH * 8192 * 2;
constexpr size_t OFF_WUQ  = OFF_WIN + 5888ull * 1024 * 2;
constexpr size_t OFF_WUKV = OFF_WUQ + 768ull * 256 * 2;
constexpr size_t OFF_WO   = OFF_WUKV + 1024ull * 256 * 2;
constexpr size_t OFF_WC   = OFF_WO + 1024ull * 512 * 2;
constexpr size_t OFF_WGLU = OFF_WC + 1024ull * 512 * 2;
constexpr size_t OFF_WOUT = OFF_WGLU + 2048ull * 512 * 2;
constexpr size_t OFF_W1   = OFF_WOUT + 1024ull * 1024 * 2;
constexpr size_t OFF_W2   = OFF_W1 + 4096ull * 1024 * 2;
constexpr size_t OFF_MT   = OFF_W2 + 1024ull * 4096 * 2;
constexpr size_t OFF_ET   = OFF_MT + 32ull * 512 * 512 * 2;
constexpr size_t OFF_FT   = OFF_ET + 32ull * 512 * 256 * 2;
constexpr size_t OFF_XN   = OFF_FT + 32ull * 256 * 512 * 2;
constexpr size_t OFF_Z    = OFF_XN + (size_t)MALL * 1024 * 2;
constexpr size_t OFF_Q    = OFF_Z + (size_t)MALL * LDZ * 2;
constexpr size_t OFF_K    = OFF_Q + 64ull * NKEY * 96 * 2;
constexpr size_t OFF_VT   = OFF_K + 64ull * NKEY * 96 * 2;
constexpr size_t WS_NEED  = OFF_VT + 64ull * 64 * NKEY * 2;
constexpr size_t OFF_T    = OFF_Q;
constexpr size_t OFF_MG   = OFF_T + (size_t)MALL * 1024 * 2;
static_assert(OFF_MG + (size_t)MALL * 1024 * 2 <= WS_NEED, "merge temporaries overflow");
constexpr size_t OFF_BAR  = WS_NEED;
constexpr size_t BAR_BYTES = 3456 * 4;
constexpr size_t OFF_SSQ  = OFF_BAR + 16384;
constexpr size_t WS_TOTAL = OFF_SSQ + (size_t)MALL * 2 * 4;
static_assert((size_t)MALL * 4096 * 2 <= OFF_VT - OFF_Z, "H alias too big");

#ifdef DUP_PH
#define DUPN(ph) ((ph) == DUP_PH ? 1 : 0)
#else
#define DUPN(ph) 0
#endif
struct P {
  const float *x, *c, *ctx, *c_ctx, *ada_w, *ada_b, *norm_mix, *w_in, *q_norm, *w_uq, *kv_norm, *w_ukv, *w_o, *conv_w, *conv_w_out,
      *a_re, *a_im, *log_dt, *b_re, *b_im, *c_re, *c_im, *s5_d, *w_glu, *w_out, *norm_mlp, *w1, *w2, *norm_final;
  float* out; char* ws;
};

DEV int get_tid() { int t; asm volatile("v_mov_b32 %0, %1" : "=v"(t) : "v"((int)(threadIdx.x & 255))); return t; }
DEV int vbsel() { return __builtin_amdgcn_readfirstlane((int)(threadIdx.x >> 8)); }
DEV int vbid() { return (int)blockIdx.x * 2 + vbsel(); }
DEV int vgrid() { return (int)gridDim.x * 2; }
DEV int vboff() { return vbsel() * 81920; }
DEV int rounds_of(int total) { const int vg = vgrid(); int r = 0; for (int t = 0; t < total; t += vg) ++r; return r; }
typedef const __attribute__((address_space(4))) P* KP;
#if defined(__HIP_DEVICE_COMPILE__)
DEV P ldp(KP k) { asm volatile("" : "+s"(k)); return *k; }
#else
DEV P ldp(KP k) { return P{}; }
#endif
DEV unsigned pk_bf16(float lo, float hi) { unsigned r; asm("v_cvt_pk_bf16_f32 %0, %1, %2" : "=v"(r) : "v"(lo), "v"(hi)); return r; }
DEV float bflo(unsigned w) { return __uint_as_float(w << 16); }
DEV float bfhi(unsigned w) { return __uint_as_float(w & 0xffff0000u); }
DEV float sigm(float x) { return 1.0f / (1.0f + __expf(-x)); }
DEV float wave_sum(float v) {
#pragma unroll
  for (int o = 32; o > 0; o >>= 1) v += __shfl_xor(v, o);
  return v;
}
DEV void sincos_d(double th, float& s, float& c) {
  double n = rint(th * 0.15915494309189535);
  double r = fma(-n, 6.283185307179586, th);
  float rev = (float)(r * 0.15915494309189535);
  s = __builtin_amdgcn_sinf(rev); c = __builtin_amdgcn_cosf(rev);
}

struct ASrc { const bf16_t* p; long lda; int row0, rmax, segshift; long segstride; };

template <int WN, bool SWAP>
DEV void gemm_core(f32x4 (&acc)[4][WN], const ASrc& a, const bf16_t* __restrict__ Bt, long ldb, int K, char* smem) {
  constexpr int BN = 32 * WN, NBL = BN / 32;
  constexpr int ABYTES = 16384, STAGE = ABYTES + BN * 128;
  const int tid = get_tid(), lane = tid & 63, wid = tid >> 6, wm = wid >> 1, wn = wid & 1;
  const int l15 = lane & 15, lq = lane >> 4;
  const int lrow = tid >> 3, lc = tid & 7;
  const int segmask = (1 << a.segshift) - 1;
  const bf16_t* ap[4];
#pragma unroll
  for (int i = 0; i < 4; ++i) { int r = a.row0 + lrow + 32 * i; r = r < a.rmax ? r : a.rmax - 1; ap[i] = a.p + (long)r * a.lda; }
  const bf16_t* bp = Bt + (long)lrow * ldb + lc * 8;
  const int vo = vboff();
  const int wofs = vo + lrow * 128 + ((lc ^ ((lrow >> 1) & 7)) << 4);
  u32x4 ra0[4], rb0[NBL], ra1[4], rb1[NBL];
  const int aoff = vo + (wm * 64 + l15) * 128, boff = vo + ABYTES + (wn * 16 * WN + l15) * 128, sx = l15 >> 1;
  int nk = K >> 6; asm volatile("" : "+s"(nk));
#define GLOAD(RA, RB, kt) { const int k_ = (kt) * 64 + lc * 8; const long ko_ = (long)(k_ >> a.segshift) * a.segstride + (k_ & segmask); \
    _Pragma("unroll") for (int i = 0; i < 4; ++i) RA[i] = *(const u32x4*)(ap[i] + ko_); \
    _Pragma("unroll") for (int i = 0; i < NBL; ++i) RB[i] = *(const u32x4*)(bp + (long)(32 * i) * ldb + (kt) * 64); }
#define LSTORE(RA, RB, buf) { char* s_ = smem + (buf) * STAGE; \
    _Pragma("unroll") for (int i = 0; i < 4; ++i) *(u32x4*)(s_ + wofs + i * 4096) = RA[i]; \
    _Pragma("unroll") for (int i = 0; i < NBL; ++i) *(u32x4*)(s_ + ABYTES + wofs + i * 4096) = RB[i]; }
#define BAR() { asm volatile("s_waitcnt lgkmcnt(0)" ::: "memory"); __builtin_amdgcn_s_barrier(); asm volatile("" ::: "memory"); }
#define COMPUTE(buf) { const char* s = smem + (buf) * STAGE; \
    _Pragma("unroll") for (int ks = 0; ks < 2; ++ks) { \
      const int co = ((ks * 4 + lq) ^ sx) << 4; \
      bf16x8 af[4], bfr[WN]; \
      _Pragma("unroll") for (int i = 0; i < 4; ++i) af[i] = *(const bf16x8*)(s + aoff + i * 2048 + co); \
      _Pragma("unroll") for (int j = 0; j < WN; ++j) bfr[j] = *(const bf16x8*)(s + boff + j * 2048 + co); \
      _Pragma("unroll") for (int i = 0; i < 4; ++i) \
        _Pragma("unroll") for (int j = 0; j < WN; ++j) \
          acc[i][j] = SWAP ? __builtin_amdgcn_mfma_f32_16x16x32_bf16(bfr[j], af[i], acc[i][j], 0, 0, 0) \
                           : __builtin_amdgcn_mfma_f32_16x16x32_bf16(af[i], bfr[j], acc[i][j], 0, 0, 0); \
    } }
  __builtin_amdgcn_sched_barrier(0);
  GLOAD(ra0, rb0, 0); GLOAD(ra1, rb1, 1); LSTORE(ra0, rb0, 0); BAR();
#pragma nounroll
  for (int kt = 0; kt < nk; kt += 2) {
    if (kt + 2 < nk) GLOAD(ra0, rb0, kt + 2);
    COMPUTE(0);
    LSTORE(ra1, rb1, 1);
    BAR();
    if (kt + 3 < nk) GLOAD(ra1, rb1, kt + 3);
    COMPUTE(1);
    if (kt + 2 < nk) LSTORE(ra0, rb0, 0);
    BAR();
  }
#undef GLOAD
#undef LSTORE
#undef COMPUTE
#undef BAR
  __builtin_amdgcn_sched_barrier(0);
}
template <int WN> DEV void zero_acc(f32x4 (&acc)[4][WN]) {
#pragma unroll
  for (int i = 0; i < 4; ++i)
#pragma unroll
    for (int j = 0; j < WN; ++j) acc[i][j] = (f32x4){0.f, 0.f, 0.f, 0.f};
}
DEV ASrc asrc(const bf16_t* p, long lda, int row0, int rmax) { ASrc a; a.p = p; a.lda = lda; a.row0 = row0; a.rmax = rmax; a.segshift = 30; a.segstride = 0; return a; }

DEV bool tile_get(int r, int nM, int nN, int& mt, int& nt) {
  const int nslots = vgrid() >> 3; int q = (r * 8 + ((int)blockIdx.x & 7)) * nslots + ((int)blockIdx.x >> 3) * 2 + vbsel();
  const bool valid = q < nM * nN; q = valid ? q : nM * nN - 1;
  const int band = q / (8 * nN), rem = q - band * 8 * nN;
  nt = rem >> 3; mt = band * 8 + (rem & 7);
  return valid;
}
DEV int tile_rounds(int total) { return rounds_of(total); }


namespace pg8 {
#define PG8_LAS __attribute__((address_space(3)))
constexpr int BM = 256, BK = 64, HALF = 128, HTB = HALF * BK * 2, STAGE_BYTES = 8 * HTB, NXCD = 8, WGM = 8;
DEV int lds_byte(int r, int c) { const int st = (r >> 4) * 2 + (c >> 5), rr = r & 15, cc = c & 31, ob = rr * 64 + cc * 2; return st * 1024 + (ob ^ (((ob >> 9) & 1) << 5)); }
DEV void stage_rc(int b, int& R, int& C) { const int st = b / 1024, sb = b % 1024, swz = sb ^ (((sb >> 9) & 1) << 5); R = (st >> 1) * 16 + swz / 64; C = (st & 1) * 32 + (swz % 64) / 2; }
DEV int perm32(int rho) { const int n = rho >> 4, i = rho & 15; return 8 * (i >> 2) + 4 * n + (i & 3); }
struct Unit { int pm, pn; };
struct Gemm { const bf16_t* A; const bf16_t* Bt; long lda; int M, N, K; long segstride; long pnstrideA; };
struct StaticOrder {
  int nM, nN, nwg, G, c;
  DEV void init(int M, int N, int G_, int c_) { nM = M / BM; nN = N / BM; nwg = nM * nN; G = G_; c = c_; }
  DEV bool next(int i, Unit& u) const {
    const long L = (long)i * G + c; if (L >= nwg) return false;
    int wgid = (int)L; { const int q = nwg / NXCD, r = nwg % NXCD, xcd = wgid % NXCD, off = wgid / NXCD; wgid = (xcd < r ? xcd * (q + 1) : r * (q + 1) + (xcd - r) * q) + off; }
    const int nig = WGM * nN, gid = wgid / nig, fm = gid * WGM, gsz = (nM - fm) < WGM ? (nM - fm) : WGM;
    u.pm = fm + ((wgid % nig) % gsz); u.pn = (wgid % nig) / gsz; return true;
  }
};
template <class Epi>
DEV void gemm_phase(PG8_LAS unsigned char* lds, const Gemm g, const StaticOrder& S, const Epi& E) {
  int tid; asm volatile("v_mov_b32 %0, %1" : "=v"(tid) : "v"((int)threadIdx.x));
  const int wid = __builtin_amdgcn_readfirstlane(tid >> 6), lane = tid & 63, wr = wid >> 2, wc = wid & 3, fr = lane & 15, fq = lane >> 4;
  const int K = g.K, nt = K / BK;
  unsigned voffA[2], voffB[2];
#pragma unroll
  for (int i = 0; i < 2; ++i) { int R, C; stage_rc(tid * 16 + i * 8192, R, C); const int Rb = Epi::PERM ? ((R & ~31) + perm32(R & 31)) : R;
    voffA[i] = (unsigned)((long)R * g.lda + (g.segstride ? (long)(C >> 4) * g.segstride + (C & 15) : (long)C)) * 2u; voffB[i] = (unsigned)(Rb * K + C) * 2u; }
  const size_t kstep = (size_t)(BK * 2);
  const size_t kstepA = g.segstride ? (size_t)(BK / 16) * g.segstride * 2 : kstep;
  const size_t pnA = (size_t)g.pnstrideA * 2;
  const size_t hstepA = (size_t)HALF * g.lda * 2, hstepB = (size_t)HALF * K * 2;
  const size_t tstepA = 2 * hstepA, tstepB = 2 * hstepB;
  const unsigned ldsw = (unsigned)wid * 1024u;
  const int aoff = lds_byte(wr * 64 + fr, fq * 8), boff = lds_byte(wc * 32 + fr, fq * 8);
#define PG8_SA(b, h) (((b) * 2 + (h)) * HTB)
#define PG8_SB(b, h) ((4 + (b) * 2 + (h)) * HTB)
#define PG8_STAGE(bufoff, gbase, voff) do { _Pragma("unroll") for (int _i = 0; _i < 2; ++_i) \
    __builtin_amdgcn_global_load_lds((const unsigned*)((const char*)(gbase) + (voff)[_i]), (PG8_LAS unsigned*)(lds + (bufoff) + ldsw + _i * 8192), 16, 0, 0); } while (0)
#define PG8_LDA(dst, b, h) do { _Pragma("unroll") for (int m = 0; m < 4; ++m) _Pragma("unroll") for (int k = 0; k < 2; ++k) dst[m][k] = *(const PG8_LAS bf16x8*)(lds + PG8_SA(b, h) + aoff + m * 2048 + k * 1024); } while (0)
#define PG8_LDB(dst, b, h) do { _Pragma("unroll") for (int n = 0; n < 2; ++n) _Pragma("unroll") for (int k = 0; k < 2; ++k) dst[n][k] = *(const PG8_LAS bf16x8*)(lds + PG8_SB(b, h) + boff + n * 2048 + k * 1024); } while (0)
#define PG8_MMA(ai, bj, At, Bt) do { __builtin_amdgcn_s_setprio(1); _Pragma("unroll") for (int m = 0; m < 4; ++m) _Pragma("unroll") for (int n = 0; n < 2; ++n) _Pragma("unroll") for (int k = 0; k < 2; ++k) \
    acc[ai][bj][m][n] = __builtin_amdgcn_mfma_f32_16x16x32_bf16(Bt[n][k], At[m][k], acc[ai][bj][m][n], 0, 0, 0); __builtin_amdgcn_s_setprio(0); } while (0)
#define PG8_WAIT_V(n) asm volatile("s_waitcnt vmcnt(" #n ")" ::: "memory")
#define PG8_WAIT_L(n) asm volatile("s_waitcnt lgkmcnt(" #n ")" ::: "memory")
#define PG8_BAR __builtin_amdgcn_s_barrier()
#define PG8_SCHED __builtin_amdgcn_sched_barrier(0)
  Unit cur, nxt; int ui = 0;
  if (!S.next(0, cur)) return;
  f32x4 acc[2][2][4][2];
#pragma unroll
  for (int a = 0; a < 2; ++a)
#pragma unroll
    for (int b = 0; b < 2; ++b)
#pragma unroll
      for (int m = 0; m < 4; ++m)
#pragma unroll
        for (int n = 0; n < 2; ++n) acc[a][b][m][n] = (f32x4){0.f, 0.f, 0.f, 0.f};
  bf16x8 At[4][2], B0[2][2], B1[2][2];
  const char* cA = (const char*)g.A + (size_t)cur.pm * tstepA + (size_t)cur.pn * pnA; const char* cB = (const char*)g.Bt + (size_t)cur.pn * tstepB;
  PG8_STAGE(PG8_SB(0, 0), cB, voffB); PG8_STAGE(PG8_SB(0, 1), cB + hstepB, voffB); PG8_STAGE(PG8_SA(0, 0), cA, voffA); PG8_STAGE(PG8_SA(0, 1), cA + hstepA, voffA);
  if (wr == 1) PG8_BAR;
  PG8_WAIT_V(2); PG8_BAR;
  PG8_STAGE(PG8_SB(1, 0), cB + kstep, voffB); PG8_STAGE(PG8_SA(1, 0), cA + kstepA, voffA); PG8_STAGE(PG8_SB(1, 1), cB + hstepB + kstep, voffB);
  PG8_WAIT_V(6); PG8_BAR;
  for (;;) {
    const bool has_next = S.next(ui + 1, nxt);
    const char* nA = has_next ? (const char*)g.A + (size_t)nxt.pm * tstepA + (size_t)nxt.pn * pnA : cA; const char* nB = has_next ? (const char*)g.Bt + (size_t)nxt.pn * tstepB : cB;
    for (int t = 0; t < nt; t += 2) {
      const bool last = (t == nt - 2);
      const char* a1 = cA + (size_t)(t + 1) * kstepA;
      const char* a2 = last ? nA : cA + (size_t)(t + 2) * kstepA; const char* b2 = last ? nB : cB + (size_t)(t + 2) * kstep;
      const char* a3 = a2 + kstepA; const char* b3 = b2 + kstep;
      PG8_LDB(B0, 0, 0); PG8_LDB(B1, 0, 1); PG8_SCHED; PG8_LDA(At, 0, 0); PG8_STAGE(PG8_SA(1, 1), a1 + hstepA, voffA);
      PG8_WAIT_V(8); PG8_WAIT_L(0); PG8_BAR; PG8_MMA(0, 0, At, B0); PG8_MMA(0, 1, At, B1); PG8_BAR; PG8_SCHED;
      PG8_LDA(At, 0, 1); PG8_STAGE(PG8_SB(0, 0), b2, voffB); PG8_STAGE(PG8_SB(0, 1), b2 + hstepB, voffB); PG8_STAGE(PG8_SA(0, 0), a2, voffA);
      PG8_WAIT_V(8); PG8_WAIT_L(0); PG8_BAR; PG8_MMA(1, 0, At, B0); PG8_MMA(1, 1, At, B1); PG8_BAR; PG8_SCHED;
      PG8_LDB(B0, 1, 0); PG8_LDB(B1, 1, 1); PG8_SCHED; PG8_LDA(At, 1, 0); PG8_STAGE(PG8_SA(0, 1), a2 + hstepA, voffA);
      PG8_WAIT_V(8); PG8_WAIT_L(0); PG8_BAR; PG8_MMA(0, 0, At, B0); PG8_MMA(0, 1, At, B1); PG8_BAR; PG8_SCHED;
      PG8_LDA(At, 1, 1); PG8_STAGE(PG8_SB(1, 0), b3, voffB); PG8_STAGE(PG8_SB(1, 1), b3 + hstepB, voffB); PG8_STAGE(PG8_SA(1, 0), a3, voffA);
      PG8_WAIT_V(8); PG8_WAIT_L(0); PG8_BAR; PG8_MMA(1, 0, At, B0); PG8_MMA(1, 1, At, B1); PG8_BAR; PG8_SCHED;
    }
    if (wr == 0) PG8_BAR;
    E(acc, cur, wr, wc, fr, fq);
    if (!has_next) break;
#pragma unroll
    for (int a = 0; a < 2; ++a)
#pragma unroll
      for (int b = 0; b < 2; ++b)
#pragma unroll
        for (int m = 0; m < 4; ++m)
#pragma unroll
          for (int n = 0; n < 2; ++n) acc[a][b][m][n] = (f32x4){0.f, 0.f, 0.f, 0.f};
    cur = nxt; cA = nA; cB = nB; ++ui;
    if (wr == 1) PG8_BAR;
  }
  PG8_WAIT_V(0);
  PG8_BAR;
#undef PG8_SA
#undef PG8_SB
#undef PG8_STAGE
#undef PG8_LDA
#undef PG8_LDB
#undef PG8_MMA
#undef PG8_WAIT_V
#undef PG8_WAIT_L
#undef PG8_BAR
#undef PG8_SCHED
}
struct Job { const bf16_t* A; const bf16_t* Bt; long lda; int M, N, K, mode; bf16_t* O; long ldc; const bf16_t* T; const float* slat; const float* sctx; float* dlat; float* dctx; const float* modg;
             long segstride, pnstrideA; int rows; float* ssq; bf16_t* O2; };
struct EpiRT {
  static constexpr bool PERM = true;
  int mode; bf16_t* O; long ldc; const bf16_t* T; const float* slat; const float* sctx; float* dlat; float* dctx; const float* modg; int rows; float* ssq; bf16_t* O2;
  DEV void operator()(const f32x4 (&acc)[2][2][4][2], const Unit& u, int wr, int wc, int fr, int fq) const {
    const int row00 = u.pm * BM + wr * 64 + fr, col00 = u.pn * BM + wc * 32 + 8 * fq;
    if (mode == 5) {
      const bool lat = u.pm * BM < MLAT; const int bi = lat ? (u.pm * BM) >> 12 : 8;
      const float* sb = lat ? slat : sctx - (size_t)MLAT * 1024; float* db = lat ? dlat : dctx - (size_t)MLAT * 1024;
      f32x4 g[2][2];
#pragma unroll
      for (int bj = 0; bj < 2; ++bj) { const float* mg = modg + (size_t)bi * 6144 + col00 + bj * HALF; g[bj][0] = *(const f32x4*)mg; g[bj][1] = *(const f32x4*)(mg + 4); }
#pragma unroll
      for (int ai = 0; ai < 2; ++ai)
#pragma unroll
        for (int mp = 0; mp < 2; ++mp) {
          f32x4 x[4][2];
#pragma unroll
          for (int c = 0; c < 4; ++c) { const float* s = sb + (size_t)(row00 + ai * HALF + (2 * mp + (c >> 1)) * 16) * 1024 + col00 + (c & 1) * HALF; x[c][0] = *(const f32x4*)s; x[c][1] = *(const f32x4*)(s + 4); }
#pragma unroll
          for (int c = 0; c < 4; ++c) { float* d = db + (size_t)(row00 + ai * HALF + (2 * mp + (c >> 1)) * 16) * 1024 + col00 + (c & 1) * HALF;
            *(f32x4*)d = x[c][0] + g[c & 1][0] * acc[ai][c & 1][2 * mp + (c >> 1)][0]; *(f32x4*)(d + 4) = x[c][1] + g[c & 1][1] * acc[ai][c & 1][2 * mp + (c >> 1)][1]; }
        }
      return;
    }
    if (mode >= 1 && mode <= 3) {
#pragma unroll
      for (int ai = 0; ai < 2; ++ai)
#pragma unroll
        for (int mp = 0; mp < 2; ++mp) {
          u32x4 tv[4], ov[4];
#pragma unroll
          for (int c = 0; c < 4; ++c) {
            const size_t row = (size_t)(row00 + ai * HALF + (2 * mp + (c >> 1)) * 16); const int col = col00 + (c & 1) * HALF;
            if (mode >= 2) tv[c] = *(const u32x4*)(T + row * 1024 + col);
            if (mode != 2) ov[c] = *(const u32x4*)(O + row * ldc + col);
          }
#pragma unroll
          for (int c = 0; c < 4; ++c) {
            const size_t row = (size_t)(row00 + ai * HALF + (2 * mp + (c >> 1)) * 16); const int col = col00 + (c & 1) * HALF;
            f32x4 v0 = acc[ai][c & 1][2 * mp + (c >> 1)][0], v1 = acc[ai][c & 1][2 * mp + (c >> 1)][1];
#pragma unroll
            for (int r = 0; r < 4; ++r) { v0[r] = sigm(v0[r]); v1[r] = sigm(v1[r]); }
            if (mode >= 2) { const u32x4 t = tv[c];
              v0[0] *= bflo(t.x); v0[1] *= bfhi(t.x); v0[2] *= bflo(t.y); v0[3] *= bfhi(t.y); v1[0] *= bflo(t.z); v1[1] *= bfhi(t.z); v1[2] *= bflo(t.w); v1[3] *= bfhi(t.w); }
            if (mode == 1) { const u32x4 o = ov[c];
              v0[0] *= bflo(o.x); v0[1] *= bfhi(o.x); v0[2] *= bflo(o.y); v0[3] *= bfhi(o.y); v1[0] *= bflo(o.z); v1[1] *= bfhi(o.z); v1[2] *= bflo(o.w); v1[3] *= bfhi(o.w); }
            if (mode == 3) { const u32x4 o = ov[c];
              v0[0] += bflo(o.x); v0[1] += bfhi(o.x); v0[2] += bflo(o.y); v0[3] += bfhi(o.y); v1[0] += bflo(o.z); v1[1] += bfhi(o.z); v1[2] += bflo(o.w); v1[3] += bfhi(o.w); }
            *(u32x4*)(O + row * ldc + col) = (u32x4){pk_bf16(v0[0], v0[1]), pk_bf16(v0[2], v0[3]), pk_bf16(v1[0], v1[1]), pk_bf16(v1[2], v1[3])};
          }
        }
      return;
    }
    float rsv[2][4];
    if (mode >= 6) {
#pragma unroll
      for (int ai = 0; ai < 2; ++ai)
#pragma unroll
        for (int m = 0; m < 4; ++m) { const int row = row00 + ai * HALF + m * 16; rsv[ai][m] = row < rows ? ssq[(size_t)row * 2 + (mode - 6)] : 1.0f; }
#pragma unroll
      for (int ai = 0; ai < 2; ++ai)
#pragma unroll
        for (int m = 0; m < 4; ++m) rsv[ai][m] = rsqrtf(rsv[ai][m] * (1.0f / 256.0f) + EPSN);
    }
#pragma unroll
    for (int ai = 0; ai < 2; ++ai)
#pragma unroll
      for (int m = 0; m < 4; ++m) {
        const int row = row00 + ai * HALF + m * 16;
#pragma unroll
        for (int bj = 0; bj < 2; ++bj) {
          const int col = col00 + bj * HALF;
          f32x4 v0 = acc[ai][bj][m][0], v1 = acc[ai][bj][m][1];
          if (mode >= 6) {
            if (row < rows) {
              int bb, tok; const bool lat = row < MLAT;
              if (lat) { bb = row >> 12; tok = row & 4095; } else { const int cr = row - MLAT; bb = cr >> 8; tok = cr & 255; }
              if (mode == 6) {
                const float rs = rsv[ai][m] * (0.10206207261596577f * 1.4426950408889634f);
                const int h = col / 96, d = col - h * 96;
                v0 = v0 * rs; v1 = v1 * rs;
                if (d >= 64 && lat) {
                  const int pp = d - 64, a = pp >> 4, f0 = (pp & 15) >> 1, pos = a ? (tok & 63) : (tok >> 6);
                  const float pr = (float)pos * 0.15915494309189535f;
                  const float i0 = f0 ? 0.01f : 1.0f, i1 = f0 ? 0.0031622776601683794f : 0.31622776601683794f, i2 = f0 ? 0.001f : 0.1f, i3 = f0 ? 0.00031622776601683794f : 0.031622776601683794f;
                  const float2 c0 = make_float2(__builtin_amdgcn_cosf(pr * i0), __builtin_amdgcn_sinf(pr * i0)), c1 = make_float2(__builtin_amdgcn_cosf(pr * i1), __builtin_amdgcn_sinf(pr * i1));
                  const float2 c2 = make_float2(__builtin_amdgcn_cosf(pr * i2), __builtin_amdgcn_sinf(pr * i2)), c3 = make_float2(__builtin_amdgcn_cosf(pr * i3), __builtin_amdgcn_sinf(pr * i3));
                  const float t0 = v0[0] * c0.x - v0[1] * c0.y, t1 = v0[1] * c0.x + v0[0] * c0.y, t2 = v0[2] * c1.x - v0[3] * c1.y, t3 = v0[3] * c1.x + v0[2] * c1.y;
                  const float t4 = v1[0] * c2.x - v1[1] * c2.y, t5 = v1[1] * c2.x + v1[0] * c2.y, t6 = v1[2] * c3.x - v1[3] * c3.y, t7 = v1[3] * c3.x + v1[2] * c3.y;
                  v0 = (f32x4){t0, t1, t2, t3}; v1 = (f32x4){t4, t5, t6, t7};
                }
                const int qrow = lat ? tok : 4096 + tok;
                *(u32x4*)(O + ((size_t)(bb * 8 + h) * NKEY + qrow) * 96 + d) = (u32x4){pk_bf16(v0[0], v0[1]), pk_bf16(v0[2], v0[3]), pk_bf16(v1[0], v1[1]), pk_bf16(v1[2], v1[3])};
              } else {
                const float rs = rsv[ai][m];
                const int h = col >> 7, dd = col & 127, key = lat ? 256 + tok : tok;
                v0 = v0 * rs; v1 = v1 * rs;
                const unsigned w0 = pk_bf16(v0[0], v0[1]), w1 = pk_bf16(v0[2], v0[3]), w2 = pk_bf16(v1[0], v1[1]), w3 = pk_bf16(v1[2], v1[3]);
                if (dd < 64) {
                  *(u32x4*)(O + ((size_t)(bb * 8 + h) * NKEY + key) * 96 + dd) = (u32x4){w0, w1, w2, w3};
                } else {
                  const int tt = key & 31, pos = ((tt >> 2) & 3) * 8 + (tt >> 4) * 4 + (tt & 3);
                  bf16_t* vp = O2 + ((size_t)(bb * 8 + h) * 64 + (dd - 64)) * NKEY + (key & ~31) + pos;
                  vp[0] = (bf16_t)(w0 & 0xffff); vp[NKEY] = (bf16_t)(w0 >> 16); vp[2 * NKEY] = (bf16_t)(w1 & 0xffff); vp[3 * NKEY] = (bf16_t)(w1 >> 16);
                  vp[4 * NKEY] = (bf16_t)(w2 & 0xffff); vp[5 * NKEY] = (bf16_t)(w2 >> 16); vp[6 * NKEY] = (bf16_t)(w3 & 0xffff); vp[7 * NKEY] = (bf16_t)(w3 >> 16);
                }
              }
            }
          } else {
            if (mode == 4) {
#pragma unroll
              for (int r = 0; r < 4; ++r) { const float a = fmaxf(v0[r], 0.f), b = fmaxf(v1[r], 0.f); v0[r] = a * a; v1[r] = b * b; }
            }
            if (row < rows) *(u32x4*)(O + (size_t)row * ldc + col) = (u32x4){pk_bf16(v0[0], v0[1]), pk_bf16(v0[2], v0[3]), pk_bf16(v1[0], v1[1]), pk_bf16(v1[2], v1[3])};
          }
        }
        if (mode == 0 && ssq != nullptr && u.pn < 2) {
          float s = 0.f;
#pragma unroll
          for (int bj = 0; bj < 2; ++bj)
#pragma unroll
            for (int n = 0; n < 2; ++n) { const f32x4 v = acc[ai][bj][m][n]; s += v[0] * v[0] + v[1] * v[1] + v[2] * v[2] + v[3] * v[3]; }
          s += __shfl_xor(s, 16); s += __shfl_xor(s, 32);
          if (fq == 0) atomicAdd(ssq + (size_t)row * 2 + u.pn, s);
        }
      }
  }
};
}
DEV void run_job(char* smem_base, const pg8::Job& j) {
  pg8::Gemm g; g.A = j.A; g.Bt = j.Bt; g.lda = j.lda; g.M = j.M; g.N = j.N; g.K = j.K; g.segstride = j.segstride; g.pnstrideA = j.pnstrideA;
  pg8::StaticOrder S; S.init(j.M, j.N, (int)gridDim.x, (int)blockIdx.x);
  pg8::EpiRT E; E.mode = j.mode; E.O = j.O; E.ldc = j.ldc; E.T = j.T; E.slat = j.slat; E.sctx = j.sctx; E.dlat = j.dlat; E.dctx = j.dctx; E.modg = j.modg; E.rows = j.rows; E.ssq = j.ssq; E.O2 = j.O2;
  pg8::gemm_phase<pg8::EpiRT>((PG8_LAS unsigned char*)smem_base, g, S, E);
}

DEV void ph_ada(const P& p, char* smem) {
  const int tid = get_tid();
  float* mod = (float*)(p.ws + OFF_MOD);
  if (vbid() < 192) {
    smem += vboff();
    float* sc = (float*)smem;
    for (int i = tid; i < 9 * 1024; i += 256) { const int bi = i >> 10, k = i & 1023; const float v = bi < 8 ? p.c[bi * 1024 + k] : p.c_ctx[k]; sc[i] = v * sigm(v); }
    __syncthreads();
    float* red = (float*)(smem + 36864);
    for (int item = vbid(); item < 192; item += vgrid()) {
      const int l = item / 96, n0 = (item % 96) * 64, nn = tid & 63, kq = tid >> 6;
      float acc[9];
#pragma unroll
      for (int b = 0; b < 9; ++b) acc[b] = 0.f;
      const float* w = p.ada_w + (size_t)l * 1024 * 6144 + n0 + nn;
      for (int k = kq * 256; k < kq * 256 + 256; ++k) {
        const float wv = w[(size_t)k * 6144];
#pragma unroll
        for (int b = 0; b < 9; ++b) acc[b] += sc[b * 1024 + k] * wv;
      }
#pragma unroll
      for (int b = 0; b < 9; ++b) red[(kq * 9 + b) * 64 + nn] = acc[b];
      __syncthreads();
      for (int e = tid; e < 9 * 64; e += 256) {
        const int b = e >> 6, n = e & 63;
        const float v = red[(0 * 9 + b) * 64 + n] + red[(1 * 9 + b) * 64 + n] + red[(2 * 9 + b) * 64 + n] + red[(3 * 9 + b) * 64 + n];
        mod[((size_t)l * 9 + b) * 6144 + n0 + n] = v + p.ada_b[l * 6144 + n0 + n];
      }
      __syncthreads();
    }
  } else if (vbid() == 192) {
    float2* rope = (float2*)(p.ws + OFF_ROPE);
    for (int e = tid; e < 512; e += 256) {
      const int pos = e >> 3, f = e & 7;
      const float inv = exp2f(-(float)f * 0.125f * 13.287712379549449f);
      float s, c; sincos_d((double)((float)pos * inv), s, c);
      rope[e] = make_float2(c, s);
    }
  }
}

DEV int map_col(int mode, int n) {
  if (mode == 0) return n;
  if (mode == 1) {
    if (n < 512) return n;
    if (n < 2560) return n + 32;
    if (n < 2592) return 512 + (n - 2560);
    if (n < 2816) return -1;
    return 2592 + (n - 2816);
  }
  if (mode == 2) {
    const int tile = n >> 7, nb = n & 127, wn = nb >> 6, j = (nb >> 4) & 3, cc = nb & 15;
    return (j < 2) ? tile * 64 + wn * 32 + j * 16 + cc : 1024 + tile * 64 + wn * 32 + (j - 2) * 16 + cc;
  }
  const int h = n / 96, d = n % 96;
  if (d < 64) return n;
  const int pp = d - 64, a = pp >> 4, f = (pp & 15) >> 1, half = pp & 1;
  return h * 96 + 64 + a * 16 + half * 8 + f;
}
DEV void cvt_tile(const float* __restrict__ src, int K, int Nsrc, bf16_t* __restrict__ dst, int mode, const float* __restrict__ gain, int nt, int kt, char* smem) {
  float* tile = (float*)smem + (vboff() >> 2);
  const int tid = get_tid();
  const int n0 = nt * 64, k0 = kt * 64;
  if (mode == 3) {
    const int r = tid >> 6, c = tid & 63;
    const int sn = map_col(mode, n0 + c);
#pragma unroll 4
    for (int i = 0; i < 16; ++i) {
      const int k = k0 + r + 4 * i;
      float v = sn >= 0 ? src[(size_t)k * Nsrc + sn] : 0.f;
      if (gain) v *= gain[k];
      tile[(r + 4 * i) * 65 + c] = v;
    }
  } else {
    const int r = tid >> 4, c4 = (tid & 15) * 4;
    const int sn = map_col(mode, n0 + c4);
#pragma unroll
    for (int i = 0; i < 4; ++i) {
      const int k = k0 + r + 16 * i;
      f32x4 v = sn >= 0 ? *(const f32x4*)(src + (size_t)k * Nsrc + sn) : (f32x4){0.f, 0.f, 0.f, 0.f};
      if (gain) v = v * gain[k];
      float* t = tile + (r + 16 * i) * 65 + c4;
      t[0] = v[0]; t[1] = v[1]; t[2] = v[2]; t[3] = v[3];
    }
  }
  __syncthreads();
  {
    const int n = tid >> 2, kp = (tid & 3) * 16;
    u32x4 w0, w1;
    w0.x = pk_bf16(tile[(kp + 0) * 65 + n], tile[(kp + 1) * 65 + n]);   w0.y = pk_bf16(tile[(kp + 2) * 65 + n], tile[(kp + 3) * 65 + n]);
    w0.z = pk_bf16(tile[(kp + 4) * 65 + n], tile[(kp + 5) * 65 + n]);   w0.w = pk_bf16(tile[(kp + 6) * 65 + n], tile[(kp + 7) * 65 + n]);
    w1.x = pk_bf16(tile[(kp + 8) * 65 + n], tile[(kp + 9) * 65 + n]);   w1.y = pk_bf16(tile[(kp + 10) * 65 + n], tile[(kp + 11) * 65 + n]);
    w1.z = pk_bf16(tile[(kp + 12) * 65 + n], tile[(kp + 13) * 65 + n]); w1.w = pk_bf16(tile[(kp + 14) * 65 + n], tile[(kp + 15) * 65 + n]);
    u32x4* d = (u32x4*)(dst + (size_t)(n0 + n) * K + k0 + kp);
    d[0] = w0; d[1] = w1;
  }
  __syncthreads();
}
DEV void cvt_item(const P& p, int l, int it, char* smem) {
  char* ws = p.ws;
  if (it < 1472) { cvt_tile(p.w_in + (size_t)l * 1024 * 5664, 1024, 5664, (bf16_t*)(ws + OFF_WIN), 1, nullptr, it / 16, it % 16, smem); return; }
  it -= 1472;
  if (it < 48) { cvt_tile(p.w_uq + (size_t)l * 256 * 768, 256, 768, (bf16_t*)(ws + OFF_WUQ), 3, p.q_norm + l * 256, it / 4, it % 4, smem); return; }
  it -= 48;
  if (it < 64) { cvt_tile(p.w_ukv + (size_t)l * 256 * 1024, 256, 1024, (bf16_t*)(ws + OFF_WUKV), 0, p.kv_norm + l * 256, it / 4, it % 4, smem); return; }
  it -= 64;
  if (it < 128) { cvt_tile(p.w_o + (size_t)l * 512 * 1024, 512, 1024, (bf16_t*)(ws + OFF_WO), 0, nullptr, it / 8, it % 8, smem); return; }
  it -= 128;
  if (it < 128) { cvt_tile(p.conv_w_out + (size_t)l * 512 * 1024, 512, 1024, (bf16_t*)(ws + OFF_WC), 0, nullptr, it / 8, it % 8, smem); return; }
  it -= 128;
  if (it < 256) { cvt_tile(p.w_glu + (size_t)l * 512 * 2048, 512, 2048, (bf16_t*)(ws + OFF_WGLU), 0, nullptr, it / 8, it % 8, smem); return; }
  it -= 256;
  if (it < 256) { cvt_tile(p.w_out + (size_t)l * 1024 * 1024, 1024, 1024, (bf16_t*)(ws + OFF_WOUT), 0, nullptr, it / 16, it % 16, smem); return; }
  it -= 256;
  if (it < 1024) { cvt_tile(p.w1 + (size_t)l * 1024 * 4096, 1024, 4096, (bf16_t*)(ws + OFF_W1), 0, nullptr, it / 16, it % 16, smem); return; }
  it -= 1024;
  cvt_tile(p.w2 + (size_t)l * 4096 * 1024, 4096, 1024, (bf16_t*)(ws + OFF_W2), 0, nullptr, it / 64, it % 64, smem);
}
constexpr int N_CVT = 4400;

struct Disc { double dt; float are, aim, fre, fim; };
DEV Disc s5_disc(const P& p, int l, int dir, int g, int pp) {
  Disc d; const int gi = (l * 2 + dir) * 32 + g;
  d.dt = (double)expf(p.log_dt[gi]); d.are = p.a_re[gi * 64 + pp]; d.aim = p.a_im[gi * 64 + pp];
  const float mag = __expf((float)(d.dt * (double)d.are)); float sn, cs; sincos_d(d.dt * (double)d.aim, sn, cs);
  const float abr = mag * cs, abi = mag * sn, den = d.are * d.are + d.aim * d.aim, nr = abr - 1.0f, ni = abi;
  d.fre = (nr * d.are + ni * d.aim) / den; d.fim = (ni * d.are - nr * d.aim) / den;
  return d;
}
DEV float2 cpow(const Disc& d, int e) {
  const float mag = __expf((float)((double)e * d.dt * (double)d.are)); float sn, cs; sincos_d((double)e * d.dt * (double)d.aim, sn, cs);
  return make_float2(mag * cs, mag * sn);
}
DEV float2 cmulf(float2 a, float2 b) { return make_float2(a.x * b.x - a.y * b.y, a.x * b.y + a.y * b.x); }

DEV void ktab_item(const P& p, int l, int it, char* smem) {
  const int tid = get_tid();
  const int lb = it & 7, dir = (it >> 3) & 1, g = it >> 4, gi = (l * 2 + dir) * 32 + g;
  smem += vboff();
  float2* CW = (float2*)smem;
  float2* BB = (float2*)(smem + 32768);
  float2* WL = (float2*)(smem + 40960);
  float2* FL = (float2*)(smem + 43008);
  {
    const int li = tid >> 6, pp = tid & 63;
    const Disc d = s5_disc(p, l, dir, g, pp);
    WL[tid] = cpow(d, lb * 4 + li);
    if (li == 0) FL[pp] = make_float2(d.fre, d.fim);
  }
  __syncthreads();
  for (int e = tid; e < 4096; e += 256) {
    const int li = e >> 10, co = (e >> 6) & 15, pp = e & 63;
    const float2 c = make_float2(p.c_re[((size_t)gi * 16 + co) * 64 + pp], p.c_im[((size_t)gi * 16 + co) * 64 + pp]);
    CW[e] = cmulf(c, WL[li * 64 + pp]);
  }
  for (int e = tid; e < 1024; e += 256) {
    const int pp = e >> 4;
    const float2 b = make_float2(p.b_re[(size_t)gi * 1024 + e], p.b_im[(size_t)gi * 1024 + e]);
    BB[e] = cmulf(FL[pp], b);
  }
  __syncthreads();
  float* ktab = (float*)(p.ws + OFF_KTAB);
  const int co = tid >> 4, ci = tid & 15;
#pragma unroll
  for (int li = 0; li < 4; ++li) {
    float acc = 0.f;
    for (int pp = 0; pp < 64; ++pp) { const float2 cw = CW[(li * 16 + co) * 64 + pp], bb = BB[pp * 16 + ci]; acc += cw.x * bb.x - cw.y * bb.y; }
    ktab[(((size_t)g * 2 + dir) * 32 + lb * 4 + li) * 256 + co * 16 + ci] = acc;
  }
  __syncthreads();
}
DEV void ef_item(const P& p, int l, int it) {
  const int g = it >> 4, id = (it & 15) * 256 + get_tid();
  const int t = id & 31, pp = (id >> 5) & 63, dir = id >> 11, gi = (l * 2 + dir) * 32 + g;
  const Disc d = s5_disc(p, l, dir, g, pp);
  const float2 we = cpow(d, dir == 0 ? t + 1 : 32 - t), wf = cpow(d, dir == 0 ? 31 - t : t);
  unsigned* Et = (unsigned*)(p.ws + OFF_ET) + (size_t)g * 512 * 128;
  bf16_t* Ft = (bf16_t*)(p.ws + OFF_FT) + (size_t)g * 256 * 512;
#pragma unroll
  for (int c = 0; c < 16; ++c) {
    const float2 cc = make_float2(p.c_re[((size_t)gi * 16 + c) * 64 + pp], p.c_im[((size_t)gi * 16 + c) * 64 + pp]);
    const float2 cw = cmulf(cc, we);
    Et[(size_t)(t * 16 + c) * 128 + dir * 64 + pp] = pk_bf16(cw.x, -cw.y);
  }
  const float2 f = make_float2(d.fre, d.fim);
  unsigned fr[8], fi[8];
#pragma unroll
  for (int c2 = 0; c2 < 8; ++c2) {
    const size_t bi = ((size_t)gi * 64 + pp) * 16 + c2 * 2;
    const float2 v0 = cmulf(wf, cmulf(f, make_float2(p.b_re[bi], p.b_im[bi])));
    const float2 v1 = cmulf(wf, cmulf(f, make_float2(p.b_re[bi + 1], p.b_im[bi + 1])));
    fr[c2] = pk_bf16(v0.x, v1.x); fi[c2] = pk_bf16(v0.y, v1.y);
  }
  u32x4* r0 = (u32x4*)(Ft + (size_t)(dir * 128 + pp * 2) * 512 + t * 16);
  u32x4* r1 = (u32x4*)(Ft + (size_t)(dir * 128 + pp * 2 + 1) * 512 + t * 16);
  r0[0] = (u32x4){fr[0], fr[1], fr[2], fr[3]}; r0[1] = (u32x4){fr[4], fr[5], fr[6], fr[7]};
  r1[0] = (u32x4){fi[0], fi[1], fi[2], fi[3]}; r1[1] = (u32x4){fi[4], fi[5], fi[6], fi[7]};
}
DEV void mt_item(const P& p, int l, int it) {
  const int g = it >> 7, id = (it & 127) * 256 + get_tid();
  const int k8 = id & 63, n = id >> 6, ti = k8 >> 1, ci0 = (k8 & 1) * 8, to = n >> 4, co = n & 15;
  const float* ktab = (const float*)(p.ws + OFF_KTAB);
  float v[8];
  if (to != ti) {
    const int dir = to > ti ? 0 : 1, lag = to > ti ? to - ti : ti - to;
    const f32x4* s = (const f32x4*)(ktab + (((size_t)g * 2 + dir) * 32 + lag) * 256 + co * 16 + ci0);
    const f32x4 a = s[0], b = s[1];
    v[0] = a[0]; v[1] = a[1]; v[2] = a[2]; v[3] = a[3]; v[4] = b[0]; v[5] = b[1]; v[6] = b[2]; v[7] = b[3];
  } else {
    const f32x4* s0 = (const f32x4*)(ktab + (((size_t)g * 2 + 0) * 32) * 256 + co * 16 + ci0);
    const f32x4* s1 = (const f32x4*)(ktab + (((size_t)g * 2 + 1) * 32) * 256 + co * 16 + ci0);
    const f32x4 a = s0[0] + s1[0], b = s0[1] + s1[1];
    v[0] = a[0]; v[1] = a[1]; v[2] = a[2]; v[3] = a[3]; v[4] = b[0]; v[5] = b[1]; v[6] = b[2]; v[7] = b[3];
    const float dd = p.s5_d[l * 512 + g * 16 + co];
#pragma unroll
    for (int e = 0; e < 8; ++e) if (ci0 + e == co) v[e] += dd;
  }
  u32x4 w; w.x = pk_bf16(v[0], v[1]); w.y = pk_bf16(v[2], v[3]); w.z = pk_bf16(v[4], v[5]); w.w = pk_bf16(v[6], v[7]);
  *(u32x4*)((bf16_t*)(p.ws + OFF_MT) + ((size_t)g * 512 + n) * 512 + k8 * 8) = w;
}

DEV void norm_rows(const P& p, const float* lat, const float* ctxp, int nrows, const float* gain, const float* modl, int ishift, int iscale) {
  const int lane = get_tid() & 63, wid = get_tid() >> 6;
  bf16_t* XN = (bf16_t*)(p.ws + OFF_XN);
  for (int item = vbid(); item < nrows / 8; item += vgrid()) {
    const int row0 = item * 8 + wid * 2;
    f32x4 v[2][4]; float ss[2];
#pragma unroll
    for (int q = 0; q < 2; ++q) {
      const int row = row0 + q;
      const float* src = row < MLAT ? lat + (size_t)row * 1024 : ctxp + (size_t)(row - MLAT) * 1024;
#pragma unroll
      for (int i = 0; i < 4; ++i) v[q][i] = ((const f32x4*)src)[lane + 64 * i];
    }
#pragma unroll
    for (int q = 0; q < 2; ++q) {
      float s = 0.f;
#pragma unroll
      for (int i = 0; i < 4; ++i) s += v[q][i][0] * v[q][i][0] + v[q][i][1] * v[q][i][1] + v[q][i][2] * v[q][i][2] + v[q][i][3] * v[q][i][3];
      ss[q] = wave_sum(s);
    }
#pragma unroll
    for (int q = 0; q < 2; ++q) {
      const int row = row0 + q, bi = row < MLAT ? row >> 12 : 8;
      const float rstd = rsqrtf(ss[q] * (1.0f / 1024.0f) + EPSN);
      const float* msh = modl + ((size_t)bi * 6 + ishift) * 1024; const float* msc = modl + ((size_t)bi * 6 + iscale) * 1024;
#pragma unroll
      for (int i = 0; i < 4; ++i) {
        const int col = (lane + 64 * i) * 4;
        const f32x4 g = *(const f32x4*)(gain + col), sh = *(const f32x4*)(msh + col), sc = *(const f32x4*)(msc + col);
        const f32x4 y = v[q][i] * rstd * g * (sc + 1.0f) + sh;
        *(u32x2*)(XN + (size_t)row * 1024 + col) = (u32x2){pk_bf16(y[0], y[1]), pk_bf16(y[2], y[3])};
      }
    }
  }
}
DEV void ph_final(const P& p) {
  const int lane = get_tid() & 63, wid = get_tid() >> 6;
  for (int item = vbid(); item < MLAT / 8; item += vgrid()) {
    const int row0 = item * 8 + wid * 2;
    f32x4 v[2][4]; float ss[2];
#pragma unroll
    for (int q = 0; q < 2; ++q)
#pragma unroll
      for (int i = 0; i < 4; ++i) v[q][i] = ((const f32x4*)(p.out + (size_t)(row0 + q) * 1024))[lane + 64 * i];
#pragma unroll
    for (int q = 0; q < 2; ++q) {
      float s = 0.f;
#pragma unroll
      for (int i = 0; i < 4; ++i) s += v[q][i][0] * v[q][i][0] + v[q][i][1] * v[q][i][1] + v[q][i][2] * v[q][i][2] + v[q][i][3] * v[q][i][3];
      ss[q] = wave_sum(s);
    }
#pragma unroll
    for (int q = 0; q < 2; ++q) {
      const float rstd = rsqrtf(ss[q] * (1.0f / 1024.0f) + EPSN);
#pragma unroll
      for (int i = 0; i < 4; ++i) { const int col = (lane + 64 * i) * 4; const f32x4 g = *(const f32x4*)(p.norm_final + col); ((f32x4*)(p.out + (size_t)(row0 + q) * 1024))[lane + 64 * i] = v[q][i] * rstd * g; }
    }
  }
}

DEV void ph_prep(const P& p, int l, char* smem) {
  for (int r_ = 0, nr_ = rounds_of(N_CVT); r_ < nr_; ++r_) { int it = vbid() + r_ * vgrid(); it = it < N_CVT ? it : N_CVT - 1; cvt_item(p, l, it, smem); }
  for (int r_ = 0, nr_ = rounds_of(512); r_ < nr_; ++r_) { int it = vbid() + r_ * vgrid(); it = it < 512 ? it : 511; ktab_item(p, l, it, smem); }
  for (int it = vbid(); it < 512; it += vgrid()) ef_item(p, l, it);
  { float* ssq = (float*)(p.ws + OFF_SSQ); const int step = vgrid() * 256; int i = vbid() * 256 + get_tid();
#pragma unroll
    for (int e = 0; e < 4; ++e) { if (i < MALL * 2) ssq[i] = 0.f; i += step; } }
  const float* modl = (const float*)(p.ws + OFF_MOD) + (size_t)l * 9 * 6144;
  if (l == 0) norm_rows(p, p.x, p.ctx, MALL, p.norm_mix, modl, 0, 1);
  else norm_rows(p, p.out, (const float*)(p.ws + OFF_XC), MALL, p.norm_mix + 1024, modl, 0, 1);
}

DEV void ph_in(const P& p, int l, char* smem) {
  for (int it = vbid(); it < 4096; it += vgrid()) mt_item(p, l, it);
}

DEV void rms_rows(const bf16_t* zb, int row0, int rmax, float* srstd) {
  const int tid = get_tid(), r = tid >> 1, half = tid & 1;
  int row = row0 + r; row = row < rmax ? row : rmax - 1;
  const u32x4* q = (const u32x4*)(zb + (size_t)row * LDZ + half * 128);
  float ss = 0.f;
#pragma unroll 4
  for (int i = 0; i < 16; ++i) {
    const u32x4 w = q[i];
    ss += bflo(w.x) * bflo(w.x) + bfhi(w.x) * bfhi(w.x) + bflo(w.y) * bflo(w.y) + bfhi(w.y) * bfhi(w.y) + bflo(w.z) * bflo(w.z) + bfhi(w.z) * bfhi(w.z) + bflo(w.w) * bflo(w.w) + bfhi(w.w) * bfhi(w.w);
  }
  ss += __shfl_xor(ss, 1);
  if (!half) srstd[r] = rsqrtf(ss * (1.0f / 256.0f) + EPSN);
  __syncthreads();
}

DEV void ph_mid(const P& p, int l, bool need, char* smem) {
  const int tid = get_tid(), lane = tid & 63, wid = tid >> 6, wm = wid >> 1, wn = wid & 1, l15 = lane & 15, lq = lane >> 4;
  bf16_t* Z = (bf16_t*)(p.ws + OFF_Z);
  bf16_t* Qb = (bf16_t*)(p.ws + OFF_Q); bf16_t* Kb = (bf16_t*)(p.ws + OFF_K); bf16_t* Vt = (bf16_t*)(p.ws + OFF_VT);
  float* srstd = (float*)(smem + 65536) + (vboff() >> 2);
  const float2* rope = (const float2*)(p.ws + OFF_ROPE);
  for (int it = vbid(); it < MALL / 16; it += vgrid()) {
    const int row = it * 16 + (tid >> 4), e = tid & 15, a = e >> 3, f = e & 7;
    const bf16_t* zp = Z + (size_t)row * LDZ + ZPE + a * 16 + f;
    float x0 = __uint_as_float((unsigned)zp[0] << 16), x1 = __uint_as_float((unsigned)zp[8] << 16);
    int b, key;
    if (row < MLAT) {
      b = row >> 12; const int n = row & 4095; key = 256 + n;
      const float2 cs = rope[(a ? (n & 63) : (n >> 6)) * 8 + f];
      const float t0 = x0 * cs.x - x1 * cs.y, t1 = x1 * cs.x + x0 * cs.y; x0 = t0; x1 = t1;
    } else { const int cr = row - MLAT; b = cr >> 8; key = cr & 255; }
    const unsigned w = pk_bf16(x0, x1);
#pragma unroll
    for (int h = 0; h < 8; ++h) *(unsigned*)(Kb + ((size_t)(b * 8 + h) * NKEY + key) * 96 + 64 + a * 16 + f * 2) = w;
  }
}

DEV void ph_carry(const P& p, int l, bool need) {
  const int tid = get_tid();
  bf16_t* Z = (bf16_t*)(p.ws + OFF_Z);
  for (int it = vbid(); it < 128; it += vgrid()) {
    const int idx = it * 256 + tid, pp = idx & 63, dir = (idx >> 6) & 1, g = (idx >> 7) & 31, b = idx >> 12;
    const Disc d = s5_disc(p, l, dir, g, pp);
    const float2 at = cpow(d, 32);
    unsigned* S = (unsigned*)(p.ws + OFF_S) + (g * 256 + dir * 128 + pp * 2) / 2;
    float sr = 0.f, si = 0.f;
    for (int blk = 0; blk < 17; ++blk) {
      unsigned v[8]; int rows[8];
#pragma unroll
      for (int e = 0; e < 8; ++e) {
        int r;
        if (blk == 0) r = 1024 + b * 8 + (dir ? 7 - e : e);
        else { const int j = (blk - 1) * 8 + e; r = b * 128 + (dir ? 127 - j : j); }
        rows[e] = r; v[e] = S[(size_t)r * 4096];
      }
#pragma unroll
      for (int e = 0; e < 8; ++e) {
        S[(size_t)rows[e] * 4096] = pk_bf16(sr, si);
        const float nr = at.x * sr - at.y * si + bflo(v[e]), ni = at.x * si + at.y * sr + bfhi(v[e]);
        sr = nr; si = ni;
      }
    }
  }
  {
    const int Mc = need ? MALL : MLAT;
    const int ch = (tid & 63) * 8, rsub = tid >> 6;
    const float* cw = p.conv_w + (size_t)l * 3 * 512 + ch;
    float w0[8], w1[8], w2[8];
#pragma unroll
    for (int e = 0; e < 8; ++e) { w0[e] = cw[e]; w1[e] = cw[512 + e]; w2[e] = cw[1024 + e]; }
    for (int it = vbid(); it < Mc / 32; it += vgrid()) {
      const int rbase = it * 32 + rsub * 8;
      float up[8], uc[8], un[8];
      auto loadu = [&](int row, bool valid, float (&u)[8]) {
        if (valid) {
          const u32x4 c = *(const u32x4*)(Z + (size_t)row * LDZ + ZCC + ch), x = *(const u32x4*)(Z + (size_t)row * LDZ + ZCX + ch);
          u[0] = bflo(c.x) * bflo(x.x); u[1] = bfhi(c.x) * bfhi(x.x); u[2] = bflo(c.y) * bflo(x.y); u[3] = bfhi(c.y) * bfhi(x.y);
          u[4] = bflo(c.z) * bflo(x.z); u[5] = bfhi(c.z) * bfhi(x.z); u[6] = bflo(c.w) * bflo(x.w); u[7] = bfhi(c.w) * bfhi(x.w);
        } else {
#pragma unroll
          for (int e = 0; e < 8; ++e) u[e] = 0.f;
        }
      };
      auto tpos = [&](int row, int& t, int& len) { if (row < MLAT) { t = row & 4095; len = 4096; } else { t = (row - MLAT) & 255; len = 256; } };
      int t0, len0; tpos(rbase, t0, len0);
      loadu(rbase - 1, t0 > 0, up); loadu(rbase, true, uc);
#pragma unroll
      for (int rr = 0; rr < 8; ++rr) {
        const int row = rbase + rr; int t, len; tpos(row, t, len);
        loadu(row + 1, t < len - 1, un);
        const u32x4 zb = *(const u32x4*)(Z + (size_t)row * LDZ + ZCB + ch);
        float y[8];
#pragma unroll
        for (int e = 0; e < 8; ++e) y[e] = w0[e] * up[e] + w1[e] * uc[e] + w2[e] * un[e];
        u32x4 o;
        o.x = pk_bf16(bflo(zb.x) * y[0], bfhi(zb.x) * y[1]); o.y = pk_bf16(bflo(zb.y) * y[2], bfhi(zb.y) * y[3]);
        o.z = pk_bf16(bflo(zb.z) * y[4], bfhi(zb.z) * y[5]); o.w = pk_bf16(bflo(zb.w) * y[6], bfhi(zb.w) * y[7]);
        *(u32x4*)(Z + (size_t)row * LDZ + ZCV + ch) = o;
#pragma unroll
        for (int e = 0; e < 8; ++e) { up[e] = uc[e]; uc[e] = un[e]; }
      }
    }
  }
}

DEV void attn_item(const P& p, int bh, int qrow0, int nkt, int outrow0, char* smem) {
  const int tid = get_tid(), lane = tid & 63, wid = tid >> 6, l15 = lane & 15, lq = lane >> 4;
  const bf16_t* Qb = (const bf16_t*)(p.ws + OFF_Q) + (size_t)bh * NKEY * 96;
  const bf16_t* Kb = (const bf16_t*)(p.ws + OFF_K) + (size_t)bh * NKEY * 96;
  const bf16_t* Vt = (const bf16_t*)(p.ws + OFF_VT) + (size_t)bh * 64 * NKEY;
  bf16_t* Z = (bf16_t*)(p.ws + OFF_Z);
  constexpr int KB = 16384, VB = 8192, VBASE = 3 * KB;
  const int vo = vboff();
  bf16x8 qf[2][3];
#pragma unroll
  for (int qt = 0; qt < 2; ++qt)
#pragma unroll
    for (int ks = 0; ks < 3; ++ks) qf[qt][ks] = *(const bf16x8*)(Qb + (size_t)(qrow0 + wid * 32 + qt * 16 + l15) * 96 + ks * 32 + lq * 8);
  f32x4 o[4][2];
#pragma unroll
  for (int vt = 0; vt < 4; ++vt)
#pragma unroll
    for (int qt = 0; qt < 2; ++qt) o[vt][qt] = (f32x4){0.f, 0.f, 0.f, 0.f};
  float mused[2] = {0.f, 0.f};
  f32x4 osum[2] = {(f32x4){0.f, 0.f, 0.f, 0.f}, (f32x4){0.f, 0.f, 0.f, 0.f}};
  const bf16x8 ones = __builtin_bit_cast(bf16x8, (u32x4){0x3f803f80u, 0x3f803f80u, 0x3f803f80u, 0x3f803f80u});
  u32x4 kr[4], vr[2];
  const int krow = tid >> 4, kc = tid & 15;
  const int vrow = tid >> 3, vc = tid & 7;
  const int kwo = vo + krow * 256 + ((kc ^ krow) << 4), vwo = vo + VBASE + vrow * 128 + ((vc ^ ((vrow >> 1) & 7)) << 4);
  const int kro = vo + l15 * 256, vro = vo + VBASE + l15 * 128;
  f32x4 st[4][2];
  bf16x8 pf[2][2], vf[2][4];
#define ALOAD(kt) { const int key0_ = (kt) * 64; \
    if (kc < 12) { _Pragma("unroll") for (int i = 0; i < 4; ++i) kr[i] = *(const u32x4*)(Kb + (size_t)(key0_ + krow + 16 * i) * 96 + kc * 8); } \
    _Pragma("unroll") for (int i = 0; i < 2; ++i) vr[i] = *(const u32x4*)(Vt + (size_t)(vrow + 32 * i) * NKEY + key0_ + vc * 8); }
#define ASTORE(slot) { char* sk_ = smem + (slot) * KB; char* sv_ = smem + (slot) * VB; \
    if (kc < 12) { _Pragma("unroll") for (int i = 0; i < 4; ++i) *(u32x4*)(sk_ + kwo + i * 4096) = kr[i]; } \
    _Pragma("unroll") for (int i = 0; i < 2; ++i) *(u32x4*)(sv_ + vwo + i * 4096) = vr[i]; }
#define LDK(dst, s_, ks_) { _Pragma("unroll") for (int kk = 0; kk < 4; ++kk) dst[kk] = *(const bf16x8*)((s_) + kk * 4096 + kro + ((((ks_) * 4 + lq) ^ l15) << 4)); }
#define MMK(src_, ks_) { _Pragma("unroll") for (int kk = 0; kk < 4; ++kk) _Pragma("unroll") for (int qt = 0; qt < 2; ++qt) st[kk][qt] = __builtin_amdgcn_mfma_f32_16x16x32_bf16(src_[kk], qf[qt][ks_], st[kk][qt], 0, 0, 0); }
#define QK(slot) { const char* s = smem + (slot) * KB; bf16x8 kfa[4], kfb[4]; \
    LDK(kfa, s, 0); LDK(kfb, s, 1); \
    _Pragma("unroll") for (int kk = 0; kk < 4; ++kk) _Pragma("unroll") for (int qt = 0; qt < 2; ++qt) { const float nm = -mused[qt]; st[kk][qt] = (f32x4){nm, nm, nm, nm}; } \
    __builtin_amdgcn_s_setprio(1); MMK(kfa, 0); LDK(kfa, s, 2); MMK(kfb, 1); MMK(kfa, 2); __builtin_amdgcn_s_setprio(0); }
#define SM(first) { _Pragma("unroll") for (int qt = 0; qt < 2; ++qt) { \
      float mx = st[0][qt][0]; \
      _Pragma("unroll") for (int kk = 0; kk < 4; ++kk) _Pragma("unroll") for (int r = 0; r < 4; ++r) mx = fmaxf(mx, st[kk][qt][r]); \
      if ((first) || __builtin_amdgcn_ballot_w64(mx > 8.0f) != 0) {     \
        mx = fmaxf(mx, __shfl_xor(mx, 16)); mx = fmaxf(mx, __shfl_xor(mx, 32)); \
        const float sc = __builtin_amdgcn_exp2f(-mx); \
        mused[qt] += mx; \
        _Pragma("unroll") for (int vt = 0; vt < 4; ++vt) o[vt][qt] = o[vt][qt] * sc; \
        osum[qt] = osum[qt] * sc; \
        _Pragma("unroll") for (int kk = 0; kk < 4; ++kk) _Pragma("unroll") for (int r = 0; r < 4; ++r) st[kk][qt][r] = __builtin_amdgcn_exp2f(st[kk][qt][r] - mx); \
      } else { \
        _Pragma("unroll") for (int kk = 0; kk < 4; ++kk) _Pragma("unroll") for (int r = 0; r < 4; ++r) st[kk][qt][r] = __builtin_amdgcn_exp2f(st[kk][qt][r]); \
      } \
      _Pragma("unroll") for (int k2 = 0; k2 < 2; ++k2) { \
        u32x4 w; \
        w.x = pk_bf16(st[2 * k2][qt][0], st[2 * k2][qt][1]); w.y = pk_bf16(st[2 * k2][qt][2], st[2 * k2][qt][3]); \
        w.z = pk_bf16(st[2 * k2 + 1][qt][0], st[2 * k2 + 1][qt][1]); w.w = pk_bf16(st[2 * k2 + 1][qt][2], st[2 * k2 + 1][qt][3]); \
        pf[qt][k2] = __builtin_bit_cast(bf16x8, w); } } }
#define PVLOAD(slot) { const char* s = smem + (slot) * VB; \
    _Pragma("unroll") for (int vt = 0; vt < 4; ++vt) vf[0][vt] = *(const bf16x8*)(s + vt * 2048 + vro + (((0 * 4 + lq) ^ (l15 >> 1)) << 4)); }
#define PVMMA(slot) { const char* s = smem + (slot) * VB; \
    _Pragma("unroll") for (int vt = 0; vt < 4; ++vt) vf[1][vt] = *(const bf16x8*)(s + vt * 2048 + vro + (((1 * 4 + lq) ^ (l15 >> 1)) << 4)); \
    __builtin_amdgcn_s_setprio(1); \
    _Pragma("unroll") for (int k2 = 0; k2 < 2; ++k2) _Pragma("unroll") for (int vt = 0; vt < 4; ++vt) \
      _Pragma("unroll") for (int qt = 0; qt < 2; ++qt) o[vt][qt] = __builtin_amdgcn_mfma_f32_16x16x32_bf16(vf[k2][vt], pf[qt][k2], o[vt][qt], 0, 0, 0); \
    _Pragma("unroll") for (int k2 = 0; k2 < 2; ++k2) _Pragma("unroll") for (int qt = 0; qt < 2; ++qt) osum[qt] = __builtin_amdgcn_mfma_f32_16x16x32_bf16(ones, pf[qt][k2], osum[qt], 0, 0, 0); \
    __builtin_amdgcn_s_setprio(0); }
  const bool skew = vbsel() != 0;
  asm volatile("" : "+s"(nkt));
#define ABAR() { asm volatile("s_waitcnt lgkmcnt(0)" ::: "memory"); __builtin_amdgcn_s_barrier(); asm volatile("" ::: "memory"); }
  ALOAD(0); ASTORE(0); if (nkt > 1) ALOAD(1); ABAR();
  int cur = 0, prev = 2, nxt = 1;
#pragma nounroll
  for (int kt = 0; kt < nkt; ++kt) {
    if (kt + 1 < nkt) ASTORE(nxt);
    if (kt + 2 < nkt) ALOAD(kt + 2);
    if (!skew) { QK(cur); PVLOAD(cur); __builtin_amdgcn_sched_barrier(0); SM(kt == 0); PVMMA(cur); }
    else { if (kt > 0) { PVLOAD(prev); __builtin_amdgcn_sched_barrier(0); SM(kt == 1); PVMMA(prev); } QK(cur); }
    ABAR();
    prev = cur; cur = nxt; nxt = (nxt == 2) ? 0 : nxt + 1;
  }
  if (skew) { PVLOAD(prev); SM(nkt == 1); PVMMA(prev); }
  ABAR();
#undef ABAR
#undef ALOAD
#undef ASTORE
#undef QK
#undef SM
#undef PVLOAD
#undef PVMMA
#undef LDK
#undef MMK
  const int h = bh & 7;
#pragma unroll
  for (int qt = 0; qt < 2; ++qt) {
    const float inv = 1.0f / osum[qt][0];
    const int row = outrow0 + wid * 32 + qt * 16 + l15;
#pragma unroll
    for (int vt = 0; vt < 4; ++vt) {
      const f32x4 v = o[vt][qt] * inv;
      *(u32x2*)(Z + (size_t)row * LDZ + ZAO + h * 64 + vt * 16 + lq * 4) = (u32x2){pk_bf16(v[0], v[1]), pk_bf16(v[2], v[3])};
    }
  }
}

DEV float gelu_t(float x) { const float z = 0.7978845608028654f * (x + 0.044715f * x * x * x); const float e = __expf(2.0f * z); return 0.5f * x * (2.0f - 2.0f / (1.0f + e)); }

DEV void ph_attn(const P& p, int l, bool need, char* smem) {
  const int tid = get_tid(), lane = tid & 63, wid = tid >> 6, wm = wid >> 1, wn = wid & 1, l15 = lane & 15, lq = lane >> 4;
  bf16_t* Z = (bf16_t*)(p.ws + OFF_Z);
  {
    const bf16_t* Mt = (const bf16_t*)(p.ws + OFF_MT); const bf16_t* Et = (const bf16_t*)(p.ws + OFF_ET); const bf16_t* S = (const bf16_t*)(p.ws + OFF_S);
    const int nmt = need ? 9 : 8, rmax = need ? NCH : 1024;
    for (int r_ = 0, nr_ = rounds_of(32 * nmt * 4); r_ < nr_; ++r_) { int t = vbid() + r_ * vgrid(); t = t < (32 * nmt * 4) ? t : (32 * nmt * 4) - 1;
      const int g = t / (nmt * 4), mt = (t % (nmt * 4)) >> 2, nt = t & 3;
      f32x4 acc[4][4]; zero_acc<4>(acc);
      ASrc a; a.p = Z + ZS5 + g * 16; a.lda = 32 * LDZ; a.row0 = mt * 128; a.rmax = rmax; a.segshift = 4; a.segstride = LDZ;
      gemm_core<4, true>(acc, a, Mt + ((size_t)g * 512 + nt * 128) * 512, 512, 512, smem);
      gemm_core<4, true>(acc, asrc(S + g * 256, 8192, mt * 128, rmax), Et + ((size_t)g * 512 + nt * 128) * 256, 256, 256, smem);
#pragma unroll
      for (int i = 0; i < 4; ++i) {
        const int crow = mt * 128 + wm * 64 + i * 16 + l15;
        if (crow < rmax) {
#pragma unroll
          for (int j = 0; j < 4; ++j) {
            const int n = nt * 128 + wn * 64 + j * 16 + lq * 4, tt = n >> 4, c = n & 15;
            *(u32x2*)(Z + (size_t)(crow * 32 + tt) * LDZ + ZS5A + g * 16 + c) =
                (u32x2){pk_bf16(gelu_t(acc[i][j][0]), gelu_t(acc[i][j][1])), pk_bf16(gelu_t(acc[i][j][2]), gelu_t(acc[i][j][3]))};
          }
        }
      }
    }
  }
  for (int r_ = 0, nr_ = rounds_of(2048); r_ < nr_; ++r_) { int it = vbid() + r_ * vgrid(); it = it < (2048) ? it : (2048) - 1;
    const int r = it >> 9, w = it & 511, xcd = (w >> 1) & 7, slot = (w >> 4) * 2 + (w & 1);
    const int bh = r * 16 + xcd * 2 + (slot >> 5), qb = slot & 31;
    attn_item(p, bh, qb * 128, 68, (bh >> 3) * 4096 + qb * 128, smem);
  }
  if (need) for (int r_ = 0, nr_ = rounds_of(128); r_ < nr_; ++r_) { int it = vbid() + r_ * vgrid(); it = it < 128 ? it : 127;
    const int bh = it >> 1, qb = it & 1;
    attn_item(p, bh, 4096 + qb * 128, 4, MLAT + (bh >> 3) * 256 + qb * 128, smem);
  }
}

DEV int n_jobs(int ph) { return ph == 2 ? 1 : ph == 3 ? 3 : ph == 6 ? 7 : (ph == 7 || ph == 9 || ph == 10) ? 1 : 0; }
DEV pg8::Job get_job(KP kp, int ph, int l, int j) {
  const P p = ldp(kp);
  const bool need = (l == 0); const int M = need ? MALL : MLAT;
  char* ws = p.ws;
  const bf16_t* Z = (const bf16_t*)(ws + OFF_Z); const bf16_t* XN = (const bf16_t*)(ws + OFF_XN);
  const bf16_t* Wg = (const bf16_t*)(ws + OFF_WIN) + (size_t)LDZ * 1024;
  bf16_t* T = (bf16_t*)(ws + OFF_T); bf16_t* MG = (bf16_t*)(ws + OFF_MG);
  float* xc = (float*)(ws + OFF_XC);
  pg8::Job b; b.lda = 1024; b.M = M; b.N = 1024; b.K = 1024; b.mode = 0; b.O = T; b.ldc = 1024; b.T = T; b.slat = p.out; b.sctx = xc; b.dlat = p.out; b.dctx = xc;
  b.modg = (const float*)(ws + OFF_MOD) + (size_t)l * 9 * 6144; b.A = XN; b.Bt = Wg;
  b.segstride = 0; b.pnstrideA = 0; b.rows = M; b.ssq = nullptr; b.O2 = nullptr;
  if (ph == 2) { b.M = MALL; b.rows = MALL; b.N = LDZ; b.Bt = (const bf16_t*)(ws + OFF_WIN); b.O = (bf16_t*)(ws + OFF_Z); b.ldc = LDZ; b.ssq = (float*)(ws + OFF_SSQ); }
  else if (ph == 3) {
    b.ssq = (float*)(ws + OFF_SSQ); b.K = 256; b.lda = LDZ; b.modg = (const float*)(ws + OFF_ROPE);
    if (j == 0) { b.A = Z + ZQ; b.Bt = (const bf16_t*)(ws + OFF_WUQ); b.N = 768; b.mode = 6; b.O = (bf16_t*)(ws + OFF_Q); }
    else if (j == 1) { b.A = Z + ZKV; b.Bt = (const bf16_t*)(ws + OFF_WUKV); b.M = MALL; b.rows = MALL; b.N = 1024; b.mode = 7; b.O = (bf16_t*)(ws + OFF_K); b.O2 = (bf16_t*)(ws + OFF_VT); }
    else { b.ssq = nullptr; b.A = Z + ZS5; b.lda = 32 * LDZ; b.segstride = LDZ; b.pnstrideA = 16; b.Bt = (const bf16_t*)(ws + OFF_FT); b.M = 1280; b.rows = NCH; b.N = 8192; b.K = 512; b.mode = 0; b.O = (bf16_t*)(ws + OFF_S); b.ldc = 8192; }
  }
  else if (ph == 6) {
    if (j == 0) { b.A = Z + ZAO; b.lda = LDZ; b.Bt = (const bf16_t*)(ws + OFF_WO); b.K = 512; }
    else if (j == 1) { b.mode = 2; b.O = MG; }
    else if (j == 2) { b.A = Z + ZCV; b.lda = LDZ; b.Bt = (const bf16_t*)(ws + OFF_WC); b.K = 512; }
    else if (j == 3) { b.mode = 3; b.O = MG; b.Bt = Wg + (size_t)1024 * 1024; }
    else if (j == 4) { b.A = Z + ZS5A; b.lda = LDZ; b.Bt = (const bf16_t*)(ws + OFF_WGLU); b.K = 512; }
    else if (j == 5) { b.A = Z + ZS5A; b.lda = LDZ; b.Bt = (const bf16_t*)(ws + OFF_WGLU) + (size_t)1024 * 512; b.K = 512; b.mode = 1; }
    else { b.mode = 3; b.O = MG; b.Bt = Wg + (size_t)2048 * 1024; }
  } else if (ph == 7) {
    b.A = MG; b.Bt = (const bf16_t*)(ws + OFF_WOUT); b.mode = 5; b.modg += 2 * 1024;
    if (l == 0) { b.slat = p.x; b.sctx = p.ctx; }
  } else if (ph == 9) { b.Bt = (const bf16_t*)(ws + OFF_W1); b.N = 4096; b.mode = 4; b.O = (bf16_t*)(ws + OFF_Z); b.ldc = 4096; }
  else { b.A = Z; b.lda = 4096; b.K = 4096; b.Bt = (const bf16_t*)(ws + OFF_W2); b.mode = 5; b.modg += 5 * 1024; }
  return b;
}

#define LAS __attribute__((address_space(3)))
#define XB_TMO      128
#define XB_XCNT(j)  (256  + 64 * (j))
#define XB_XSUB(j)  (1280 + 64 * (j))
#define XB_XGEN(j)  (2304 + 64 * (j))
#define XB_TOP      3328
#define XB_TOPGEN   3392
#define XCD_BAR_WORDS 3456
#define XB_SPIN_CAP (1u << 18)

__device__ __forceinline__ unsigned xb_ld(unsigned* p)              { return __hip_atomic_load(p, __ATOMIC_RELAXED, __HIP_MEMORY_SCOPE_AGENT); }
__device__ __forceinline__ unsigned xb_add(unsigned* p, unsigned v) { return __hip_atomic_fetch_add(p, v, __ATOMIC_RELAXED, __HIP_MEMORY_SCOPE_AGENT); }
__device__ __forceinline__ unsigned xb_xcc_id() { return (unsigned)__builtin_amdgcn_s_getreg((3 << 11) | 20) & 0xFu; }
#define XB_SPIN(cond, bar) do { unsigned _sp = 0; while (cond) { __builtin_amdgcn_s_sleep(1); \
    if ((++_sp & 255u) == 0u) { if (xb_ld(&(bar)[XB_TMO])) break; if (_sp > XB_SPIN_CAP) { atomicAdd(&(bar)[XB_TMO], 1u); break; } } } } while (0)

struct XcdBarrier {
    unsigned* bar; unsigned x;
    volatile LAS unsigned* st;
};

__device__ __forceinline__ XcdBarrier xcd_barrier_post(unsigned* bar, volatile LAS unsigned* st) {
    XcdBarrier b; b.bar = bar; b.x = xb_xcc_id(); b.st = st;
    if (threadIdx.x == 0) (void)xb_add(&bar[XB_XCNT(b.x)], 1u);
    return b;
}
__device__ __forceinline__ void xcd_barrier_complete(unsigned* bar, unsigned x, unsigned& nloc, unsigned& nx) {
    const unsigned G = gridDim.x * gridDim.y * gridDim.z;
    unsigned sum, cnt, mine, sp = 0u;
    for (;;) {
        sum = 0u; cnt = 0u; mine = 0u;
#pragma unroll
        for (unsigned j = 0; j < 16; ++j) { const unsigned c = xb_ld(&bar[XB_XCNT(j)]); sum += c; cnt += (c > 0u) ? 1u : 0u; mine = (j == x) ? c : mine; }
        if (sum == G) break;
        __builtin_amdgcn_s_sleep(1);
        if ((++sp & 255u) == 0u) { if (xb_ld(&bar[XB_TMO])) break; if (sp > XB_SPIN_CAP) { atomicAdd(&bar[XB_TMO], 1u); break; } }
    }
    nloc = mine > 0u ? mine : 1u; nx = cnt > 0u ? cnt : 1u;
}

__device__ __forceinline__ void xcd_barrier(const XcdBarrier& b) {
    asm volatile("s_waitcnt vmcnt(0)" ::: "memory");
    __syncthreads();
    if (threadIdx.x == 0) {
        unsigned* bar = b.bar;
        __builtin_amdgcn_s_waitcnt(0);
        unsigned nloc = b.st[0], nx = b.st[1];
        if (nloc == 0u) { xcd_barrier_complete(bar, b.x, nloc, nx); b.st[0] = nloc; b.st[1] = nx; }
        const unsigned old = xb_add(&bar[XB_XSUB(b.x)], 1u);
        const unsigned gen = old / nloc;
        if (old + 1u == (gen + 1u) * nloc) {
            __builtin_amdgcn_fence(__ATOMIC_RELEASE, "agent");
            asm volatile("s_waitcnt vmcnt(0)" ::: "memory");
            const unsigned og = xb_add(&bar[XB_TOP], 1u);
            const unsigned tg = og / nx;
            if (og + 1u == (tg + 1u) * nx) xb_add(&bar[XB_TOPGEN], 1u);
            else XB_SPIN(xb_ld(&bar[XB_TOPGEN]) == tg, bar);
            __builtin_amdgcn_fence(__ATOMIC_ACQUIRE, "agent");
            xb_add(&bar[XB_XGEN(b.x)], 1u);
            asm volatile("s_waitcnt vmcnt(0)" ::: "memory");
        } else {
            XB_SPIN(xb_ld(&bar[XB_XGEN(b.x)]) == gen, bar);
            __builtin_amdgcn_fence(__ATOMIC_ACQUIRE, "agent");
            asm volatile("s_waitcnt vmcnt(0)" ::: "memory");
        }
    }
    __syncthreads();
}

DEV void run_phase(KP kp, int ph, int l, char* smem) {
  const bool need = (l == 0);
  switch (ph) {
    case 0: { const P p = ldp(kp); ph_ada(p, smem); } break;
    case 1: { const P p = ldp(kp); ph_prep(p, l, smem); } break;
    case 2: { const P p = ldp(kp); ph_in(p, l, smem); } break;
    case 3: { const P p = ldp(kp); ph_mid(p, l, need, smem); } break;
    case 4: { const P p = ldp(kp); ph_carry(p, l, need); } break;
    case 5: { const P p = ldp(kp); ph_attn(p, l, need, smem); } break;
    case 8: { const P p = ldp(kp); norm_rows(p, p.out, (const float*)(p.ws + OFF_XC), need ? MALL : MLAT, p.norm_mlp + l * 1024, (const float*)(p.ws + OFF_MOD) + (size_t)l * 9 * 6144, 3, 4); } break;
    case 11: { const P p = ldp(kp); ph_final(p); } break;
    default: break;
  }
}

__global__ void __launch_bounds__(512) mega(P p_unused) {
  __shared__ __attribute__((aligned(16))) char smem_all[163840];
  char* smem = smem_all;
  KP kp = (KP)__builtin_amdgcn_kernarg_segment_ptr();
  cg::grid_group grid = cg::this_grid();
  unsigned* xb_st = (unsigned*)(smem_all + 163824);
  if (threadIdx.x == 0) { xb_st[0] = 0u; xb_st[1] = 0u; }
  __syncthreads();
  unsigned* barw; { const P p0 = ldp(kp); barw = (unsigned*)(p0.ws + OFF_BAR); }
  const XcdBarrier XB = xcd_barrier_post(barw, (volatile LAS unsigned*)xb_st);
  run_phase(kp, 0, 0, smem);
  grid.sync();
  for (int l = 0; l < 2; ++l)
    for (int ph = 1; ph <= 10; ++ph) {
      for (int rep_ = 0; rep_ < 1 + DUPN(ph); ++rep_) {
        const int nj = n_jobs(ph);
        if (nj == 0 || ph == 2 || ph == 3) run_phase(kp, ph, l, smem);
        for (int j = 0; j < nj; ++j) { const pg8::Job jb = get_job(kp, ph, l, j); run_job(smem, jb); }
        xcd_barrier(XB);
      }
    }
  run_phase(kp, 11, 0, smem);
}

extern "C" void kernel_launch(void* const* d_in, const int* in_sizes, int n_in, void* d_out, int out_size, void* d_ws, size_t ws_size, hipStream_t stream) {
  static int grid_blocks = 0;
  if (!grid_blocks) {
    int dev = 0, cus = 0, per_cu = 0;
    hipGetDevice(&dev);
    hipDeviceGetAttribute(&cus, hipDeviceAttributeMultiprocessorCount, dev);
    hipOccupancyMaxActiveBlocksPerMultiprocessor(&per_cu, mega, 512, 0);
    if (per_cu > 1) per_cu = 1;
    grid_blocks = cus * per_cu;
  }
  if (ws_size < WS_TOTAL) fprintf(stderr, "workspace too small: %zu < %zu\n", ws_size, (size_t)WS_TOTAL);
  (void)hipMemsetAsync((char*)d_ws + OFF_BAR, 0, BAR_BYTES, stream);
  P p{};
  const float** f = (const float**)&p;
  for (int i = 0; i < 29; ++i) f[i] = (const float*)d_in[i];
  p.out = (float*)d_out; p.ws = (char*)d_ws;
  void* args[] = {&p};
  hipError_t e = hipLaunchCooperativeKernel((void*)mega, dim3(grid_blocks), dim3(512), args, 0, stream);
  if (e != hipSuccess) fprintf(stderr, "cooperative launch failed: %s (grid %d)\n", hipGetErrorString(e), grid_blocks);
}
```

```cpp
#include <hip/hip_runtime.h>
#include <hip/hip_cooperative_groups.h>
#include <stdint.h>
#include <cstdio>
namespace cg = cooperative_groups;

typedef unsigned short bf16_t;
typedef short bf16x8 __attribute__((ext_vector_type(8)));
typedef float f32x4 __attribute__((ext_vector_type(4)));
typedef unsigned u32x4 __attribute__((ext_vector_type(4)));
typedef unsigned u32x2 __attribute__((ext_vector_type(2)));
#define DEV __device__ __forceinline__

constexpr int MLAT = 32768, MCTX = 2048, MALL = 34816;
constexpr int LDZ = 2816, ZQ = 0, ZKV = 256, ZCB = 512, ZCC = 1024, ZCX = 1536, ZS5 = 2048, ZPE = 2560;
constexpr int ZCV = 0, ZAO = 512, ZS5A = 1024, ZMG = 1536;
constexpr int NKEY = 4352;
constexpr int NCH = 1088;
constexpr float EPSN = 1e-6f;

constexpr size_t OFF_MOD  = 0;
constexpr size_t OFF_ROPE = OFF_MOD + 2ull * 9 * 6144 * 4;
constexpr size_t OFF_KTAB = OFF_ROPE + 4096;
constexpr size_t OFF_XC   = OFF_KTAB + 32ull * 2 * 32 * 256 * 4;
constexpr size_t OFF_S    = OFF_XC + 2048ull * 1024 * 4;
constexpr size_t OFF_WIN  = OFF_S + (size_t)NCH * 8192 * 2;
constexpr size_t OFF_WUQ  = OFF_WIN + 5888ull * 1024 * 2;
constexpr size_t OFF_WUKV = OFF_WUQ + 768ull * 256 * 2;
constexpr size_t OFF_WO   = OFF_WUKV + 1024ull * 256 * 2;
constexpr size_t OFF_WC   = OFF_WO + 1024ull * 512 * 2;
constexpr size_t OFF_WGLU = OFF_WC + 1024ull * 512 * 2;
constexpr size_t OFF_WOUT = OFF_WGLU + 2048ull * 512 * 2;
constexpr size_t OFF_W1   = OFF_WOUT + 1024ull * 1024 * 2;
constexpr size_t OFF_W2   = OFF_W1 + 4096ull * 1024 * 2;
constexpr size_t OFF_MT   = OFF_W2 + 1024ull * 4096 * 2;
constexpr size_t OFF_ET   = OFF_MT + 32ull * 512 * 512 * 2;
constexpr size_t OFF_FT   = OFF_ET + 32ull * 512 * 256 * 2;
constexpr size_t OFF_XN   = OFF_FT + 32ull * 256 * 512 * 2;
constexpr size_t OFF_Z    = OFF_XN + (size_t)MALL * 1024 * 2;
constexpr size_t OFF_Q    = OFF_Z + (size_t)MALL * LDZ * 2;
constexpr size_t OFF_K    = OFF_Q + 64ull * NKEY * 96 * 2;
constexpr size_t OFF_VT   = OFF_K + 64ull * NKEY * 96 * 2;
constexpr size_t WS_NEED  = OFF_VT + 64ull * 64 * NKEY * 2;
constexpr size_t OFF_T    = OFF_Q;
constexpr size_t OFF_MG   = OFF_T + (size_t)MALL * 1024 * 2;
static_assert(OFF_MG + (size_t)MALL * 1024 * 2 <= WS_NEED, "merge temporaries overflow");
constexpr size_t OFF_BAR  = WS_NEED;
constexpr size_t BAR_BYTES = 3456 * 4;
constexpr size_t OFF_SSQ  = OFF_BAR + 16384;
constexpr size_t WS_TOTAL = OFF_SSQ + (size_t)MALL * 2 * 4;
static_assert((size_t)MALL * 4096 * 2 <= OFF_VT - OFF_Z, "H alias too big");

#ifdef DUP_PH
#define DUPN(ph) ((ph) == DUP_PH ? 1 : 0)
#else
#define DUPN(ph) 0
#endif
struct P {
  const float *x, *c, *ctx, *c_ctx, *ada_w, *ada_b, *norm_mix, *w_in, *q_norm, *w_uq, *kv_norm, *w_ukv, *w_o, *conv_w, *conv_w_out,
      *a_re, *a_im, *log_dt, *b_re, *b_im, *c_re, *c_im, *s5_d, *w_glu, *w_out, *norm_mlp, *w1, *w2, *norm_final;
  float* out; char* ws;
};

DEV int get_tid() { int t; asm volatile("v_mov_b32 %0, %1" : "=v"(t) : "v"((int)(threadIdx.x & 255))); return t; }
DEV int vbsel() { return __builtin_amdgcn_readfirstlane((int)(threadIdx.x >> 8)); }
DEV int vbid() { return (int)blockIdx.x * 2 + vbsel(); }
DEV int vgrid() { return (int)gridDim.x * 2; }
DEV int vboff() { return vbsel() * 81920; }
DEV int rounds_of(int total) { const int vg = vgrid(); int r = 0; for (int t = 0; t < total; t += vg) ++r; return r; }
typedef const __attribute__((address_space(4))) P* KP;
#if defined(__HIP_DEVICE_COMPILE__)
DEV P ldp(KP k) { asm volatile("" : "+s"(k)); return *k; }
#else
DEV P ldp(KP k) { return P{}; }
#endif
DEV unsigned pk_bf16(float lo, float hi) { unsigned r; asm("v_cvt_pk_bf16_f32 %0, %1, %2" : "=v"(r) : "v"(lo), "v"(hi)); return r; }
DEV float bflo(unsigned w) { return __uint_as_float(w << 16); }
DEV float bfhi(unsigned w) { return __uint_as_float(w & 0xffff0000u); }
DEV float sigm(float x) { return 1.0f / (1.0f + __expf(-x)); }
DEV float wave_sum(float v) {
#pragma unroll
  for (int o = 32; o > 0; o >>= 1) v += __shfl_xor(v, o);
  return v;
}
DEV void sincos_d(double th, float& s, float& c) {
  double n = rint(th * 0.15915494309189535);
  double r = fma(-n, 6.283185307179586, th);
  float rev = (float)(r * 0.15915494309189535);
  s = __builtin_amdgcn_sinf(rev); c = __builtin_amdgcn_cosf(rev);
}

struct ASrc { const bf16_t* p; long lda; int row0, rmax, segshift; long segstride; };

template <int WN, bool SWAP>
DEV void gemm_core(f32x4 (&acc)[4][WN], const ASrc& a, const bf16_t* __restrict__ Bt, long ldb, int K, char* smem) {
  constexpr int BN = 32 * WN, NBL = BN / 32;
  constexpr int ABYTES = 16384, STAGE = ABYTES + BN * 128;
  const int tid = get_tid(), lane = tid & 63, wid = tid >> 6, wm = wid >> 1, wn = wid & 1;
  const int l15 = lane & 15, lq = lane >> 4;
  const int lrow = tid >> 3, lc = tid & 7;
  const int segmask = (1 << a.segshift) - 1;
  const bf16_t* ap[4];
#pragma unroll
  for (int i = 0; i < 4; ++i) { int r = a.row0 + lrow + 32 * i; r = r < a.rmax ? r : a.rmax - 1; ap[i] = a.p + (long)r * a.lda; }
  const bf16_t* bp = Bt + (long)lrow * ldb + lc * 8;
  const int vo = vboff();
  const int wofs = vo + lrow * 128 + ((lc ^ ((lrow >> 1) & 7)) << 4);
  u32x4 ra0[4], rb0[NBL], ra1[4], rb1[NBL];
  const int aoff = vo + (wm * 64 + l15) * 128, boff = vo + ABYTES + (wn * 16 * WN + l15) * 128, sx = l15 >> 1;
  int nk = K >> 6; asm volatile("" : "+s"(nk));
#define GLOAD(RA, RB, kt) { const int k_ = (kt) * 64 + lc * 8; const long ko_ = (long)(k_ >> a.segshift) * a.segstride + (k_ & segmask); \
    _Pragma("unroll") for (int i = 0; i < 4; ++i) RA[i] = *(const u32x4*)(ap[i] + ko_); \
    _Pragma("unroll") for (int i = 0; i < NBL; ++i) RB[i] = *(const u32x4*)(bp + (long)(32 * i) * ldb + (kt) * 64); }
#define LSTORE(RA, RB, buf) { char* s_ = smem + (buf) * STAGE; \
    _Pragma("unroll") for (int i = 0; i < 4; ++i) *(u32x4*)(s_ + wofs + i * 4096) = RA[i]; \
    _Pragma("unroll") for (int i = 0; i < NBL; ++i) *(u32x4*)(s_ + ABYTES + wofs + i * 4096) = RB[i]; }
#define BAR() { asm volatile("s_waitcnt lgkmcnt(0)" ::: "memory"); __builtin_amdgcn_s_barrier(); asm volatile("" ::: "memory"); }
#define COMPUTE(buf) { const char* s = smem + (buf) * STAGE; \
    _Pragma("unroll") for (int ks = 0; ks < 2; ++ks) { \
      const int co = ((ks * 4 + lq) ^ sx) << 4; \
      bf16x8 af[4], bfr[WN]; \
      _Pragma("unroll") for (int i = 0; i < 4; ++i) af[i] = *(const bf16x8*)(s + aoff + i * 2048 + co); \
      _Pragma("unroll") for (int j = 0; j < WN; ++j) bfr[j] = *(const bf16x8*)(s + boff + j * 2048 + co); \
      _Pragma("unroll") for (int i = 0; i < 4; ++i) \
        _Pragma("unroll") for (int j = 0; j < WN; ++j) \
          acc[i][j] = SWAP ? __builtin_amdgcn_mfma_f32_16x16x32_bf16(bfr[j], af[i], acc[i][j], 0, 0, 0) \
                           : __builtin_amdgcn_mfma_f32_16x16x32_bf16(af[i], bfr[j], acc[i][j], 0, 0, 0); \
    } }
  __builtin_amdgcn_sched_barrier(0);
  GLOAD(ra0, rb0, 0); GLOAD(ra1, rb1, 1); LSTORE(ra0, rb0, 0); BAR();
#pragma nounroll
  for (int kt = 0; kt < nk; kt += 2) {
    if (kt + 2 < nk) GLOAD(ra0, rb0, kt + 2);
    COMPUTE(0);
    LSTORE(ra1, rb1, 1);
    BAR();
    if (kt + 3 < nk) GLOAD(ra1, rb1, kt + 3);
    COMPUTE(1);
    if (kt + 2 < nk) LSTORE(ra0, rb0, 0);
    BAR();
  }
#undef GLOAD
#undef LSTORE
#undef COMPUTE
#undef BAR
  __builtin_amdgcn_sched_barrier(0);
}
template <int WN> DEV void zero_acc(f32x4 (&acc)[4][WN]) {
#pragma unroll
  for (int i = 0; i < 4; ++i)
#pragma unroll
    for (int j = 0; j < WN; ++j) acc[i][j] = (f32x4){0.f, 0.f, 0.f, 0.f};
}
DEV ASrc asrc(const bf16_t* p, long lda, int row0, int rmax) { ASrc a; a.p = p; a.lda = lda; a.row0 = row0; a.rmax = rmax; a.segshift = 30; a.segstride = 0; return a; }

DEV bool tile_get(int r, int nM, int nN, int& mt, int& nt) {
  const int nslots = vgrid() >> 3; int q = (r * 8 + ((int)blockIdx.x & 7)) * nslots + ((int)blockIdx.x >> 3) * 2 + vbsel();
  const bool valid = q < nM * nN; q = valid ? q : nM * nN - 1;
  const int band = q / (8 * nN), rem = q - band * 8 * nN;
  nt = rem >> 3; mt = band * 8 + (rem & 7);
  return valid;
}
DEV int tile_rounds(int total) { return rounds_of(total); }


namespace pg8 {
#define PG8_LAS __attribute__((address_space(3)))
constexpr int BM = 256, BK = 64, HALF = 128, HTB = HALF * BK * 2, STAGE_BYTES = 8 * HTB, NXCD = 8, WGM = 8;
DEV int lds_byte(int r, int c) { const int st = (r >> 4) * 2 + (c >> 5), rr = r & 15, cc = c & 31, ob = rr * 64 + cc * 2; return st * 1024 + (ob ^ (((ob >> 9) & 1) << 5)); }
DEV void stage_rc(int b, int& R, int& C) { const int st = b / 1024, sb = b % 1024, swz = sb ^ (((sb >> 9) & 1) << 5); R = (st >> 1) * 16 + swz / 64; C = (st & 1) * 32 + (swz % 64) / 2; }
DEV int perm32(int rho) { const int n = rho >> 4, i = rho & 15; return 8 * (i >> 2) + 4 * n + (i & 3); }
struct Unit { int pm, pn; };
struct Gemm { const bf16_t* A; const bf16_t* Bt; long lda; int M, N, K; long segstride; long pnstrideA; };
struct StaticOrder {
  int nM, nN, nwg, G, c;
  DEV void init(int M, int N, int G_, int c_) { nM = M / BM; nN = N / BM; nwg = nM * nN; G = G_; c = c_; }
  DEV bool next(int i, Unit& u) const {
    const long L = (long)i * G + c; if (L >= nwg) return false;
    int wgid = (int)L; { const int q = nwg / NXCD, r = nwg % NXCD, xcd = wgid % NXCD, off = wgid / NXCD; wgid = (xcd < r ? xcd * (q + 1) : r * (q + 1) + (xcd - r) * q) + off; }
    const int nig = WGM * nN, gid = wgid / nig, fm = gid * WGM, gsz = (nM - fm) < WGM ? (nM - fm) : WGM;
    u.pm = fm + ((wgid % nig) % gsz); u.pn = (wgid % nig) / gsz; return true;
  }
};
template <class Epi>
DEV void gemm_phase(PG8_LAS unsigned char* lds, const Gemm g, const StaticOrder& S, const Epi& E) {
  int tid; asm volatile("v_mov_b32 %0, %1" : "=v"(tid) : "v"((int)threadIdx.x));
  const int wid = __builtin_amdgcn_readfirstlane(tid >> 6), lane = tid & 63, wr = wid >> 2, wc = wid & 3, fr = lane & 15, fq = lane >> 4;
  const int K = g.K, nt = K / BK;
  unsigned voffA[2], voffB[2];
#pragma unroll
  for (int i = 0; i < 2; ++i) { int R, C; stage_rc(tid * 16 + i * 8192, R, C); const int Rb = Epi::PERM ? ((R & ~31) + perm32(R & 31)) : R;
    voffA[i] = (unsigned)((long)R * g.lda + (g.segstride ? (long)(C >> 4) * g.segstride + (C & 15) : (long)C)) * 2u; voffB[i] = (unsigned)(Rb * K + C) * 2u; }
  const size_t kstep = (size_t)(BK * 2);
  const size_t kstepA = g.segstride ? (size_t)(BK / 16) * g.segstride * 2 : kstep;
  const size_t pnA = (size_t)g.pnstrideA * 2;
  const size_t hstepA = (size_t)HALF * g.lda * 2, hstepB = (size_t)HALF * K * 2;
  const size_t tstepA = 2 * hstepA, tstepB = 2 * hstepB;
  const unsigned ldsw = (unsigned)wid * 1024u;
  const int aoff = lds_byte(wr * 64 + fr, fq * 8), boff = lds_byte(wc * 32 + fr, fq * 8);
#define PG8_SA(b, h) (((b) * 2 + (h)) * HTB)
#define PG8_SB(b, h) ((4 + (b) * 2 + (h)) * HTB)
#define PG8_STAGE(bufoff, gbase, voff) do { _Pragma("unroll") for (int _i = 0; _i < 2; ++_i) \
    __builtin_amdgcn_global_load_lds((const unsigned*)((const char*)(gbase) + (voff)[_i]), (PG8_LAS unsigned*)(lds + (bufoff) + ldsw + _i * 8192), 16, 0, 0); } while (0)
#define PG8_LDA(dst, b, h) do { _Pragma("unroll") for (int m = 0; m < 4; ++m) _Pragma("unroll") for (int k = 0; k < 2; ++k) dst[m][k] = *(const PG8_LAS bf16x8*)(lds + PG8_SA(b, h) + aoff + m * 2048 + k * 1024); } while (0)
#define PG8_LDB(dst, b, h) do { _Pragma("unroll") for (int n = 0; n < 2; ++n) _Pragma("unroll") for (int k = 0; k < 2; ++k) dst[n][k] = *(const PG8_LAS bf16x8*)(lds + PG8_SB(b, h) + boff + n * 2048 + k * 1024); } while (0)
#define PG8_MMA(ai, bj, At, Bt) do { __builtin_amdgcn_s_setprio(1); _Pragma("unroll") for (int m = 0; m < 4; ++m) _Pragma("unroll") for (int n = 0; n < 2; ++n) _Pragma("unroll") for (int k = 0; k < 2; ++k) \
    acc[ai][bj][m][n] = __builtin_amdgcn_mfma_f32_16x16x32_bf16(Bt[n][k], At[m][k], acc[ai][bj][m][n], 0, 0, 0); __builtin_amdgcn_s_setprio(0); } while (0)
#define PG8_WAIT_V(n) asm volatile("s_waitcnt vmcnt(" #n ")" ::: "memory")
#define PG8_WAIT_L(n) asm volatile("s_waitcnt lgkmcnt(" #n ")" ::: "memory")
#define PG8_BAR __builtin_amdgcn_s_barrier()
#define PG8_SCHED __builtin_amdgcn_sched_barrier(0)
  Unit cur, nxt; int ui = 0;
  if (!S.next(0, cur)) return;
  f32x4 acc[2][2][4][2];
#pragma unroll
  for (int a = 0; a < 2; ++a)
#pragma unroll
    for (int b = 0; b < 2; ++b)
#pragma unroll
      for (int m = 0; m < 4; ++m)
#pragma unroll
        for (int n = 0; n < 2; ++n) acc[a][b][m][n] = (f32x4){0.f, 0.f, 0.f, 0.f};
  bf16x8 At[4][2], B0[2][2], B1[2][2];
  const char* cA = (const char*)g.A + (size_t)cur.pm * tstepA + (size_t)cur.pn * pnA; const char* cB = (const char*)g.Bt + (size_t)cur.pn * tstepB;
  PG8_STAGE(PG8_SB(0, 0), cB, voffB); PG8_STAGE(PG8_SB(0, 1), cB + hstepB, voffB); PG8_STAGE(PG8_SA(0, 0), cA, voffA); PG8_STAGE(PG8_SA(0, 1), cA + hstepA, voffA);
  if (wr == 1) PG8_BAR;
  PG8_WAIT_V(2); PG8_BAR;
  PG8_STAGE(PG8_SB(1, 0), cB + kstep, voffB); PG8_STAGE(PG8_SA(1, 0), cA + kstepA, voffA); PG8_STAGE(PG8_SB(1, 1), cB + hstepB + kstep, voffB);
  PG8_WAIT_V(6); PG8_BAR;
  for (;;) {
    const bool has_next = S.next(ui + 1, nxt);
    const char* nA = has_next ? (const char*)g.A + (size_t)nxt.pm * tstepA + (size_t)nxt.pn * pnA : cA; const char* nB = has_next ? (const char*)g.Bt + (size_t)nxt.pn * tstepB : cB;
    for (int t = 0; t < nt; t += 2) {
      const bool last = (t == nt - 2);
      const char* a1 = cA + (size_t)(t + 1) * kstepA;
      const char* a2 = last ? nA : cA + (size_t)(t + 2) * kstepA; const char* b2 = last ? nB : cB + (size_t)(t + 2) * kstep;
      const char* a3 = a2 + kstepA; const char* b3 = b2 + kstep;
      PG8_LDB(B0, 0, 0); PG8_LDB(B1, 0, 1); PG8_SCHED; PG8_LDA(At, 0, 0); PG8_STAGE(PG8_SA(1, 1), a1 + hstepA, voffA);
      PG8_WAIT_V(8); PG8_WAIT_L(0); PG8_BAR; PG8_MMA(0, 0, At, B0); PG8_MMA(0, 1, At, B1); PG8_BAR; PG8_SCHED;
      PG8_LDA(At, 0, 1); PG8_STAGE(PG8_SB(0, 0), b2, voffB); PG8_STAGE(PG8_SB(0, 1), b2 + hstepB, voffB); PG8_STAGE(PG8_SA(0, 0), a2, voffA);
      PG8_WAIT_V(8); PG8_WAIT_L(0); PG8_BAR; PG8_MMA(1, 0, At, B0); PG8_MMA(1, 1, At, B1); PG8_BAR; PG8_SCHED;
      PG8_LDB(B0, 1, 0); PG8_LDB(B1, 1, 1); PG8_SCHED; PG8_LDA(At, 1, 0); PG8_STAGE(PG8_SA(0, 1), a2 + hstepA, voffA);
      PG8_WAIT_V(8); PG8_WAIT_L(0); PG8_BAR; PG8_MMA(0, 0, At, B0); PG8_MMA(0, 1, At, B1); PG8_BAR; PG8_SCHED;
      PG8_LDA(At, 1, 1); PG8_STAGE(PG8_SB(1, 0), b3, voffB); PG8_STAGE(PG8_SB(1, 1), b3 + hstepB, voffB); PG8_STAGE(PG8_SA(1, 0), a3, voffA);
      PG8_WAIT_V(8); PG8_WAIT_L(0); PG8_BAR; PG8_MMA(1, 0, At, B0); PG8_MMA(1, 1, At, B1); PG8_BAR; PG8_SCHED;
    }
    if (wr == 0) PG8_BAR;
    E(acc, cur, wr, wc, fr, fq);
    if (!has_next) break;
#pragma unroll
    for (int a = 0; a < 2; ++a)
#pragma unroll
      for (int b = 0; b < 2; ++b)
#pragma unroll
        for (int m = 0; m < 4; ++m)
#pragma unroll
          for (int n = 0; n < 2; ++n) acc[a][b][m][n] = (f32x4){0.f, 0.f, 0.f, 0.f};
    cur = nxt; cA = nA; cB = nB; ++ui;
    if (wr == 1) PG8_BAR;
  }
  PG8_WAIT_V(0);
  PG8_BAR;
#undef PG8_SA
#undef PG8_SB
#undef PG8_STAGE
#undef PG8_LDA
#undef PG8_LDB
#undef PG8_MMA
#undef PG8_WAIT_V
#undef PG8_WAIT_L
#undef PG8_BAR
#undef PG8_SCHED
}
struct Job { const bf16_t* A; const bf16_t* Bt; long lda; int M, N, K, mode; bf16_t* O; long ldc; const bf16_t* T; const float* slat; const float* sctx; float* dlat; float* dctx; const float* modg;
             long segstride, pnstrideA; int rows; float* ssq; bf16_t* O2; };
struct EpiRT {
  static constexpr bool PERM = true;
  int mode; bf16_t* O; long ldc; const bf16_t* T; const float* slat; const float* sctx; float* dlat; float* dctx; const float* modg; int rows; float* ssq; bf16_t* O2;
  DEV void operator()(const f32x4 (&acc)[2][2][4][2], const Unit& u, int wr, int wc, int fr, int fq) const {
    const int row00 = u.pm * BM + wr * 64 + fr, col00 = u.pn * BM + wc * 32 + 8 * fq;
    if (mode == 5) {
      const bool lat = u.pm * BM < MLAT; const int bi = lat ? (u.pm * BM) >> 12 : 8;
      const float* sb = lat ? slat : sctx - (size_t)MLAT * 1024; float* db = lat ? dlat : dctx - (size_t)MLAT * 1024;
      f32x4 g[2][2];
#pragma unroll
      for (int bj = 0; bj < 2; ++bj) { const float* mg = modg + (size_t)bi * 6144 + col00 + bj * HALF; g[bj][0] = *(const f32x4*)mg; g[bj][1] = *(const f32x4*)(mg + 4); }
#pragma unroll
      for (int ai = 0; ai < 2; ++ai)
#pragma unroll
        for (int mp = 0; mp < 2; ++mp) {
          f32x4 x[4][2];
#pragma unroll
          for (int c = 0; c < 4; ++c) { const float* s = sb + (size_t)(row00 + ai * HALF + (2 * mp + (c >> 1)) * 16) * 1024 + col00 + (c & 1) * HALF; x[c][0] = *(const f32x4*)s; x[c][1] = *(const f32x4*)(s + 4); }
#pragma unroll
          for (int c = 0; c < 4; ++c) { float* d = db + (size_t)(row00 + ai * HALF + (2 * mp + (c >> 1)) * 16) * 1024 + col00 + (c & 1) * HALF;
            *(f32x4*)d = x[c][0] + g[c & 1][0] * acc[ai][c & 1][2 * mp + (c >> 1)][0]; *(f32x4*)(d + 4) = x[c][1] + g[c & 1][1] * acc[ai][c & 1][2 * mp + (c >> 1)][1]; }
        }
      return;
    }
    if (mode >= 1 && mode <= 3) {
#pragma unroll
      for (int ai = 0; ai < 2; ++ai)
#pragma unroll
        for (int mp = 0; mp < 2; ++mp) {
          u32x4 tv[4], ov[4];
#pragma unroll
          for (int c = 0; c < 4; ++c) {
            const size_t row = (size_t)(row00 + ai * HALF + (2 * mp + (c >> 1)) * 16); const int col = col00 + (c & 1) * HALF;
            if (mode >= 2) tv[c] = *(const u32x4*)(T + row * 1024 + col);
            if (mode != 2) ov[c] = *(const u32x4*)(O + row * ldc + col);
          }
#pragma unroll
          for (int c = 0; c < 4; ++c) {
            const size_t row = (size_t)(row00 + ai * HALF + (2 * mp + (c >> 1)) * 16); const int col = col00 + (c & 1) * HALF;
            f32x4 v0 = acc[ai][c & 1][2 * mp + (c >> 1)][0], v1 = acc[ai][c & 1][2 * mp + (c >> 1)][1];
#pragma unroll
            for (int r = 0; r < 4; ++r) { v0[r] = sigm(v0[r]); v1[r] = sigm(v1[r]); }
            if (mode >= 2) { const u32x4 t = tv[c];
              v0[0] *= bflo(t.x); v0[1] *= bfhi(t.x); v0[2] *= bflo(t.y); v0[3] *= bfhi(t.y); v1[0] *= bflo(t.z); v1[1] *= bfhi(t.z); v1[2] *= bflo(t.w); v1[3] *= bfhi(t.w); }
            if (mode == 1) { const u32x4 o = ov[c];
              v0[0] *= bflo(o.x); v0[1] *= bfhi(o.x); v0[2] *= bflo(o.y); v0[3] *= bfhi(o.y); v1[0] *= bflo(o.z); v1[1] *= bfhi(o.z); v1[2] *= bflo(o.w); v1[3] *= bfhi(o.w); }
            if (mode == 3) { const u32x4 o = ov[c];
              v0[0] += bflo(o.x); v0[1] += bfhi(o.x); v0[2] += bflo(o.y); v0[3] += bfhi(o.y); v1[0] += bflo(o.z); v1[1] += bfhi(o.z); v1[2] += bflo(o.w); v1[3] += bfhi(o.w); }
            *(u32x4*)(O + row * ldc + col) = (u32x4){pk_bf16(v0[0], v0[1]), pk_bf16(v0[2], v0[3]), pk_bf16(v1[0], v1[1]), pk_bf16(v1[2], v1[3])};
          }
        }
      return;
    }
    float rsv[2][4];
    if (mode >= 6) {
#pragma unroll
      for (int ai = 0; ai < 2; ++ai)
#pragma unroll
        for (int m = 0; m < 4; ++m) { const int row = row00 + ai * HALF + m * 16; rsv[ai][m] = row < rows ? ssq[(size_t)row * 2 + (mode - 6)] : 1.0f; }
#pragma unroll
      for (int ai = 0; ai < 2; ++ai)
#pragma unroll
        for (int m = 0; m < 4; ++m) rsv[ai][m] = rsqrtf(rsv[ai][m] * (1.0f / 256.0f) + EPSN);
    }
#pragma unroll
    for (int ai = 0; ai < 2; ++ai)
#pragma unroll
      for (int m = 0; m < 4; ++m) {
        const int row = row00 + ai * HALF + m * 16;
#pragma unroll
        for (int bj = 0; bj < 2; ++bj) {
          const int col = col00 + bj * HALF;
          f32x4 v0 = acc[ai][bj][m][0], v1 = acc[ai][bj][m][1];
          if (mode >= 6) {
            if (row < rows) {
              int bb, tok; const bool lat = row < MLAT;
              if (lat) { bb = row >> 12; tok = row & 4095; } else { const int cr = row - MLAT; bb = cr >> 8; tok = cr & 255; }
              if (mode == 6) {
                const float rs = rsv[ai][m] * (0.10206207261596577f * 1.4426950408889634f);
                const int h = col / 96, d = col - h * 96;
                v0 = v0 * rs; v1 = v1 * rs;
                if (d >= 64 && lat) {
                  const int pp = d - 64, a = pp >> 4, f0 = (pp & 15) >> 1, pos = a ? (tok & 63) : (tok >> 6);
                  const float pr = (float)pos * 0.15915494309189535f;
                  const float i0 = f0 ? 0.01f : 1.0f, i1 = f0 ? 0.0031622776601683794f : 0.31622776601683794f, i2 = f0 ? 0.001f : 0.1f, i3 = f0 ? 0.00031622776601683794f : 0.031622776601683794f;
                  const float2 c0 = make_float2(__builtin_amdgcn_cosf(pr * i0), __builtin_amdgcn_sinf(pr * i0)), c1 = make_float2(__builtin_amdgcn_cosf(pr * i1), __builtin_amdgcn_sinf(pr * i1));
                  const float2 c2 = make_float2(__builtin_amdgcn_cosf(pr * i2), __builtin_amdgcn_sinf(pr * i2)), c3 = make_float2(__builtin_amdgcn_cosf(pr * i3), __builtin_amdgcn_sinf(pr * i3));
                  const float t0 = v0[0] * c0.x - v0[1] * c0.y, t1 = v0[1] * c0.x + v0[0] * c0.y, t2 = v0[2] * c1.x - v0[3] * c1.y, t3 = v0[3] * c1.x + v0[2] * c1.y;
                  const float t4 = v1[0] * c2.x - v1[1] * c2.y, t5 = v1[1] * c2.x + v1[0] * c2.y, t6 = v1[2] * c3.x - v1[3] * c3.y, t7 = v1[3] * c3.x + v1[2] * c3.y;
                  v0 = (f32x4){t0, t1, t2, t3}; v1 = (f32x4){t4, t5, t6, t7};
                }
                const int qrow = lat ? tok : 4096 + tok;
                *(u32x4*)(O + ((size_t)(bb * 8 + h) * NKEY + qrow) * 96 + d) = (u32x4){pk_bf16(v0[0], v0[1]), pk_bf16(v0[2], v0[3]), pk_bf16(v1[0], v1[1]), pk_bf16(v1[2], v1[3])};
              } else {
                const float rs = rsv[ai][m];
                const int h = col >> 7, dd = col & 127, key = lat ? 256 + tok : tok;
                v0 = v0 * rs; v1 = v1 * rs;
                const unsigned w0 = pk_bf16(v0[0], v0[1]), w1 = pk_bf16(v0[2], v0[3]), w2 = pk_bf16(v1[0], v1[1]), w3 = pk_bf16(v1[2], v1[3]);
                if (dd < 64) {
                  *(u32x4*)(O + ((size_t)(bb * 8 + h) * NKEY + key) * 96 + dd) = (u32x4){w0, w1, w2, w3};
                } else {
                  const int tt = key & 31, pos = ((tt >> 2) & 3) * 8 + (tt >> 4) * 4 + (tt & 3);
                  bf16_t* vp = O2 + ((size_t)(bb * 8 + h) * 64 + (dd - 64)) * NKEY + (key & ~31) + pos;
                  vp[0] = (bf16_t)(w0 & 0xffff); vp[NKEY] = (bf16_t)(w0 >> 16); vp[2 * NKEY] = (bf16_t)(w1 & 0xffff); vp[3 * NKEY] = (bf16_t)(w1 >> 16);
                  vp[4 * NKEY] = (bf16_t)(w2 & 0xffff); vp[5 * NKEY] = (bf16_t)(w2 >> 16); vp[6 * NKEY] = (bf16_t)(w3 & 0xffff); vp[7 * NKEY] = (bf16_t)(w3 >> 16);
                }
              }
            }
          } else {
            if (mode == 4) {
#pragma unroll
              for (int r = 0; r < 4; ++r) { const float a = fmaxf(v0[r], 0.f), b = fmaxf(v1[r], 0.f); v0[r] = a * a; v1[r] = b * b; }
            }
            if (row < rows) *(u32x4*)(O + (size_t)row * ldc + col) = (u32x4){pk_bf16(v0[0], v0[1]), pk_bf16(v0[2], v0[3]), pk_bf16(v1[0], v1[1]), pk_bf16(v1[2], v1[3])};
          }
        }
        if (mode == 0 && ssq != nullptr && u.pn < 2) {
          float s = 0.f;
#pragma unroll
          for (int bj = 0; bj < 2; ++bj)
#pragma unroll
            for (int n = 0; n < 2; ++n) { const f32x4 v = acc[ai][bj][m][n]; s += v[0] * v[0] + v[1] * v[1] + v[2] * v[2] + v[3] * v[3]; }
          s += __shfl_xor(s, 16); s += __shfl_xor(s, 32);
          if (fq == 0) atomicAdd(ssq + (size_t)row * 2 + u.pn, s);
        }
      }
  }
};
}
DEV void run_job(char* smem_base, const pg8::Job& j) {
  pg8::Gemm g; g.A = j.A; g.Bt = j.Bt; g.lda = j.lda; g.M = j.M; g.N = j.N; g.K = j.K; g.segstride = j.segstride; g.pnstrideA = j.pnstrideA;
  pg8::StaticOrder S; S.init(j.M, j.N, (int)gridDim.x, (int)blockIdx.x);
  pg8::EpiRT E; E.mode = j.mode; E.O = j.O; E.ldc = j.ldc; E.T = j.T; E.slat = j.slat; E.sctx = j.sctx; E.dlat = j.dlat; E.dctx = j.dctx; E.modg = j.modg; E.rows = j.rows; E.ssq = j.ssq; E.O2 = j.O2;
  pg8::gemm_phase<pg8::EpiRT>((PG8_LAS unsigned char*)smem_base, g, S, E);
}

DEV void ph_ada(const P& p, char* smem) {
  const int tid = get_tid();
  float* mod = (float*)(p.ws + OFF_MOD);
  if (vbid() < 192) {
    smem += vboff();
    float* sc = (float*)smem;
    for (int i = tid; i < 9 * 1024; i += 256) { const int bi = i >> 10, k = i & 1023; const float v = bi < 8 ? p.c[bi * 1024 + k] : p.c_ctx[k]; sc[i] = v * sigm(v); }
    __syncthreads();
    float* red = (float*)(smem + 36864);
    for (int item = vbid(); item < 192; item += vgrid()) {
      const int l = item / 96, n0 = (item % 96) * 64, nn = tid & 63, kq = tid >> 6;
      float acc[9];
#pragma unroll
      for (int b = 0; b < 9; ++b) acc[b] = 0.f;
      const float* w = p.ada_w + (size_t)l * 1024 * 6144 + n0 + nn;
      for (int k = kq * 256; k < kq * 256 + 256; ++k) {
        const float wv = w[(size_t)k * 6144];
#pragma unroll
        for (int b = 0; b < 9; ++b) acc[b] += sc[b * 1024 + k] * wv;
      }
#pragma unroll
      for (int b = 0; b < 9; ++b) red[(kq * 9 + b) * 64 + nn] = acc[b];
      __syncthreads();
      for (int e = tid; e < 9 * 64; e += 256) {
        const int b = e >> 6, n = e & 63;
        const float v = red[(0 * 9 + b) * 64 + n] + red[(1 * 9 + b) * 64 + n] + red[(2 * 9 + b) * 64 + n] + red[(3 * 9 + b) * 64 + n];
        mod[((size_t)l * 9 + b) * 6144 + n0 + n] = v + p.ada_b[l * 6144 + n0 + n];
      }
      __syncthreads();
    }
  } else if (vbid() == 192) {
    float2* rope = (float2*)(p.ws + OFF_ROPE);
    for (int e = tid; e < 512; e += 256) {
      const int pos = e >> 3, f = e & 7;
      const float inv = exp2f(-(float)f * 0.125f * 13.287712379549449f);
      float s, c; sincos_d((double)((float)pos * inv), s, c);
      rope[e] = make_float2(c, s);
    }
  }
}

DEV int map_col(int mode, int n) {
  if (mode == 0) return n;
  if (mode == 1) {
    if (n < 512) return n;
    if (n < 2560) return n + 32;
    if (n < 2592) return 512 + (n - 2560);
    if (n < 2816) return -1;
    return 2592 + (n - 2816);
  }
  if (mode == 2) {
    const int tile = n >> 7, nb = n & 127, wn = nb >> 6, j = (nb >> 4) & 3, cc = nb & 15;
    return (j < 2) ? tile * 64 + wn * 32 + j * 16 + cc : 1024 + tile * 64 + wn * 32 + (j - 2) * 16 + cc;
  }
  const int h = n / 96, d = n % 96;
  if (d < 64) return n;
  const int pp = d - 64, a = pp >> 4, f = (pp & 15) >> 1, half = pp & 1;
  return h * 96 + 64 + a * 16 + half * 8 + f;
}
DEV void cvt_tile(const float* __restrict__ src, int K, int Nsrc, bf16_t* __restrict__ dst, int mode, const float* __restrict__ gain, int nt, int kt, char* smem) {
  float* tile = (float*)smem + (vboff() >> 2);
  const int tid = get_tid();
  const int n0 = nt * 64, k0 = kt * 64;
  if (mode == 3) {
    const int r = tid >> 6, c = tid & 63;
    const int sn = map_col(mode, n0 + c);
#pragma unroll 4
    for (int i = 0; i < 16; ++i) {
      const int k = k0 + r + 4 * i;
      float v = sn >= 0 ? src[(size_t)k * Nsrc + sn] : 0.f;
      if (gain) v *= gain[k];
      tile[(r + 4 * i) * 65 + c] = v;
    }
  } else {
    const int r = tid >> 4, c4 = (tid & 15) * 4;
    const int sn = map_col(mode, n0 + c4);
#pragma unroll
    for (int i = 0; i < 4; ++i) {
      const int k = k0 + r + 16 * i;
      f32x4 v = sn >= 0 ? *(const f32x4*)(src + (size_t)k * Nsrc + sn) : (f32x4){0.f, 0.f, 0.f, 0.f};
      if (gain) v = v * gain[k];
      float* t = tile + (r + 16 * i) * 65 + c4;
      t[0] = v[0]; t[1] = v[1]; t[2] = v[2]; t[3] = v[3];
    }
  }
  __syncthreads();
  {
    const int n = tid >> 2, kp = (tid & 3) * 16;
    u32x4 w0, w1;
    w0.x = pk_bf16(tile[(kp + 0) * 65 + n], tile[(kp + 1) * 65 + n]);   w0.y = pk_bf16(tile[(kp + 2) * 65 + n], tile[(kp + 3) * 65 + n]);
    w0.z = pk_bf16(tile[(kp + 4) * 65 + n], tile[(kp + 5) * 65 + n]);   w0.w = pk_bf16(tile[(kp + 6) * 65 + n], tile[(kp + 7) * 65 + n]);
    w1.x = pk_bf16(tile[(kp + 8) * 65 + n], tile[(kp + 9) * 65 + n]);   w1.y = pk_bf16(tile[(kp + 10) * 65 + n], tile[(kp + 11) * 65 + n]);
    w1.z = pk_bf16(tile[(kp + 12) * 65 + n], tile[(kp + 13) * 65 + n]); w1.w = pk_bf16(tile[(kp + 14) * 65 + n], tile[(kp + 15) * 65 + n]);
    u32x4* d = (u32x4*)(dst + (size_t)(n0 + n) * K + k0 + kp);
    d[0] = w0; d[1] = w1;
  }
  __syncthreads();
}
DEV void cvt_item(const P& p, int l, int it, char* smem) {
  char* ws = p.ws;
  if (it < 1472) { cvt_tile(p.w_in + (size_t)l * 1024 * 5664, 1024, 5664, (bf16_t*)(ws + OFF_WIN), 1, nullptr, it / 16, it % 16, smem); return; }
  it -= 1472;
  if (it < 48) { cvt_tile(p.w_uq + (size_t)l * 256 * 768, 256, 768, (bf16_t*)(ws + OFF_WUQ), 3, p.q_norm + l * 256, it / 4, it % 4, smem); return; }
  it -= 48;
  if (it < 64) { cvt_tile(p.w_ukv + (size_t)l * 256 * 1024, 256, 1024, (bf16_t*)(ws + OFF_WUKV), 0, p.kv_norm + l * 256, it / 4, it % 4, smem); return; }
  it -= 64;
  if (it < 128) { cvt_tile(p.w_o + (size_t)l * 512 * 1024, 512, 1024, (bf16_t*)(ws + OFF_WO), 0, nullptr, it / 8, it % 8, smem); return; }
  it -= 128;
  if (it < 128) { cvt_tile(p.conv_w_out + (size_t)l * 512 * 1024, 512, 1024, (bf16_t*)(ws + OFF_WC), 0, nullptr, it / 8, it % 8, smem); return; }
  it -= 128;
  if (it < 256) { cvt_tile(p.w_glu + (size_t)l * 512 * 2048, 512, 2048, (bf16_t*)(ws + OFF_WGLU), 0, nullptr, it / 8, it % 8, smem); return; }
  it -= 256;
  if (it < 256) { cvt_tile(p.w_out + (size_t)l * 1024 * 1024, 1024, 1024, (bf16_t*)(ws + OFF_WOUT), 0, nullptr, it / 16, it % 16, smem); return; }
  it -= 256;
  if (it < 1024) { cvt_tile(p.w1 + (size_t)l * 1024 * 4096, 1024, 4096, (bf16_t*)(ws + OFF_W1), 0, nullptr, it / 16, it % 16, smem); return; }
  it -= 1024;
  cvt_tile(p.w2 + (size_t)l * 4096 * 1024, 4096, 1024, (bf16_t*)(ws + OFF_W2), 0, nullptr, it / 64, it % 64, smem);
}
constexpr int N_CVT = 4400;

struct Disc { double dt; float are, aim, fre, fim; };
DEV Disc s5_disc(const P& p, int l, int dir, int g, int pp) {
  Disc d; const int gi = (l * 2 + dir) * 32 + g;
  d.dt = (double)expf(p.log_dt[gi]); d.are = p.a_re[gi * 64 + pp]; d.aim = p.a_im[gi * 64 + pp];
  const float mag = __expf((float)(d.dt * (double)d.are)); float sn, cs; sincos_d(d.dt * (double)d.aim, sn, cs);
  const float abr = mag * cs, abi = mag * sn, den = d.are * d.are + d.aim * d.aim, nr = abr - 1.0f, ni = abi;
  d.fre = (nr * d.are + ni * d.aim) / den; d.fim = (ni * d.are - nr * d.aim) / den;
  return d;
}
DEV float2 cpow(const Disc& d, int e) {
  const float mag = __expf((float)((double)e * d.dt * (double)d.are)); float sn, cs; sincos_d((double)e * d.dt * (double)d.aim, sn, cs);
  return make_float2(mag * cs, mag * sn);
}
DEV float2 cmulf(float2 a, float2 b) { return make_float2(a.x * b.x - a.y * b.y, a.x * b.y + a.y * b.x); }

DEV void ktab_item(const P& p, int l, int it, char* smem) {
  const int tid = get_tid();
  const int lb = it & 7, dir = (it >> 3) & 1, g = it >> 4, gi = (l * 2 + dir) * 32 + g;
  smem += vboff();
  float2* CW = (float2*)smem;
  float2* BB = (float2*)(smem + 32768);
  float2* WL = (float2*)(smem + 40960);
  float2* FL = (float2*)(smem + 43008);
  {
    const int li = tid >> 6, pp = tid & 63;
    const Disc d = s5_disc(p, l, dir, g, pp);
    WL[tid] = cpow(d, lb * 4 + li);
    if (li == 0) FL[pp] = make_float2(d.fre, d.fim);
  }
  __syncthreads();
  for (int e = tid; e < 4096; e += 256) {
    const int li = e >> 10, co = (e >> 6) & 15, pp = e & 63;
    const float2 c = make_float2(p.c_re[((size_t)gi * 16 + co) * 64 + pp], p.c_im[((size_t)gi * 16 + co) * 64 + pp]);
    CW[e] = cmulf(c, WL[li * 64 + pp]);
  }
  for (int e = tid; e < 1024; e += 256) {
    const int pp = e >> 4;
    const float2 b = make_float2(p.b_re[(size_t)gi * 1024 + e], p.b_im[(size_t)gi * 1024 + e]);
    BB[e] = cmulf(FL[pp], b);
  }
  __syncthreads();
  float* ktab = (float*)(p.ws + OFF_KTAB);
  const int co = tid >> 4, ci = tid & 15;
#pragma unroll
  for (int li = 0; li < 4; ++li) {
    float acc = 0.f;
    for (int pp = 0; pp < 64; ++pp) { const float2 cw = CW[(li * 16 + co) * 64 + pp], bb = BB[pp * 16 + ci]; acc += cw.x * bb.x - cw.y * bb.y; }
    ktab[(((size_t)g * 2 + dir) * 32 + lb * 4 + li) * 256 + co * 16 + ci] = acc;
  }
  __syncthreads();
}
DEV void ef_item(const P& p, int l, int it) {
  const int g = it >> 4, id = (it & 15) * 256 + get_tid();
  const int t = id & 31, pp = (id >> 5) & 63, dir = id >> 11, gi = (l * 2 + dir) * 32 + g;
  const Disc d = s5_disc(p, l, dir, g, pp);
  const float2 we = cpow(d, dir == 0 ? t + 1 : 32 - t), wf = cpow(d, dir == 0 ? 31 - t : t);
  unsigned* Et = (unsigned*)(p.ws + OFF_ET) + (size_t)g * 512 * 128;
  bf16_t* Ft = (bf16_t*)(p.ws + OFF_FT) + (size_t)g * 256 * 512;
#pragma unroll
  for (int c = 0; c < 16; ++c) {
    const float2 cc = make_float2(p.c_re[((size_t)gi * 16 + c) * 64 + pp], p.c_im[((size_t)gi * 16 + c) * 64 + pp]);
    const float2 cw = cmulf(cc, we);
    Et[(size_t)(t * 16 + c) * 128 + dir * 64 + pp] = pk_bf16(cw.x, -cw.y);
  }
  const float2 f = make_float2(d.fre, d.fim);
  unsigned fr[8], fi[8];
#pragma unroll
  for (int c2 = 0; c2 < 8; ++c2) {
    const size_t bi = ((size_t)gi * 64 + pp) * 16 + c2 * 2;
    const float2 v0 = cmulf(wf, cmulf(f, make_float2(p.b_re[bi], p.b_im[bi])));
    const float2 v1 = cmulf(wf, cmulf(f, make_float2(p.b_re[bi + 1], p.b_im[bi + 1])));
    fr[c2] = pk_bf16(v0.x, v1.x); fi[c2] = pk_bf16(v0.y, v1.y);
  }
  u32x4* r0 = (u32x4*)(Ft + (size_t)(dir * 128 + pp * 2) * 512 + t * 16);
  u32x4* r1 = (u32x4*)(Ft + (size_t)(dir * 128 + pp * 2 + 1) * 512 + t * 16);
  r0[0] = (u32x4){fr[0], fr[1], fr[2], fr[3]}; r0[1] = (u32x4){fr[4], fr[5], fr[6], fr[7]};
  r1[0] = (u32x4){fi[0], fi[1], fi[2], fi[3]}; r1[1] = (u32x4){fi[4], fi[5], fi[6], fi[7]};
}
DEV void mt_item(const P& p, int l, int it) {
  const int g = it >> 7, id = (it & 127) * 256 + get_tid();
  const int k8 = id & 63, n = id >> 6, ti = k8 >> 1, ci0 = (k8 & 1) * 8, to = n >> 4, co = n & 15;
  const float* ktab = (const float*)(p.ws + OFF_KTAB);
  float v[8];
  if (to != ti) {
    const int dir = to > ti ? 0 : 1, lag = to > ti ? to - ti : ti - to;
    const f32x4* s = (const f32x4*)(ktab + (((size_t)g * 2 + dir) * 32 + lag) * 256 + co * 16 + ci0);
    const f32x4 a = s[0], b = s[1];
    v[0] = a[0]; v[1] = a[1]; v[2] = a[2]; v[3] = a[3]; v[4] = b[0]; v[5] = b[1]; v[6] = b[2]; v[7] = b[3];
  } else {
    const f32x4* s0 = (const f32x4*)(ktab + (((size_t)g * 2 + 0) * 32) * 256 + co * 16 + ci0);
    const f32x4* s1 = (const f32x4*)(ktab + (((size_t)g * 2 + 1) * 32) * 256 + co * 16 + ci0);
    const f32x4 a = s0[0] + s1[0], b = s0[1] + s1[1];
    v[0] = a[0]; v[1] = a[1]; v[2] = a[2]; v[3] = a[3]; v[4] = b[0]; v[5] = b[1]; v[6] = b[2]; v[7] = b[3];
    const float dd = p.s5_d[l * 512 + g * 16 + co];
#pragma unroll
    for (int e = 0; e < 8; ++e) if (ci0 + e == co) v[e] += dd;
  }
  u32x4 w; w.x = pk_bf16(v[0], v[1]); w.y = pk_bf16(v[2], v[3]); w.z = pk_bf16(v[4], v[5]); w.w = pk_bf16(v[6], v[7]);
  *(u32x4*)((bf16_t*)(p.ws + OFF_MT) + ((size_t)g * 512 + n) * 512 + k8 * 8) = w;
}

DEV void norm_rows(const P& p, const float* lat, const float* ctxp, int nrows, const float* gain, const float* modl, int ishift, int iscale) {
  const int lane = get_tid() & 63, wid = get_tid() >> 6;
  bf16_t* XN = (bf16_t*)(p.ws + OFF_XN);
  for (int item = vbid(); item < nrows / 8; item += vgrid()) {
    const int row0 = item * 8 + wid * 2;
    f32x4 v[2][4]; float ss[2];
#pragma unroll
    for (int q = 0; q < 2; ++q) {
      const int row = row0 + q;
      const float* src = row < MLAT ? lat + (size_t)row * 1024 : ctxp + (size_t)(row - MLAT) * 1024;
#pragma unroll
      for (int i = 0; i < 4; ++i) v[q][i] = ((const f32x4*)src)[lane + 64 * i];
    }
#pragma unroll
    for (int q = 0; q < 2; ++q) {
      float s = 0.f;
#pragma unroll
      for (int i = 0; i < 4; ++i) s += v[q][i][0] * v[q][i][0] + v[q][i][1] * v[q][i][1] + v[q][i][2] * v[q][i][2] + v[q][i][3] * v[q][i][3];
      ss[q] = wave_sum(s);
    }
#pragma unroll
    for (int q = 0; q < 2; ++q) {
      const int row = row0 + q, bi = row < MLAT ? row >> 12 : 8;
      const float rstd = rsqrtf(ss[q] * (1.0f / 1024.0f) + EPSN);
      const float* msh = modl + ((size_t)bi * 6 + ishift) * 1024; const float* msc = modl + ((size_t)bi * 6 + iscale) * 1024;
#pragma unroll
      for (int i = 0; i < 4; ++i) {
        const int col = (lane + 64 * i) * 4;
        const f32x4 g = *(const f32x4*)(gain + col), sh = *(const f32x4*)(msh + col), sc = *(const f32x4*)(msc + col);
        const f32x4 y = v[q][i] * rstd * g * (sc + 1.0f) + sh;
        *(u32x2*)(XN + (size_t)row * 1024 + col) = (u32x2){pk_bf16(y[0], y[1]), pk_bf16(y[2], y[3])};
      }
    }
  }
}
DEV void ph_final(const P& p) {
  const int lane = get_tid() & 63, wid = get_tid() >> 6;
  for (int item = vbid(); item < MLAT / 8; item += vgrid()) {
    const int row0 = item * 8 + wid * 2;
    f32x4 v[2][4]; float ss[2];
#pragma unroll
    for (int q = 0; q < 2; ++q)
#pragma unroll
      for (int i = 0; i < 4; ++i) v[q][i] = ((const f32x4*)(p.out + (size_t)(row0 + q) * 1024))[lane + 64 * i];
#pragma unroll
    for (int q = 0; q < 2; ++q) {
      float s = 0.f;
#pragma unroll
      for (int i = 0; i < 4; ++i) s += v[q][i][0] * v[q][i][0] + v[q][i][1] * v[q][i][1] + v[q][i][2] * v[q][i][2] + v[q][i][3] * v[q][i][3];
      ss[q] = wave_sum(s);
    }
#pragma unroll
    for (int q = 0; q < 2; ++q) {
      const float rstd = rsqrtf(ss[q] * (1.0f / 1024.0f) + EPSN);
#pragma unroll
      for (int i = 0; i < 4; ++i) { const int col = (lane + 64 * i) * 4; const f32x4 g = *(const f32x4*)(p.norm_final + col); ((f32x4*)(p.out + (size_t)(row0 + q) * 1024))[lane + 64 * i] = v[q][i] * rstd * g; }
    }
  }
}

DEV void ph_prep(const P& p, int l, char* smem) {
  for (int r_ = 0, nr_ = rounds_of(N_CVT); r_ < nr_; ++r_) { int it = vbid() + r_ * vgrid(); it = it < N_CVT ? it : N_CVT - 1; cvt_item(p, l, it, smem); }
  for (int r_ = 0, nr_ = rounds_of(512); r_ < nr_; ++r_) { int it = vbid() + r_ * vgrid(); it = it < 512 ? it : 511; ktab_item(p, l, it, smem); }
  for (int it = vbid(); it < 512; it += vgrid()) ef_item(p, l, it);
  { float* ssq = (float*)(p.ws + OFF_SSQ); const int step = vgrid() * 256; int i = vbid() * 256 + get_tid();
#pragma unroll
    for (int e = 0; e < 4; ++e) { if (i < MALL * 2) ssq[i] = 0.f; i += step; } }
  const float* modl = (const float*)(p.ws + OFF_MOD) + (size_t)l * 9 * 6144;
  if (l == 0) norm_rows(p, p.x, p.ctx, MALL, p.norm_mix, modl, 0, 1);
  else norm_rows(p, p.out, (const float*)(p.ws + OFF_XC), MALL, p.norm_mix + 1024, modl, 0, 1);
}

DEV void ph_in(const P& p, int l, char* smem) {
  for (int it = vbid(); it < 4096; it += vgrid()) mt_item(p, l, it);
}

DEV void rms_rows(const bf16_t* zb, int row0, int rmax, float* srstd) {
  const int tid = get_tid(), r = tid >> 1, half = tid & 1;
  int row = row0 + r; row = row < rmax ? row : rmax - 1;
  const u32x4* q = (const u32x4*)(zb + (size_t)row * LDZ + half * 128);
  float ss = 0.f;
#pragma unroll 4
  for (int i = 0; i < 16; ++i) {
    const u32x4 w = q[i];
    ss += bflo(w.x) * bflo(w.x) + bfhi(w.x) * bfhi(w.x) + bflo(w.y) * bflo(w.y) + bfhi(w.y) * bfhi(w.y) + bflo(w.z) * bflo(w.z) + bfhi(w.z) * bfhi(w.z) + bflo(w.w) * bflo(w.w) + bfhi(w.w) * bfhi(w.w);
  }
  ss += __shfl_xor(ss, 1);
  if (!half) srstd[r] = rsqrtf(ss * (1.0f / 256.0f) + EPSN);
  __syncthreads();
}

DEV void ph_mid(const P& p, int l, bool need, char* smem) {
  const int tid = get_tid(), lane = tid & 63, wid = tid >> 6, wm = wid >> 1, wn = wid & 1, l15 = lane & 15, lq = lane >> 4;
  bf16_t* Z = (bf16_t*)(p.ws + OFF_Z);
  bf16_t* Qb = (bf16_t*)(p.ws + OFF_Q); bf16_t* Kb = (bf16_t*)(p.ws + OFF_K); bf16_t* Vt = (bf16_t*)(p.ws + OFF_VT);
  float* srstd = (float*)(smem + 65536) + (vboff() >> 2);
  const float2* rope = (const float2*)(p.ws + OFF_ROPE);
  for (int it = vbid(); it < MALL / 16; it += vgrid()) {
    const int row = it * 16 + (tid >> 4), e = tid & 15, a = e >> 3, f = e & 7;
    const bf16_t* zp = Z + (size_t)row * LDZ + ZPE + a * 16 + f;
    float x0 = __uint_as_float((unsigned)zp[0] << 16), x1 = __uint_as_float((unsigned)zp[8] << 16);
    int b, key;
    if (row < MLAT) {
      b = row >> 12; const int n = row & 4095; key = 256 + n;
      const float2 cs = rope[(a ? (n & 63) : (n >> 6)) * 8 + f];
      const float t0 = x0 * cs.x - x1 * cs.y, t1 = x1 * cs.x + x0 * cs.y; x0 = t0; x1 = t1;
    } else { const int cr = row - MLAT; b = cr >> 8; key = cr & 255; }
    const unsigned w = pk_bf16(x0, x1);
#pragma unroll
    for (int h = 0; h < 8; ++h) *(unsigned*)(Kb + ((size_t)(b * 8 + h) * NKEY + key) * 96 + 64 + a * 16 + f * 2) = w;
  }
}

DEV void ph_carry(const P& p, int l, bool need) {
  const int tid = get_tid();
  bf16_t* Z = (bf16_t*)(p.ws + OFF_Z);
  for (int it = vbid(); it < 128; it += vgrid()) {
    const int idx = it * 256 + tid, pp = idx & 63, dir = (idx >> 6) & 1, g = (idx >> 7) & 31, b = idx >> 12;
    const Disc d = s5_disc(p, l, dir, g, pp);
    const float2 at = cpow(d, 32);
    unsigned* S = (unsigned*)(p.ws + OFF_S) + (g * 256 + dir * 128 + pp * 2) / 2;
    float sr = 0.f, si = 0.f;
    for (int blk = 0; blk < 17; ++blk) {
      unsigned v[8]; int rows[8];
#pragma unroll
      for (int e = 0; e < 8; ++e) {
        int r;
        if (blk == 0) r = 1024 + b * 8 + (dir ? 7 - e : e);
        else { const int j = (blk - 1) * 8 + e; r = b * 128 + (dir ? 127 - j : j); }
        rows[e] = r; v[e] = S[(size_t)r * 4096];
      }
#pragma unroll
      for (int e = 0; e < 8; ++e) {
        S[(size_t)rows[e] * 4096] = pk_bf16(sr, si);
        const float nr = at.x * sr - at.y * si + bflo(v[e]), ni = at.x * si + at.y * sr + bfhi(v[e]);
        sr = nr; si = ni;
      }
    }
  }
  {
    const int Mc = need ? MALL : MLAT;
    const int ch = (tid & 63) * 8, rsub = tid >> 6;
    const float* cw = p.conv_w + (size_t)l * 3 * 512 + ch;
    float w0[8], w1[8], w2[8];
#pragma unroll
    for (int e = 0; e < 8; ++e) { w0[e] = cw[e]; w1[e] = cw[512 + e]; w2[e] = cw[1024 + e]; }
    for (int it = vbid(); it < Mc / 32; it += vgrid()) {
      const int rbase = it * 32 + rsub * 8;
      float up[8], uc[8], un[8];
      auto loadu = [&](int row, bool valid, float (&u)[8]) {
        if (valid) {
          const u32x4 c = *(const u32x4*)(Z + (size_t)row * LDZ + ZCC + ch), x = *(const u32x4*)(Z + (size_t)row * LDZ + ZCX + ch);
          u[0] = bflo(c.x) * bflo(x.x); u[1] = bfhi(c.x) * bfhi(x.x); u[2] = bflo(c.y) * bflo(x.y); u[3] = bfhi(c.y) * bfhi(x.y);
          u[4] = bflo(c.z) * bflo(x.z); u[5] = bfhi(c.z) * bfhi(x.z); u[6] = bflo(c.w) * bflo(x.w); u[7] = bfhi(c.w) * bfhi(x.w);
        } else {
#pragma unroll
          for (int e = 0; e < 8; ++e) u[e] = 0.f;
        }
      };
      auto tpos = [&](int row, int& t, int& len) { if (row < MLAT) { t = row & 4095; len = 4096; } else { t = (row - MLAT) & 255; len = 256; } };
      int t0, len0; tpos(rbase, t0, len0);
      loadu(rbase - 1, t0 > 0, up); loadu(rbase, true, uc);
#pragma unroll
      for (int rr = 0; rr < 8; ++rr) {
        const int row = rbase + rr; int t, len; tpos(row, t, len);
        loadu(row + 1, t < len - 1, un);
        const u32x4 zb = *(const u32x4*)(Z + (size_t)row * LDZ + ZCB + ch);
        float y[8];
#pragma unroll
        for (int e = 0; e < 8; ++e) y[e] = w0[e] * up[e] + w1[e] * uc[e] + w2[e] * un[e];
        u32x4 o;
        o.x = pk_bf16(bflo(zb.x) * y[0], bfhi(zb.x) * y[1]); o.y = pk_bf16(bflo(zb.y) * y[2], bfhi(zb.y) * y[3]);
        o.z = pk_bf16(bflo(zb.z) * y[4], bfhi(zb.z) * y[5]); o.w = pk_bf16(bflo(zb.w) * y[6], bfhi(zb.w) * y[7]);
        *(u32x4*)(Z + (size_t)row * LDZ + ZCV + ch) = o;
#pragma unroll
        for (int e = 0; e < 8; ++e) { up[e] = uc[e]; uc[e] = un[e]; }
      }
    }
  }
}

DEV float max3a(float a, float b, float c) { float r; asm("v_max3_f32 %0, %1, %2, %3" : "=v"(r) : "v"(a), "v"(b), "v"(c)); return r; }
DEV void attn_item(const P& p, int bh, int qrow0, int nkt, int outrow0, char* smem) {
  int tid; asm volatile("v_mov_b32 %0, %1" : "=v"(tid) : "v"((int)threadIdx.x));
  const int lane = tid & 63, wid = __builtin_amdgcn_readfirstlane(tid >> 6), l15 = lane & 15, lq = lane >> 4;
  const bf16_t* Qb = (const bf16_t*)(p.ws + OFF_Q) + (size_t)bh * NKEY * 96;
  const bf16_t* Kb = (const bf16_t*)(p.ws + OFF_K) + (size_t)bh * NKEY * 96;
  const bf16_t* Vt = (const bf16_t*)(p.ws + OFF_VT) + (size_t)bh * 64 * NKEY;
  bf16_t* Z = (bf16_t*)(p.ws + OFF_Z);
  constexpr int KB = 16384, VB = 8192, VBASE = 3 * KB;
  int vo = 0; asm volatile("" : "+v"(vo));
  bf16x8 qf[2][3];
#pragma unroll
  for (int qt = 0; qt < 2; ++qt)
#pragma unroll
    for (int ks = 0; ks < 3; ++ks) qf[qt][ks] = *(const bf16x8*)(Qb + (size_t)(qrow0 + wid * 32 + qt * 16 + l15) * 96 + ks * 32 + lq * 8);
  f32x4 o[4][2];
#pragma unroll
  for (int vt = 0; vt < 4; ++vt)
#pragma unroll
    for (int qt = 0; qt < 2; ++qt) o[vt][qt] = (f32x4){0.f, 0.f, 0.f, 0.f};
  float mused[2] = {0.f, 0.f};
  f32x4 osum[2] = {(f32x4){0.f, 0.f, 0.f, 0.f}, (f32x4){0.f, 0.f, 0.f, 0.f}};
  const bf16x8 ones = __builtin_bit_cast(bf16x8, (u32x4){0x3f803f80u, 0x3f803f80u, 0x3f803f80u, 0x3f803f80u});
  u32x4 kr[2], vr[1];
  const int krow = tid >> 4, kc = tid & 15;
  const int vrow = tid >> 3, vc = tid & 7;
  const int kwo = vo + krow * 256 + ((kc ^ (krow & 15)) << 4), vwo = vo + VBASE + vrow * 128 + ((vc ^ ((vrow >> 1) & 7)) << 4);
  const int kro = vo + l15 * 256, vro = vo + VBASE + l15 * 128;
  f32x4 st[4][2];
  bf16x8 pf[2][2], vf[2][4];
#define ALOAD(kt) { const int key0_ = (kt) * 64; \
    if (kc < 12) { _Pragma("unroll") for (int i = 0; i < 2; ++i) kr[i] = *(const u32x4*)(Kb + (size_t)(key0_ + krow + 32 * i) * 96 + kc * 8); } \
    vr[0] = *(const u32x4*)(Vt + (size_t)vrow * NKEY + key0_ + vc * 8); }
#define ASTORE(slot) { char* sk_ = smem + (slot) * KB; char* sv_ = smem + (slot) * VB; \
    if (kc < 12) { _Pragma("unroll") for (int i = 0; i < 2; ++i) *(u32x4*)(sk_ + kwo + i * 8192) = kr[i]; } \
    *(u32x4*)(sv_ + vwo) = vr[0]; }
#define LDK(dst, s_, ks_) { _Pragma("unroll") for (int kk = 0; kk < 4; ++kk) dst[kk] = *(const bf16x8*)((s_) + kk * 4096 + kro + ((((ks_) * 4 + lq) ^ l15) << 4)); }
#define MMK(src_, ks_) { _Pragma("unroll") for (int kk = 0; kk < 4; ++kk) _Pragma("unroll") for (int qt = 0; qt < 2; ++qt) st[kk][qt] = __builtin_amdgcn_mfma_f32_16x16x32_bf16(src_[kk], qf[qt][ks_], st[kk][qt], 0, 0, 0); }
#define QK(slot) { const char* s = smem + (slot) * KB; bf16x8 kfa[4], kfb[4]; \
    LDK(kfa, s, 0); LDK(kfb, s, 1); \
    _Pragma("unroll") for (int kk = 0; kk < 4; ++kk) _Pragma("unroll") for (int qt = 0; qt < 2; ++qt) { const float nm = -mused[qt]; st[kk][qt] = (f32x4){nm, nm, nm, nm}; } \
    __builtin_amdgcn_s_setprio(1); MMK(kfa, 0); LDK(kfa, s, 2); MMK(kfb, 1); MMK(kfa, 2); __builtin_amdgcn_s_setprio(0); }
#define SM(first) { _Pragma("unroll") for (int qt = 0; qt < 2; ++qt) { \
      float mx = max3a(st[0][qt][0], st[0][qt][1], st[0][qt][2]); \
      mx = max3a(mx, st[0][qt][3], st[1][qt][0]); mx = max3a(mx, st[1][qt][1], st[1][qt][2]); mx = max3a(mx, st[1][qt][3], st[2][qt][0]); \
      mx = max3a(mx, st[2][qt][1], st[2][qt][2]); mx = max3a(mx, st[2][qt][3], st[3][qt][0]); mx = max3a(mx, st[3][qt][1], st[3][qt][2]); mx = max3a(mx, st[3][qt][3], st[3][qt][3]); \
      if ((first) || __builtin_amdgcn_ballot_w64(mx > 8.0f) != 0) {     \
        mx = fmaxf(mx, __shfl_xor(mx, 16)); mx = fmaxf(mx, __shfl_xor(mx, 32)); \
        const float sc = __builtin_amdgcn_exp2f(-mx); \
        mused[qt] += mx; \
        _Pragma("unroll") for (int vt = 0; vt < 4; ++vt) o[vt][qt] = o[vt][qt] * sc; \
        osum[qt] = osum[qt] * sc; \
        _Pragma("unroll") for (int kk = 0; kk < 4; ++kk) _Pragma("unroll") for (int r = 0; r < 4; ++r) st[kk][qt][r] = __builtin_amdgcn_exp2f(st[kk][qt][r] - mx); \
      } else { \
        _Pragma("unroll") for (int kk = 0; kk < 4; ++kk) _Pragma("unroll") for (int r = 0; r < 4; ++r) st[kk][qt][r] = __builtin_amdgcn_exp2f(st[kk][qt][r]); \
      } \
      _Pragma("unroll") for (int k2 = 0; k2 < 2; ++k2) { \
        u32x4 w; \
        w.x = pk_bf16(st[2 * k2][qt][0], st[2 * k2][qt][1]); w.y = pk_bf16(st[2 * k2][qt][2], st[2 * k2][qt][3]); \
        w.z = pk_bf16(st[2 * k2 + 1][qt][0], st[2 * k2 + 1][qt][1]); w.w = pk_bf16(st[2 * k2 + 1][qt][2], st[2 * k2 + 1][qt][3]); \
        pf[qt][k2] = __builtin_bit_cast(bf16x8, w); } } }
#define PVLOAD(slot) { const char* s = smem + (slot) * VB; \
    _Pragma("unroll") for (int vt = 0; vt < 4; ++vt) vf[0][vt] = *(const bf16x8*)(s + vt * 2048 + vro + (((0 * 4 + lq) ^ (l15 >> 1)) << 4)); }
#define PVMMA(slot) { const char* s = smem + (slot) * VB; \
    _Pragma("unroll") for (int vt = 0; vt < 4; ++vt) vf[1][vt] = *(const bf16x8*)(s + vt * 2048 + vro + (((1 * 4 + lq) ^ (l15 >> 1)) << 4)); \
    __builtin_amdgcn_s_setprio(1); \
    _Pragma("unroll") for (int k2 = 0; k2 < 2; ++k2) _Pragma("unroll") for (int vt = 0; vt < 4; ++vt) \
      _Pragma("unroll") for (int qt = 0; qt < 2; ++qt) o[vt][qt] = __builtin_amdgcn_mfma_f32_16x16x32_bf16(vf[k2][vt], pf[qt][k2], o[vt][qt], 0, 0, 0); \
    _Pragma("unroll") for (int k2 = 0; k2 < 2; ++k2) _Pragma("unroll") for (int qt = 0; qt < 2; ++qt) osum[qt] = __builtin_amdgcn_mfma_f32_16x16x32_bf16(ones, pf[qt][k2], osum[qt], 0, 0, 0); \
    __builtin_amdgcn_s_setprio(0); }
  const bool skew = vbsel() != 0;
  asm volatile("" : "+s"(nkt));
#define ABAR() { asm volatile("s_waitcnt lgkmcnt(0)" ::: "memory"); __builtin_amdgcn_s_barrier(); asm volatile("" ::: "memory"); }
  ALOAD(0); ASTORE(0); if (nkt > 1) ALOAD(1); ABAR();
  int cur = 0, prev = 2, nxt = 1;
#pragma nounroll
  for (int kt = 0; kt < nkt; ++kt) {
    if (kt + 1 < nkt) ASTORE(nxt);
    if (kt + 2 < nkt) ALOAD(kt + 2);
    if (!skew) { QK(cur); PVLOAD(cur); __builtin_amdgcn_sched_barrier(0); SM(kt == 0); PVMMA(cur); }
    else { if (kt > 0) { PVLOAD(prev); __builtin_amdgcn_sched_barrier(0); SM(kt == 1); PVMMA(prev); } QK(cur); }
    ABAR();
    prev = cur; cur = nxt; nxt = (nxt == 2) ? 0 : nxt + 1;
  }
  if (skew) { PVLOAD(prev); SM(nkt == 1); PVMMA(prev); }
  ABAR();
#undef ABAR
#undef ALOAD
#undef ASTORE
#undef QK
#undef SM
#undef PVLOAD
#undef PVMMA
#undef LDK
#undef MMK
  const int h = bh & 7;
#pragma unroll
  for (int qt = 0; qt < 2; ++qt) {
    const float inv = 1.0f / osum[qt][0];
    const int row = outrow0 + wid * 32 + qt * 16 + l15;
#pragma unroll
    for (int vt = 0; vt < 4; ++vt) {
      const f32x4 v = o[vt][qt] * inv;
      *(u32x2*)(Z + (size_t)row * LDZ + ZAO + h * 64 + vt * 16 + lq * 4) = (u32x2){pk_bf16(v[0], v[1]), pk_bf16(v[2], v[3])};
    }
  }
}

DEV float gelu_t(float x) { const float z = 0.7978845608028654f * (x + 0.044715f * x * x * x); const float e = __expf(2.0f * z); return 0.5f * x * (2.0f - 2.0f / (1.0f + e)); }

DEV void ph_attn(const P& p, int l, bool need, char* smem) {
  const int tid = get_tid(), lane = tid & 63, wid = tid >> 6, wm = wid >> 1, wn = wid & 1, l15 = lane & 15, lq = lane >> 4;
  bf16_t* Z = (bf16_t*)(p.ws + OFF_Z);
  {
    const bf16_t* Mt = (const bf16_t*)(p.ws + OFF_MT); const bf16_t* Et = (const bf16_t*)(p.ws + OFF_ET); const bf16_t* S = (const bf16_t*)(p.ws + OFF_S);
    const int nmt = need ? 9 : 8, rmax = need ? NCH : 1024;
    for (int r_ = 0, nr_ = rounds_of(32 * nmt * 4); r_ < nr_; ++r_) { int t = vbid() + r_ * vgrid(); t = t < (32 * nmt * 4) ? t : (32 * nmt * 4) - 1;
      const int g = t / (nmt * 4), mt = (t % (nmt * 4)) >> 2, nt = t & 3;
      f32x4 acc[4][4]; zero_acc<4>(acc);
      ASrc a; a.p = Z + ZS5 + g * 16; a.lda = 32 * LDZ; a.row0 = mt * 128; a.rmax = rmax; a.segshift = 4; a.segstride = LDZ;
      gemm_core<4, true>(acc, a, Mt + ((size_t)g * 512 + nt * 128) * 512, 512, 512, smem);
      gemm_core<4, true>(acc, asrc(S + g * 256, 8192, mt * 128, rmax), Et + ((size_t)g * 512 + nt * 128) * 256, 256, 256, smem);
#pragma unroll
      for (int i = 0; i < 4; ++i) {
        const int crow = mt * 128 + wm * 64 + i * 16 + l15;
        if (crow < rmax) {
#pragma unroll
          for (int j = 0; j < 4; ++j) {
            const int n = nt * 128 + wn * 64 + j * 16 + lq * 4, tt = n >> 4, c = n & 15;
            *(u32x2*)(Z + (size_t)(crow * 32 + tt) * LDZ + ZS5A + g * 16 + c) =
                (u32x2){pk_bf16(gelu_t(acc[i][j][0]), gelu_t(acc[i][j][1])), pk_bf16(gelu_t(acc[i][j][2]), gelu_t(acc[i][j][3]))};
          }
        }
      }
    }
  }
  for (int it = blockIdx.x; it < 1024; it += gridDim.x) {
    const int r = it >> 8, w = it & 255, xcd = w & 7, slot = w >> 3;
    const int bh = r * 16 + xcd * 2 + (slot >> 4), qb = slot & 15;
    attn_item(p, bh, qb * 256, 68, (bh >> 3) * 4096 + qb * 256, smem);
  }
  if (need) for (int it = blockIdx.x; it < 64; it += gridDim.x) attn_item(p, it, 4096, 4, MLAT + (it >> 3) * 256, smem);
}

DEV int n_jobs(int ph) { return ph == 2 ? 1 : ph == 3 ? 3 : ph == 6 ? 7 : (ph == 7 || ph == 9 || ph == 10) ? 1 : 0; }
DEV pg8::Job get_job(KP kp, int ph, int l, int j) {
  const P p = ldp(kp);
  const bool need = (l == 0); const int M = need ? MALL : MLAT;
  char* ws = p.ws;
  const bf16_t* Z = (const bf16_t*)(ws + OFF_Z); const bf16_t* XN = (const bf16_t*)(ws + OFF_XN);
  const bf16_t* Wg = (const bf16_t*)(ws + OFF_WIN) + (size_t)LDZ * 1024;
  bf16_t* T = (bf16_t*)(ws + OFF_T); bf16_t* MG = (bf16_t*)(ws + OFF_MG);
  float* xc = (float*)(ws + OFF_XC);
  pg8::Job b; b.lda = 1024; b.M = M; b.N = 1024; b.K = 1024; b.mode = 0; b.O = T; b.ldc = 1024; b.T = T; b.slat = p.out; b.sctx = xc; b.dlat = p.out; b.dctx = xc;
  b.modg = (const float*)(ws + OFF_MOD) + (size_t)l * 9 * 6144; b.A = XN; b.Bt = Wg;
  b.segstride = 0; b.pnstrideA = 0; b.rows = M; b.ssq = nullptr; b.O2 = nullptr;
  if (ph == 2) { b.M = MALL; b.rows = MALL; b.N = LDZ; b.Bt = (const bf16_t*)(ws + OFF_WIN); b.O = (bf16_t*)(ws + OFF_Z); b.ldc = LDZ; b.ssq = (float*)(ws + OFF_SSQ); }
  else if (ph == 3) {
    b.ssq = (float*)(ws + OFF_SSQ); b.K = 256; b.lda = LDZ; b.modg = (const float*)(ws + OFF_ROPE);
    if (j == 0) { b.A = Z + ZQ; b.Bt = (const bf16_t*)(ws + OFF_WUQ); b.N = 768; b.mode = 6; b.O = (bf16_t*)(ws + OFF_Q); }
    else if (j == 1) { b.A = Z + ZKV; b.Bt = (const bf16_t*)(ws + OFF_WUKV); b.M = MALL; b.rows = MALL; b.N = 1024; b.mode = 7; b.O = (bf16_t*)(ws + OFF_K); b.O2 = (bf16_t*)(ws + OFF_VT); }
    else { b.ssq = nullptr; b.A = Z + ZS5; b.lda = 32 * LDZ; b.segstride = LDZ; b.pnstrideA = 16; b.Bt = (const bf16_t*)(ws + OFF_FT); b.M = 1280; b.rows = NCH; b.N = 8192; b.K = 512; b.mode = 0; b.O = (bf16_t*)(ws + OFF_S); b.ldc = 8192; }
  }
  else if (ph == 6) {
    if (j == 0) { b.A = Z + ZAO; b.lda = LDZ; b.Bt = (const bf16_t*)(ws + OFF_WO); b.K = 512; }
    else if (j == 1) { b.mode = 2; b.O = MG; }
    else if (j == 2) { b.A = Z + ZCV; b.lda = LDZ; b.Bt = (const bf16_t*)(ws + OFF_WC); b.K = 512; }
    else if (j == 3) { b.mode = 3; b.O = MG; b.Bt = Wg + (size_t)1024 * 1024; }
    else if (j == 4) { b.A = Z + ZS5A; b.lda = LDZ; b.Bt = (const bf16_t*)(ws + OFF_WGLU); b.K = 512; }
    else if (j == 5) { b.A = Z + ZS5A; b.lda = LDZ; b.Bt = (const bf16_t*)(ws + OFF_WGLU) + (size_t)1024 * 512; b.K = 512; b.mode = 1; }
    else { b.mode = 3; b.O = MG; b.Bt = Wg + (size_t)2048 * 1024; }
  } else if (ph == 7) {
    b.A = MG; b.Bt = (const bf16_t*)(ws + OFF_WOUT); b.mode = 5; b.modg += 2 * 1024;
    if (l == 0) { b.slat = p.x; b.sctx = p.ctx; }
  } else if (ph == 9) { b.Bt = (const bf16_t*)(ws + OFF_W1); b.N = 4096; b.mode = 4; b.O = (bf16_t*)(ws + OFF_Z); b.ldc = 4096; }
  else { b.A = Z; b.lda = 4096; b.K = 4096; b.Bt = (const bf16_t*)(ws + OFF_W2); b.mode = 5; b.modg += 5 * 1024; }
  return b;
}

#define LAS __attribute__((address_space(3)))
#define XB_TMO      128
#define XB_XCNT(j)  (256  + 64 * (j))
#define XB_XSUB(j)  (1280 + 64 * (j))
#define XB_XGEN(j)  (2304 + 64 * (j))
#define XB_TOP      3328
#define XB_TOPGEN   3392
#define XCD_BAR_WORDS 3456
#define XB_SPIN_CAP (1u << 18)

__device__ __forceinline__ unsigned xb_ld(unsigned* p)              { return __hip_atomic_load(p, __ATOMIC_RELAXED, __HIP_MEMORY_SCOPE_AGENT); }
__device__ __forceinline__ unsigned xb_add(unsigned* p, unsigned v) { return __hip_atomic_fetch_add(p, v, __ATOMIC_RELAXED, __HIP_MEMORY_SCOPE_AGENT); }
__device__ __forceinline__ unsigned xb_xcc_id() { return (unsigned)__builtin_amdgcn_s_getreg((3 << 11) | 20) & 0xFu; }
#define XB_SPIN(cond, bar) do { unsigned _sp = 0; while (cond) { __builtin_amdgcn_s_sleep(1); \
    if ((++_sp & 255u) == 0u) { if (xb_ld(&(bar)[XB_TMO])) break; if (_sp > XB_SPIN_CAP) { atomicAdd(&(bar)[XB_TMO], 1u); break; } } } } while (0)

struct XcdBarrier {
    unsigned* bar; unsigned x;
    volatile LAS unsigned* st;
};

__device__ __forceinline__ XcdBarrier xcd_barrier_post(unsigned* bar, volatile LAS unsigned* st) {
    XcdBarrier b; b.bar = bar; b.x = xb_xcc_id(); b.st = st;
    if (threadIdx.x == 0) (void)xb_add(&bar[XB_XCNT(b.x)], 1u);
    return b;
}
__device__ __forceinline__ void xcd_barrier_complete(unsigned* bar, unsigned x, unsigned& nloc, unsigned& nx) {
    const unsigned G = gridDim.x * gridDim.y * gridDim.z;
    unsigned sum, cnt, mine, sp = 0u;
    for (;;) {
        sum = 0u; cnt = 0u; mine = 0u;
#pragma unroll
        for (unsigned j = 0; j < 16; ++j) { const unsigned c = xb_ld(&bar[XB_XCNT(j)]); sum += c; cnt += (c > 0u) ? 1u : 0u; mine = (j == x) ? c : mine; }
        if (sum == G) break;
        __builtin_amdgcn_s_sleep(1);
        if ((++sp & 255u) == 0u) { if (xb_ld(&bar[XB_TMO])) break; if (sp > XB_SPIN_CAP) { atomicAdd(&bar[XB_TMO], 1u); break; } }
    }
    nloc = mine > 0u ? mine : 1u; nx = cnt > 0u ? cnt : 1u;
}

__device__ __forceinline__ void xcd_barrier(const XcdBarrier& b) {
    asm volatile("s_waitcnt vmcnt(0)" ::: "memory");
    __syncthreads();
    if (threadIdx.x == 0) {
        unsigned* bar = b.bar;
        __builtin_amdgcn_s_waitcnt(0);
        unsigned nloc = b.st[0], nx = b.st[1];
        if (nloc == 0u) { xcd_barrier_complete(bar, b.x, nloc, nx); b.st[0] = nloc; b.st[1] = nx; }
        const unsigned old = xb_add(&bar[XB_XSUB(b.x)], 1u);
        const unsigned gen = old / nloc;
        if (old + 1u == (gen + 1u) * nloc) {
            __builtin_amdgcn_fence(__ATOMIC_RELEASE, "agent");
            asm volatile("s_waitcnt vmcnt(0)" ::: "memory");
            const unsigned og = xb_add(&bar[XB_TOP], 1u);
            const unsigned tg = og / nx;
            if (og + 1u == (tg + 1u) * nx) xb_add(&bar[XB_TOPGEN], 1u);
            else XB_SPIN(xb_ld(&bar[XB_TOPGEN]) == tg, bar);
            __builtin_amdgcn_fence(__ATOMIC_ACQUIRE, "agent");
            xb_add(&bar[XB_XGEN(b.x)], 1u);
            asm volatile("s_waitcnt vmcnt(0)" ::: "memory");
        } else {
            XB_SPIN(xb_ld(&bar[XB_XGEN(b.x)]) == gen, bar);
            __builtin_amdgcn_fence(__ATOMIC_ACQUIRE, "agent");
            asm volatile("s_waitcnt vmcnt(0)" ::: "memory");
        }
    }
    __syncthreads();
}

DEV void run_phase(KP kp, int ph, int l, char* smem) {
  const bool need = (l == 0);
  switch (ph) {
    case 0: { const P p = ldp(kp); ph_ada(p, smem); } break;
    case 1: { const P p = ldp(kp); ph_prep(p, l, smem); } break;
    case 2: { const P p = ldp(kp); ph_in(p, l, smem); } break;
    case 3: { const P p = ldp(kp); ph_mid(p, l, need, smem); } break;
    case 4: { const P p = ldp(kp); ph_carry(p, l, need); } break;
    case 5: { const P p = ldp(kp); ph_attn(p, l, need, smem); } break;
    case 8: { const P p = ldp(kp); norm_rows(p, p.out, (const float*)(p.ws + OFF_XC), need ? MALL : MLAT, p.norm_mlp + l * 1024, (const float*)(p.ws + OFF_MOD) + (size_t)l * 9 * 6144, 3, 4); } break;
    case 11: { const P p = ldp(kp); ph_final(p); } break;
    default: break;
  }
}

__global__ void __launch_bounds__(512) mega(P p_unused) {
  __shared__ __attribute__((aligned(16))) char smem_all[163840];
  char* smem = smem_all;
  KP kp = (KP)__builtin_amdgcn_kernarg_segment_ptr();
  cg::grid_group grid = cg::this_grid();
  unsigned* xb_st = (unsigned*)(smem_all + 163824);
  if (threadIdx.x == 0) { xb_st[0] = 0u; xb_st[1] = 0u; }
  __syncthreads();
  unsigned* barw; { const P p0 = ldp(kp); barw = (unsigned*)(p0.ws + OFF_BAR); }
  const XcdBarrier XB = xcd_barrier_post(barw, (volatile LAS unsigned*)xb_st);
  run_phase(kp, 0, 0, smem);
  grid.sync();
  for (int l = 0; l < 2; ++l)
    for (int ph = 1; ph <= 10; ++ph) {
      for (int rep_ = 0; rep_ < 1 + DUPN(ph); ++rep_) {
        const int nj = n_jobs(ph);
        if (nj == 0 || ph == 2 || ph == 3) run_phase(kp, ph, l, smem);
        for (int j = 0; j < nj; ++j) { const pg8::Job jb = get_job(kp, ph, l, j); run_job(smem, jb); }
        xcd_barrier(XB);
      }
    }
  run_phase(kp, 11, 0, smem);
}

extern "C" void kernel_launch(void* const* d_in, const int* in_sizes, int n_in, void* d_out, int out_size, void* d_ws, size_t ws_size, hipStream_t stream) {
  static int grid_blocks = 0;
  if (!grid_blocks) {
    int dev = 0, cus = 0, per_cu = 0;
    hipGetDevice(&dev);
    hipDeviceGetAttribute(&cus, hipDeviceAttributeMultiprocessorCount, dev);
    hipOccupancyMaxActiveBlocksPerMultiprocessor(&per_cu, mega, 512, 0);
    if (per_cu > 1) per_cu = 1;
    grid_blocks = cus * per_cu;
  }
  if (ws_size < WS_TOTAL) fprintf(stderr, "workspace too small: %zu < %zu\n", ws_size, (size_t)WS_TOTAL);
  (void)hipMemsetAsync((char*)d_ws + OFF_BAR, 0, BAR_BYTES, stream);
  P p{};
  const float** f = (const float**)&p;
  for (int i = 0; i < 29; ++i) f[i] = (const float*)d_in[i];
  p.out = (float*)d_out; p.ws = (char*)d_ws;
  void* args[] = {&p};
  hipError_t e = hipLaunchCooperativeKernel((void*)mega, dim3(grid_blocks), dim3(512), args, 0, stream);
  if (e != hipSuccess) fprintf(stderr, "cooperative launch failed: %s (grid %d)\n", hipGetErrorString(e), grid_blocks);
}
```

```cpp
#include <hip/hip_runtime.h>
#include <hip/hip_cooperative_groups.h>
#include <stdint.h>
#include <cstdio>
namespace cg = cooperative_groups;

typedef unsigned short bf16_t;
typedef short bf16x8 __attribute__((ext_vector_type(8)));
typedef float f32x4 __attribute__((ext_vector_type(4)));
typedef unsigned u32x4 __attribute__((ext_vector_type(4)));
typedef unsigned u32x2 __attribute__((ext_vector_type(2)));
#define DEV __device__ __forceinline__

constexpr int MLAT = 32768, MCTX = 2048, MALL = 34816;
constexpr int LDZ = 2816, ZQ = 0, ZKV = 256, ZCB = 512, ZCC = 1024, ZCX = 1536, ZS5 = 2048, ZPE = 2560;
constexpr int ZCV = 0, ZAO = 512, ZS5A = 1024, ZMG = 1536;
constexpr int NKEY = 4352;
constexpr int NCH = 1088;
constexpr float EPSN = 1e-6f;

constexpr size_t OFF_MOD  = 0;
constexpr size_t OFF_ROPE = OFF_MOD + 2ull * 9 * 6144 * 4;
constexpr size_t OFF_KTAB = OFF_ROPE + 4096;
constexpr size_t OFF_XC   = OFF_KTAB + 32ull * 2 * 32 * 256 * 4;
constexpr size_t OFF_S    = OFF_XC + 2048ull * 1024 * 4;
constexpr size_t OFF_WIN  = OFF_S + (size_t)NCH * 8192 * 2;
constexpr size_t OFF_WUQ  = OFF_WIN + 5888ull * 1024 * 2;
constexpr size_t OFF_WUKV = OFF_WUQ + 768ull * 256 * 2;
constexpr size_t OFF_WO   = OFF_WUKV + 1024ull * 256 * 2;
constexpr size_t OFF_WC   = OFF_WO + 1024ull * 512 * 2;
constexpr size_t OFF_WGLU = OFF_WC + 1024ull * 512 * 2;
constexpr size_t OFF_WOUT = OFF_WGLU + 2048ull * 512 * 2;
constexpr size_t OFF_W1   = OFF_WOUT + 1024ull * 1024 * 2;
constexpr size_t OFF_W2   = OFF_W1 + 4096ull * 1024 * 2;
constexpr size_t OFF_MT   = OFF_W2 + 1024ull * 4096 * 2;
constexpr size_t OFF_ET   = OFF_MT + 32ull * 512 * 512 * 2;
constexpr size_t OFF_FT   = OFF_ET + 32ull * 512 * 256 * 2;
constexpr size_t OFF_XN   = OFF_FT + 32ull * 256 * 512 * 2;
constexpr size_t OFF_Z    = OFF_XN + (size_t)MALL * 1024 * 2;
constexpr size_t OFF_Q    = OFF_Z + (size_t)MALL * LDZ * 2;
constexpr size_t OFF_K    = OFF_Q + 64ull * NKEY * 96 * 2;
constexpr size_t OFF_VT   = OFF_K + 64ull * NKEY * 96 * 2;
constexpr size_t WS_NEED  = OFF_VT + 64ull * 64 * NKEY * 2;
constexpr size_t OFF_T    = OFF_Q;
constexpr size_t OFF_MG   = OFF_T + (size_t)MALL * 1024 * 2;
static_assert(OFF_MG + (size_t)MALL * 1024 * 2 <= WS_NEED, "merge temporaries overflow");
constexpr size_t OFF_BAR  = WS_NEED;
constexpr size_t BAR_BYTES = 3456 * 4;
constexpr size_t OFF_SSQ  = OFF_BAR + 16384;
constexpr size_t WS_TOTAL = OFF_SSQ + (size_t)MALL * 2 * 4;
static_assert((size_t)MALL * 4096 * 2 <= OFF_VT - OFF_Z, "H alias too big");

#ifdef DUP_PH
#define DUPN(ph) ((ph) == DUP_PH ? 1 : 0)
#else
#define DUPN(ph) 0
#endif
struct P {
  const float *x, *c, *ctx, *c_ctx, *ada_w, *ada_b, *norm_mix, *w_in, *q_norm, *w_uq, *kv_norm, *w_ukv, *w_o, *conv_w, *conv_w_out,
      *a_re, *a_im, *log_dt, *b_re, *b_im, *c_re, *c_im, *s5_d, *w_glu, *w_out, *norm_mlp, *w1, *w2, *norm_final;
  float* out; char* ws;
};

DEV int get_tid() { int t; asm volatile("v_mov_b32 %0, %1" : "=v"(t) : "v"((int)(threadIdx.x & 255))); return t; }
DEV int vbsel() { return __builtin_amdgcn_readfirstlane((int)(threadIdx.x >> 8)); }
DEV int vbid() { return (int)blockIdx.x * 2 + vbsel(); }
DEV int vgrid() { return (int)gridDim.x * 2; }
DEV int vboff() { return vbsel() * 81920; }
DEV int rounds_of(int total) { const int vg = vgrid(); int r = 0; for (int t = 0; t < total; t += vg) ++r; return r; }
typedef const __attribute__((address_space(4))) P* KP;
#if defined(__HIP_DEVICE_COMPILE__)
DEV P ldp(KP k) { asm volatile("" : "+s"(k)); return *k; }
#else
DEV P ldp(KP k) { return P{}; }
#endif
DEV unsigned pk_bf16(float lo, float hi) { unsigned r; asm("v_cvt_pk_bf16_f32 %0, %1, %2" : "=v"(r) : "v"(lo), "v"(hi)); return r; }
DEV float bflo(unsigned w) { return __uint_as_float(w << 16); }
DEV float bfhi(unsigned w) { return __uint_as_float(w & 0xffff0000u); }
DEV float sigm(float x) { return 1.0f / (1.0f + __expf(-x)); }
DEV float wave_sum(float v) {
#pragma unroll
  for (int o = 32; o > 0; o >>= 1) v += __shfl_xor(v, o);
  return v;
}
DEV void sincos_d(double th, float& s, float& c) {
  double n = rint(th * 0.15915494309189535);
  double r = fma(-n, 6.283185307179586, th);
  float rev = (float)(r * 0.15915494309189535);
  s = __builtin_amdgcn_sinf(rev); c = __builtin_amdgcn_cosf(rev);
}

struct ASrc { const bf16_t* p; long lda; int row0, rmax, segshift; long segstride; };

template <int WN, bool SWAP>
DEV void gemm_core(f32x4 (&acc)[4][WN], const ASrc& a, const bf16_t* __restrict__ Bt, long ldb, int K, char* smem) {
  constexpr int BN = 32 * WN, NBL = BN / 32;
  constexpr int ABYTES = 16384, STAGE = ABYTES + BN * 128;
  const int tid = get_tid(), lane = tid & 63, wid = tid >> 6, wm = wid >> 1, wn = wid & 1;
  const int l15 = lane & 15, lq = lane >> 4;
  const int lrow = tid >> 3, lc = tid & 7;
  const int segmask = (1 << a.segshift) - 1;
  const bf16_t* ap[4];
#pragma unroll
  for (int i = 0; i < 4; ++i) { int r = a.row0 + lrow + 32 * i; r = r < a.rmax ? r : a.rmax - 1; ap[i] = a.p + (long)r * a.lda; }
  const bf16_t* bp = Bt + (long)lrow * ldb + lc * 8;
  const int vo = vboff();
  const int wofs = vo + lrow * 128 + ((lc ^ ((lrow >> 1) & 7)) << 4);
  u32x4 ra0[4], rb0[NBL], ra1[4], rb1[NBL];
  const int aoff = vo + (wm * 64 + l15) * 128, boff = vo + ABYTES + (wn * 16 * WN + l15) * 128, sx = l15 >> 1;
  int nk = K >> 6; asm volatile("" : "+s"(nk));
#define GLOAD(RA, RB, kt) { const int k_ = (kt) * 64 + lc * 8; const long ko_ = (long)(k_ >> a.segshift) * a.segstride + (k_ & segmask); \
    _Pragma("unroll") for (int i = 0; i < 4; ++i) RA[i] = *(const u32x4*)(ap[i] + ko_); \
    _Pragma("unroll") for (int i = 0; i < NBL; ++i) RB[i] = *(const u32x4*)(bp + (long)(32 * i) * ldb + (kt) * 64); }
#define LSTORE(RA, RB, buf) { char* s_ = smem + (buf) * STAGE; \
    _Pragma("unroll") for (int i = 0; i < 4; ++i) *(u32x4*)(s_ + wofs + i * 4096) = RA[i]; \
    _Pragma("unroll") for (int i = 0; i < NBL; ++i) *(u32x4*)(s_ + ABYTES + wofs + i * 4096) = RB[i]; }
#define BAR() { asm volatile("s_waitcnt lgkmcnt(0)" ::: "memory"); __builtin_amdgcn_s_barrier(); asm volatile("" ::: "memory"); }
#define COMPUTE(buf) { const char* s = smem + (buf) * STAGE; \
    _Pragma("unroll") for (int ks = 0; ks < 2; ++ks) { \
      const int co = ((ks * 4 + lq) ^ sx) << 4; \
      bf16x8 af[4], bfr[WN]; \
      _Pragma("unroll") for (int i = 0; i < 4; ++i) af[i] = *(const bf16x8*)(s + aoff + i * 2048 + co); \
      _Pragma("unroll") for (int j = 0; j < WN; ++j) bfr[j] = *(const bf16x8*)(s + boff + j * 2048 + co); \
      _Pragma("unroll") for (int i = 0; i < 4; ++i) \
        _Pragma("unroll") for (int j = 0; j < WN; ++j) \
          acc[i][j] = SWAP ? __builtin_amdgcn_mfma_f32_16x16x32_bf16(bfr[j], af[i], acc[i][j], 0, 0, 0) \
                           : __builtin_amdgcn_mfma_f32_16x16x32_bf16(af[i], bfr[j], acc[i][j], 0, 0, 0); \
    } }
  __builtin_amdgcn_sched_barrier(0);
  GLOAD(ra0, rb0, 0); GLOAD(ra1, rb1, 1); LSTORE(ra0, rb0, 0); BAR();
#pragma nounroll
  for (int kt = 0; kt < nk; kt += 2) {
    if (kt + 2 < nk) GLOAD(ra0, rb0, kt + 2);
    COMPUTE(0);
    LSTORE(ra1, rb1, 1);
    BAR();
    if (kt + 3 < nk) GLOAD(ra1, rb1, kt + 3);
    COMPUTE(1);
    if (kt + 2 < nk) LSTORE(ra0, rb0, 0);
    BAR();
  }
#undef GLOAD
#undef LSTORE
#undef COMPUTE
#undef BAR
  __builtin_amdgcn_sched_barrier(0);
}
template <int WN> DEV void zero_acc(f32x4 (&acc)[4][WN]) {
#pragma unroll
  for (int i = 0; i < 4; ++i)
#pragma unroll
    for (int j = 0; j < WN; ++j) acc[i][j] = (f32x4){0.f, 0.f, 0.f, 0.f};
}
DEV ASrc asrc(const bf16_t* p, long lda, int row0, int rmax) { ASrc a; a.p = p; a.lda = lda; a.row0 = row0; a.rmax = rmax; a.segshift = 30; a.segstride = 0; return a; }

DEV bool tile_get(int r, int nM, int nN, int& mt, int& nt) {
  const int nslots = vgrid() >> 3; int q = (r * 8 + ((int)blockIdx.x & 7)) * nslots + ((int)blockIdx.x >> 3) * 2 + vbsel();
  const bool valid = q < nM * nN; q = valid ? q : nM * nN - 1;
  const int band = q / (8 * nN), rem = q - band * 8 * nN;
  nt = rem >> 3; mt = band * 8 + (rem & 7);
  return valid;
}
DEV int tile_rounds(int total) { return rounds_of(total); }


namespace pg8 {
#define PG8_LAS __attribute__((address_space(3)))
constexpr int BM = 256, BK = 64, HALF = 128, HTB = HALF * BK * 2, STAGE_BYTES = 8 * HTB, NXCD = 8, WGM = 8;
DEV int lds_byte(int r, int c) { const int st = (r >> 4) * 2 + (c >> 5), rr = r & 15, cc = c & 31, ob = rr * 64 + cc * 2; return st * 1024 + (ob ^ (((ob >> 9) & 1) << 5)); }
DEV void stage_rc(int b, int& R, int& C) { const int st = b / 1024, sb = b % 1024, swz = sb ^ (((sb >> 9) & 1) << 5); R = (st >> 1) * 16 + swz / 64; C = (st & 1) * 32 + (swz % 64) / 2; }
DEV int perm32(int rho) { const int n = rho >> 4, i = rho & 15; return 8 * (i >> 2) + 4 * n + (i & 3); }
struct Unit { int pm, pn; };
struct Gemm { const bf16_t* A; const bf16_t* Bt; long lda; int M, N, K; long segstride; long pnstrideA; };
struct StaticOrder {
  int nM, nN, nwg, G, c;
  DEV void init(int M, int N, int G_, int c_) { nM = M / BM; nN = N / BM; nwg = nM * nN; G = G_; c = c_; }
  DEV bool next(int i, Unit& u) const {
    const long L = (long)i * G + c; if (L >= nwg) return false;
    int wgid = (int)L; { const int q = nwg / NXCD, r = nwg % NXCD, xcd = wgid % NXCD, off = wgid / NXCD; wgid = (xcd < r ? xcd * (q + 1) : r * (q + 1) + (xcd - r) * q) + off; }
    const int nig = WGM * nN, gid = wgid / nig, fm = gid * WGM, gsz = (nM - fm) < WGM ? (nM - fm) : WGM;
    u.pm = fm + ((wgid % nig) % gsz); u.pn = (wgid % nig) / gsz; return true;
  }
};
template <class Epi>
DEV void gemm_phase(PG8_LAS unsigned char* lds, const Gemm g, const StaticOrder& S, const Epi& E) {
  int tid; asm volatile("v_mov_b32 %0, %1" : "=v"(tid) : "v"((int)threadIdx.x));
  const int wid = __builtin_amdgcn_readfirstlane(tid >> 6), lane = tid & 63, wr = wid >> 2, wc = wid & 3, fr = lane & 15, fq = lane >> 4;
  const int K = g.K, nt = K / BK;
  unsigned voffA[2], voffB[2];
#pragma unroll
  for (int i = 0; i < 2; ++i) { int R, C; stage_rc(tid * 16 + i * 8192, R, C); const int Rb = Epi::PERM ? ((R & ~31) + perm32(R & 31)) : R;
    voffA[i] = (unsigned)((long)R * g.lda + (g.segstride ? (long)(C >> 4) * g.segstride + (C & 15) : (long)C)) * 2u; voffB[i] = (unsigned)(Rb * K + C) * 2u; }
  const size_t kstep = (size_t)(BK * 2);
  const size_t kstepA = g.segstride ? (size_t)(BK / 16) * g.segstride * 2 : kstep;
  const size_t pnA = (size_t)g.pnstrideA * 2;
  const size_t hstepA = (size_t)HALF * g.lda * 2, hstepB = (size_t)HALF * K * 2;
  const size_t tstepA = 2 * hstepA, tstepB = 2 * hstepB;
  const unsigned ldsw = (unsigned)wid * 1024u;
  const int aoff = lds_byte(wr * 64 + fr, fq * 8), boff = lds_byte(wc * 32 + fr, fq * 8);
#define PG8_SA(b, h) (((b) * 2 + (h)) * HTB)
#define PG8_SB(b, h) ((4 + (b) * 2 + (h)) * HTB)
#define PG8_STAGE(bufoff, gbase, voff) do { _Pragma("unroll") for (int _i = 0; _i < 2; ++_i) \
    __builtin_amdgcn_global_load_lds((const unsigned*)((const char*)(gbase) + (voff)[_i]), (PG8_LAS unsigned*)(lds + (bufoff) + ldsw + _i * 8192), 16, 0, 0); } while (0)
#define PG8_LDA(dst, b, h) do { _Pragma("unroll") for (int m = 0; m < 4; ++m) _Pragma("unroll") for (int k = 0; k < 2; ++k) dst[m][k] = *(const PG8_LAS bf16x8*)(lds + PG8_SA(b, h) + aoff + m * 2048 + k * 1024); } while (0)
#define PG8_LDB(dst, b, h) do { _Pragma("unroll") for (int n = 0; n < 2; ++n) _Pragma("unroll") for (int k = 0; k < 2; ++k) dst[n][k] = *(const PG8_LAS bf16x8*)(lds + PG8_SB(b, h) + boff + n * 2048 + k * 1024); } while (0)
#define PG8_MMA(ai, bj, At, Bt) do { __builtin_amdgcn_s_setprio(1); _Pragma("unroll") for (int m = 0; m < 4; ++m) _Pragma("unroll") for (int n = 0; n < 2; ++n) _Pragma("unroll") for (int k = 0; k < 2; ++k) \
    acc[ai][bj][m][n] = __builtin_amdgcn_mfma_f32_16x16x32_bf16(Bt[n][k], At[m][k], acc[ai][bj][m][n], 0, 0, 0); __builtin_amdgcn_s_setprio(0); } while (0)
#define PG8_WAIT_V(n) asm volatile("s_waitcnt vmcnt(" #n ")" ::: "memory")
#define PG8_WAIT_L(n) asm volatile("s_waitcnt lgkmcnt(" #n ")" ::: "memory")
#define PG8_BAR __builtin_amdgcn_s_barrier()
#define PG8_SCHED __builtin_amdgcn_sched_barrier(0)
  Unit cur, nxt; int ui = 0;
  if (!S.next(0, cur)) return;
  f32x4 acc[2][2][4][2];
#pragma unroll
  for (int a = 0; a < 2; ++a)
#pragma unroll
    for (int b = 0; b < 2; ++b)
#pragma unroll
      for (int m = 0; m < 4; ++m)
#pragma unroll
        for (int n = 0; n < 2; ++n) acc[a][b][m][n] = (f32x4){0.f, 0.f, 0.f, 0.f};
  bf16x8 At[4][2], B0[2][2], B1[2][2];
  const char* cA = (const char*)g.A + (size_t)cur.pm * tstepA + (size_t)cur.pn * pnA; const char* cB = (const char*)g.Bt + (size_t)cur.pn * tstepB;
  PG8_STAGE(PG8_SB(0, 0), cB, voffB); PG8_STAGE(PG8_SB(0, 1), cB + hstepB, voffB); PG8_STAGE(PG8_SA(0, 0), cA, voffA); PG8_STAGE(PG8_SA(0, 1), cA + hstepA, voffA);
  if (wr == 1) PG8_BAR;
  PG8_WAIT_V(2); PG8_BAR;
  PG8_STAGE(PG8_SB(1, 0), cB + kstep, voffB); PG8_STAGE(PG8_SA(1, 0), cA + kstepA, voffA); PG8_STAGE(PG8_SB(1, 1), cB + hstepB + kstep, voffB);
  PG8_WAIT_V(6); PG8_BAR;
  for (;;) {
    const bool has_next = S.next(ui + 1, nxt);
    const char* nA = has_next ? (const char*)g.A + (size_t)nxt.pm * tstepA + (size_t)nxt.pn * pnA : cA; const char* nB = has_next ? (const char*)g.Bt + (size_t)nxt.pn * tstepB : cB;
    for (int t = 0; t < nt; t += 2) {
      const bool last = (t == nt - 2);
      const char* a1 = cA + (size_t)(t + 1) * kstepA;
      const char* a2 = last ? nA : cA + (size_t)(t + 2) * kstepA; const char* b2 = last ? nB : cB + (size_t)(t + 2) * kstep;
      const char* a3 = a2 + kstepA; const char* b3 = b2 + kstep;
      PG8_LDB(B0, 0, 0); PG8_LDB(B1, 0, 1); PG8_SCHED; PG8_LDA(At, 0, 0); PG8_STAGE(PG8_SA(1, 1), a1 + hstepA, voffA);
      PG8_WAIT_V(8); PG8_WAIT_L(0); PG8_BAR; PG8_MMA(0, 0, At, B0); PG8_MMA(0, 1, At, B1); PG8_BAR; PG8_SCHED;
      PG8_LDA(At, 0, 1); PG8_STAGE(PG8_SB(0, 0), b2, voffB); PG8_STAGE(PG8_SB(0, 1), b2 + hstepB, voffB); PG8_STAGE(PG8_SA(0, 0), a2, voffA);
      PG8_WAIT_V(8); PG8_WAIT_L(0); PG8_BAR; PG8_MMA(1, 0, At, B0); PG8_MMA(1, 1, At, B1); PG8_BAR; PG8_SCHED;
      PG8_LDB(B0, 1, 0); PG8_LDB(B1, 1, 1); PG8_SCHED; PG8_LDA(At, 1, 0); PG8_STAGE(PG8_SA(0, 1), a2 + hstepA, voffA);
      PG8_WAIT_V(8); PG8_WAIT_L(0); PG8_BAR; PG8_MMA(0, 0, At, B0); PG8_MMA(0, 1, At, B1); PG8_BAR; PG8_SCHED;
      PG8_LDA(At, 1, 1); PG8_STAGE(PG8_SB(1, 0), b3, voffB); PG8_STAGE(PG8_SB(1, 1), b3 + hstepB, voffB); PG8_STAGE(PG8_SA(1, 0), a3, voffA);
      PG8_WAIT_V(8); PG8_WAIT_L(0); PG8_BAR; PG8_MMA(1, 0, At, B0); PG8_MMA(1, 1, At, B1); PG8_BAR; PG8_SCHED;
    }
    if (wr == 0) PG8_BAR;
    E(acc, cur, wr, wc, fr, fq);
    if (!has_next) break;
#pragma unroll
    for (int a = 0; a < 2; ++a)
#pragma unroll
      for (int b = 0; b < 2; ++b)
#pragma unroll
        for (int m = 0; m < 4; ++m)
#pragma unroll
          for (int n = 0; n < 2; ++n) acc[a][b][m][n] = (f32x4){0.f, 0.f, 0.f, 0.f};
    cur = nxt; cA = nA; cB = nB; ++ui;
    if (wr == 1) PG8_BAR;
  }
  PG8_WAIT_V(0);
  PG8_BAR;
#undef PG8_SA
#undef PG8_SB
#undef PG8_STAGE
#undef PG8_LDA
#undef PG8_LDB
#undef PG8_MMA
#undef PG8_WAIT_V
#undef PG8_WAIT_L
#undef PG8_BAR
#undef PG8_SCHED
}
struct Job { const bf16_t* A; const bf16_t* Bt; long lda; int M, N, K, mode; bf16_t* O; long ldc; const bf16_t* T; const float* slat; const float* sctx; float* dlat; float* dctx; const float* modg;
             long segstride, pnstrideA; int rows; float* ssq; bf16_t* O2; };
struct EpiRT {
  static constexpr bool PERM = true;
  int mode; bf16_t* O; long ldc; const bf16_t* T; const float* slat; const float* sctx; float* dlat; float* dctx; const float* modg; int rows; float* ssq; bf16_t* O2;
  DEV void operator()(const f32x4 (&acc)[2][2][4][2], const Unit& u, int wr, int wc, int fr, int fq) const {
    const int row00 = u.pm * BM + wr * 64 + fr, col00 = u.pn * BM + wc * 32 + 8 * fq;
    if (mode == 5) {
      const bool lat = u.pm * BM < MLAT; const int bi = lat ? (u.pm * BM) >> 12 : 8;
      const float* sb = lat ? slat : sctx - (size_t)MLAT * 1024; float* db = lat ? dlat : dctx - (size_t)MLAT * 1024;
      f32x4 g[2][2];
#pragma unroll
      for (int bj = 0; bj < 2; ++bj) { const float* mg = modg + (size_t)bi * 6144 + col00 + bj * HALF; g[bj][0] = *(const f32x4*)mg; g[bj][1] = *(const f32x4*)(mg + 4); }
#pragma unroll
      for (int ai = 0; ai < 2; ++ai)
#pragma unroll
        for (int mp = 0; mp < 2; ++mp) {
          f32x4 x[4][2];
#pragma unroll
          for (int c = 0; c < 4; ++c) { const float* s = sb + (size_t)(row00 + ai * HALF + (2 * mp + (c >> 1)) * 16) * 1024 + col00 + (c & 1) * HALF; x[c][0] = *(const f32x4*)s; x[c][1] = *(const f32x4*)(s + 4); }
#pragma unroll
          for (int c = 0; c < 4; ++c) { float* d = db + (size_t)(row00 + ai * HALF + (2 * mp + (c >> 1)) * 16) * 1024 + col00 + (c & 1) * HALF;
            *(f32x4*)d = x[c][0] + g[c & 1][0] * acc[ai][c & 1][2 * mp + (c >> 1)][0]; *(f32x4*)(d + 4) = x[c][1] + g[c & 1][1] * acc[ai][c & 1][2 * mp + (c >> 1)][1]; }
        }
      return;
    }
    if (mode >= 1 && mode <= 3) {
#pragma unroll
      for (int ai = 0; ai < 2; ++ai)
#pragma unroll
        for (int mp = 0; mp < 2; ++mp) {
          u32x4 tv[4], ov[4];
#pragma unroll
          for (int c = 0; c < 4; ++c) {
            const size_t row = (size_t)(row00 + ai * HALF + (2 * mp + (c >> 1)) * 16); const int col = col00 + (c & 1) * HALF;
            if (mode >= 2) tv[c] = *(const u32x4*)(T + row * 1024 + col);
            if (mode != 2) ov[c] = *(const u32x4*)(O + row * ldc + col);
          }
#pragma unroll
          for (int c = 0; c < 4; ++c) {
            const size_t row = (size_t)(row00 + ai * HALF + (2 * mp + (c >> 1)) * 16); const int col = col00 + (c & 1) * HALF;
            f32x4 v0 = acc[ai][c & 1][2 * mp + (c >> 1)][0], v1 = acc[ai][c & 1][2 * mp + (c >> 1)][1];
#pragma unroll
            for (int r = 0; r < 4; ++r) { v0[r] = sigm(v0[r]); v1[r] = sigm(v1[r]); }
            if (mode >= 2) { const u32x4 t = tv[c];
              v0[0] *= bflo(t.x); v0[1] *= bfhi(t.x); v0[2] *= bflo(t.y); v0[3] *= bfhi(t.y); v1[0] *= bflo(t.z); v1[1] *= bfhi(t.z); v1[2] *= bflo(t.w); v1[3] *= bfhi(t.w); }
            if (mode == 1) { const u32x4 o = ov[c];
              v0[0] *= bflo(o.x); v0[1] *= bfhi(o.x); v0[2] *= bflo(o.y); v0[3] *= bfhi(o.y); v1[0] *= bflo(o.z); v1[1] *= bfhi(o.z); v1[2] *= bflo(o.w); v1[3] *= bfhi(o.w); }
            if (mode == 3) { const u32x4 o = ov[c];
              v0[0] += bflo(o.x); v0[1] += bfhi(o.x); v0[2] += bflo(o.y); v0[3] += bfhi(o.y); v1[0] += bflo(o.z); v1[1] += bfhi(o.z); v1[2] += bflo(o.w); v1[3] += bfhi(o.w); }
            *(u32x4*)(O + row * ldc + col) = (u32x4){pk_bf16(v0[0], v0[1]), pk_bf16(v0[2], v0[3]), pk_bf16(v1[0], v1[1]), pk_bf16(v1[2], v1[3])};
          }
        }
      return;
    }
    float rsv[2][4];
    if (mode >= 6) {
#pragma unroll
      for (int ai = 0; ai < 2; ++ai)
#pragma unroll
        for (int m = 0; m < 4; ++m) { const int row = row00 + ai * HALF + m * 16; rsv[ai][m] = row < rows ? ssq[(size_t)row * 2 + (mode - 6)] : 1.0f; }
#pragma unroll
      for (int ai = 0; ai < 2; ++ai)
#pragma unroll
        for (int m = 0; m < 4; ++m) rsv[ai][m] = rsqrtf(rsv[ai][m] * (1.0f / 256.0f) + EPSN);
    }
#pragma unroll
    for (int ai = 0; ai < 2; ++ai)
#pragma unroll
      for (int m = 0; m < 4; ++m) {
        const int row = row00 + ai * HALF + m * 16;
#pragma unroll
        for (int bj = 0; bj < 2; ++bj) {
          const int col = col00 + bj * HALF;
          f32x4 v0 = acc[ai][bj][m][0], v1 = acc[ai][bj][m][1];
          if (mode >= 6) {
            if (row < rows) {
              int bb, tok; const bool lat = row < MLAT;
              if (lat) { bb = row >> 12; tok = row & 4095; } else { const int cr = row - MLAT; bb = cr >> 8; tok = cr & 255; }
              if (mode == 6) {
                const float rs = rsv[ai][m] * (0.10206207261596577f * 1.4426950408889634f);
                const int h = col / 96, d = col - h * 96;
                v0 = v0 * rs; v1 = v1 * rs;
                if (d >= 64 && lat) {
                  const int pp = d - 64, a = pp >> 4, f0 = (pp & 15) >> 1, pos = a ? (tok & 63) : (tok >> 6);
                  const float pr = (float)pos * 0.15915494309189535f;
                  const float i0 = f0 ? 0.01f : 1.0f, i1 = f0 ? 0.0031622776601683794f : 0.31622776601683794f, i2 = f0 ? 0.001f : 0.1f, i3 = f0 ? 0.00031622776601683794f : 0.031622776601683794f;
                  const float2 c0 = make_float2(__builtin_amdgcn_cosf(pr * i0), __builtin_amdgcn_sinf(pr * i0)), c1 = make_float2(__builtin_amdgcn_cosf(pr * i1), __builtin_amdgcn_sinf(pr * i1));
                  const float2 c2 = make_float2(__builtin_amdgcn_cosf(pr * i2), __builtin_amdgcn_sinf(pr * i2)), c3 = make_float2(__builtin_amdgcn_cosf(pr * i3), __builtin_amdgcn_sinf(pr * i3));
                  const float t0 = v0[0] * c0.x - v0[1] * c0.y, t1 = v0[1] * c0.x + v0[0] * c0.y, t2 = v0[2] * c1.x - v0[3] * c1.y, t3 = v0[3] * c1.x + v0[2] * c1.y;
                  const float t4 = v1[0] * c2.x - v1[1] * c2.y, t5 = v1[1] * c2.x + v1[0] * c2.y, t6 = v1[2] * c3.x - v1[3] * c3.y, t7 = v1[3] * c3.x + v1[2] * c3.y;
                  v0 = (f32x4){t0, t1, t2, t3}; v1 = (f32x4){t4, t5, t6, t7};
                }
                const int qrow = lat ? tok : 4096 + tok;
                *(u32x4*)(O + ((size_t)(bb * 8 + h) * NKEY + qrow) * 96 + d) = (u32x4){pk_bf16(v0[0], v0[1]), pk_bf16(v0[2], v0[3]), pk_bf16(v1[0], v1[1]), pk_bf16(v1[2], v1[3])};
              } else {
                const float rs = rsv[ai][m];
                const int h = col >> 7, dd = col & 127, key = lat ? 256 + tok : tok;
                v0 = v0 * rs; v1 = v1 * rs;
                const unsigned w0 = pk_bf16(v0[0], v0[1]), w1 = pk_bf16(v0[2], v0[3]), w2 = pk_bf16(v1[0], v1[1]), w3 = pk_bf16(v1[2], v1[3]);
                if (dd < 64) {
                  *(u32x4*)(O + ((size_t)(bb * 8 + h) * NKEY + key) * 96 + dd) = (u32x4){w0, w1, w2, w3};
                } else {
                  const int tt = key & 31, pos = ((tt >> 2) & 3) * 8 + (tt >> 4) * 4 + (tt & 3);
                  bf16_t* vp = O2 + ((size_t)(bb * 8 + h) * 64 + (dd - 64)) * NKEY + (key & ~31) + pos;
                  vp[0] = (bf16_t)(w0 & 0xffff); vp[NKEY] = (bf16_t)(w0 >> 16); vp[2 * NKEY] = (bf16_t)(w1 & 0xffff); vp[3 * NKEY] = (bf16_t)(w1 >> 16);
                  vp[4 * NKEY] = (bf16_t)(w2 & 0xffff); vp[5 * NKEY] = (bf16_t)(w2 >> 16); vp[6 * NKEY] = (bf16_t)(w3 & 0xffff); vp[7 * NKEY] = (bf16_t)(w3 >> 16);
                }
              }
            }
          } else {
            if (mode == 4) {
#pragma unroll
              for (int r = 0; r < 4; ++r) { const float a = fmaxf(v0[r], 0.f), b = fmaxf(v1[r], 0.f); v0[r] = a * a; v1[r] = b * b; }
            }
            if (row < rows) *(u32x4*)(O + (size_t)row * ldc + col) = (u32x4){pk_bf16(v0[0], v0[1]), pk_bf16(v0[2], v0[3]), pk_bf16(v1[0], v1[1]), pk_bf16(v1[2], v1[3])};
          }
        }
        if (mode == 0 && ssq != nullptr && u.pn < 2) {
          float s = 0.f;
#pragma unroll
          for (int bj = 0; bj < 2; ++bj)
#pragma unroll
            for (int n = 0; n < 2; ++n) { const f32x4 v = acc[ai][bj][m][n]; s += v[0] * v[0] + v[1] * v[1] + v[2] * v[2] + v[3] * v[3]; }
          s += __shfl_xor(s, 16); s += __shfl_xor(s, 32);
          if (fq == 0) atomicAdd(ssq + (size_t)row * 2 + u.pn, s);
        }
      }
  }
};
}
DEV void run_job(char* smem_base, const pg8::Job& j) {
  pg8::Gemm g; g.A = j.A; g.Bt = j.Bt; g.lda = j.lda; g.M = j.M; g.N = j.N; g.K = j.K; g.segstride = j.segstride; g.pnstrideA = j.pnstrideA;
  pg8::StaticOrder S; S.init(j.M, j.N, (int)gridDim.x, (int)blockIdx.x);
  pg8::EpiRT E; E.mode = j.mode; E.O = j.O; E.ldc = j.ldc; E.T = j.T; E.slat = j.slat; E.sctx = j.sctx; E.dlat = j.dlat; E.dctx = j.dctx; E.modg = j.modg; E.rows = j.rows; E.ssq = j.ssq; E.O2 = j.O2;
  pg8::gemm_phase<pg8::EpiRT>((PG8_LAS unsigned char*)smem_base, g, S, E);
}

DEV void ph_ada(const P& p, char* smem) {
  const int tid = get_tid();
  float* mod = (float*)(p.ws + OFF_MOD);
  if (vbid() < 192) {
    smem += vboff();
    float* sc = (float*)smem;
    for (int i = tid; i < 9 * 1024; i += 256) { const int bi = i >> 10, k = i & 1023; const float v = bi < 8 ? p.c[bi * 1024 + k] : p.c_ctx[k]; sc[i] = v * sigm(v); }
    __syncthreads();
    float* red = (float*)(smem + 36864);
    for (int item = vbid(); item < 192; item += vgrid()) {
      const int l = item / 96, n0 = (item % 96) * 64, nn = tid & 63, kq = tid >> 6;
      float acc[9];
#pragma unroll
      for (int b = 0; b < 9; ++b) acc[b] = 0.f;
      const float* w = p.ada_w + (size_t)l * 1024 * 6144 + n0 + nn;
      for (int k = kq * 256; k < kq * 256 + 256; ++k) {
        const float wv = w[(size_t)k * 6144];
#pragma unroll
        for (int b = 0; b < 9; ++b) acc[b] += sc[b * 1024 + k] * wv;
      }
#pragma unroll
      for (int b = 0; b < 9; ++b) red[(kq * 9 + b) * 64 + nn] = acc[b];
      __syncthreads();
      for (int e = tid; e < 9 * 64; e += 256) {
        const int b = e >> 6, n = e & 63;
        const float v = red[(0 * 9 + b) * 64 + n] + red[(1 * 9 + b) * 64 + n] + red[(2 * 9 + b) * 64 + n] + red[(3 * 9 + b) * 64 + n];
        mod[((size_t)l * 9 + b) * 6144 + n0 + n] = v + p.ada_b[l * 6144 + n0 + n];
      }
      __syncthreads();
    }
  } else if (vbid() == 192) {
    float2* rope = (float2*)(p.ws + OFF_ROPE);
    for (int e = tid; e < 512; e += 256) {
      const int pos = e >> 3, f = e & 7;
      const float inv = exp2f(-(float)f * 0.125f * 13.287712379549449f);
      float s, c; sincos_d((double)((float)pos * inv), s, c);
      rope[e] = make_float2(c, s);
    }
  }
}

DEV int map_col(int mode, int n) {
  if (mode == 0) return n;
  if (mode == 1) {
    if (n < 512) return n;
    if (n < 2560) return n + 32;
    if (n < 2592) return 512 + (n - 2560);
    if (n < 2816) return -1;
    return 2592 + (n - 2816);
  }
  if (mode == 2) {
    const int tile = n >> 7, nb = n & 127, wn = nb >> 6, j = (nb >> 4) & 3, cc = nb & 15;
    return (j < 2) ? tile * 64 + wn * 32 + j * 16 + cc : 1024 + tile * 64 + wn * 32 + (j - 2) * 16 + cc;
  }
  const int h = n / 96, d = n % 96;
  if (d < 64) return n;
  const int pp = d - 64, a = pp >> 4, f = (pp & 15) >> 1, half = pp & 1;
  return h * 96 + 64 + a * 16 + half * 8 + f;
}
DEV void cvt_tile(const float* __restrict__ src, int K, int Nsrc, bf16_t* __restrict__ dst, int mode, const float* __restrict__ gain, int nt, int kt, char* smem) {
  float* tile = (float*)smem + (vboff() >> 2);
  const int tid = get_tid();
  const int n0 = nt * 64, k0 = kt * 64;
  if (mode == 3) {
    const int r = tid >> 6, c = tid & 63;
    const int sn = map_col(mode, n0 + c);
#pragma unroll 4
    for (int i = 0; i < 16; ++i) {
      const int k = k0 + r + 4 * i;
      float v = sn >= 0 ? src[(size_t)k * Nsrc + sn] : 0.f;
      if (gain) v *= gain[k];
      tile[(r + 4 * i) * 65 + c] = v;
    }
  } else {
    const int r = tid >> 4, c4 = (tid & 15) * 4;
    const int sn = map_col(mode, n0 + c4);
#pragma unroll
    for (int i = 0; i < 4; ++i) {
      const int k = k0 + r + 16 * i;
      f32x4 v = sn >= 0 ? *(const f32x4*)(src + (size_t)k * Nsrc + sn) : (f32x4){0.f, 0.f, 0.f, 0.f};
      if (gain) v = v * gain[k];
      float* t = tile + (r + 16 * i) * 65 + c4;
      t[0] = v[0]; t[1] = v[1]; t[2] = v[2]; t[3] = v[3];
    }
  }
  __syncthreads();
  {
    const int n = tid >> 2, kp = (tid & 3) * 16;
    u32x4 w0, w1;
    w0.x = pk_bf16(tile[(kp + 0) * 65 + n], tile[(kp + 1) * 65 + n]);   w0.y = pk_bf16(tile[(kp + 2) * 65 + n], tile[(kp + 3) * 65 + n]);
    w0.z = pk_bf16(tile[(kp + 4) * 65 + n], tile[(kp + 5) * 65 + n]);   w0.w = pk_bf16(tile[(kp + 6) * 65 + n], tile[(kp + 7) * 65 + n]);
    w1.x = pk_bf16(tile[(kp + 8) * 65 + n], tile[(kp + 9) * 65 + n]);   w1.y = pk_bf16(tile[(kp + 10) * 65 + n], tile[(kp + 11) * 65 + n]);
    w1.z = pk_bf16(tile[(kp + 12) * 65 + n], tile[(kp + 13) * 65 + n]); w1.w = pk_bf16(tile[(kp + 14) * 65 + n], tile[(kp + 15) * 65 + n]);
    u32x4* d = (u32x4*)(dst + (size_t)(n0 + n) * K + k0 + kp);
    d[0] = w0; d[1] = w1;
  }
  __syncthreads();
}
DEV void cvt_item(const P& p, int l, int it, char* smem) {
  char* ws = p.ws;
  if (it < 1472) { cvt_tile(p.w_in + (size_t)l * 1024 * 5664, 1024, 5664, (bf16_t*)(ws + OFF_WIN), 1, nullptr, it / 16, it % 16, smem); return; }
  it -= 1472;
  if (it < 48) { cvt_tile(p.w_uq + (size_t)l * 256 * 768, 256, 768, (bf16_t*)(ws + OFF_WUQ), 3, p.q_norm + l * 256, it / 4, it % 4, smem); return; }
  it -= 48;
  if (it < 64) { cvt_tile(p.w_ukv + (size_t)l * 256 * 1024, 256, 1024, (bf16_t*)(ws + OFF_WUKV), 0, p.kv_norm + l * 256, it / 4, it % 4, smem); return; }
  it -= 64;
  if (it < 128) { cvt_tile(p.w_o + (size_t)l * 512 * 1024, 512, 1024, (bf16_t*)(ws + OFF_WO), 0, nullptr, it / 8, it % 8, smem); return; }
  it -= 128;
  if (it < 128) { cvt_tile(p.conv_w_out + (size_t)l * 512 * 1024, 512, 1024, (bf16_t*)(ws + OFF_WC), 0, nullptr, it / 8, it % 8, smem); return; }
  it -= 128;
  if (it < 256) { cvt_tile(p.w_glu + (size_t)l * 512 * 2048, 512, 2048, (bf16_t*)(ws + OFF_WGLU), 0, nullptr, it / 8, it % 8, smem); return; }
  it -= 256;
  if (it < 256) { cvt_tile(p.w_out + (size_t)l * 1024 * 1024, 1024, 1024, (bf16_t*)(ws + OFF_WOUT), 0, nullptr, it / 16, it % 16, smem); return; }
  it -= 256;
  if (it < 1024) { cvt_tile(p.w1 + (size_t)l * 1024 * 4096, 1024, 4096, (bf16_t*)(ws + OFF_W1), 0, nullptr, it / 16, it % 16, smem); return; }
  it -= 1024;
  cvt_tile(p.w2 + (size_t)l * 4096 * 1024, 4096, 1024, (bf16_t*)(ws + OFF_W2), 0, nullptr, it / 64, it % 64, smem);
}
constexpr int N_CVT = 4400;

struct Disc { double dt; float are, aim, fre, fim; };
DEV Disc s5_disc(const P& p, int l, int dir, int g, int pp) {
  Disc d; const int gi = (l * 2 + dir) * 32 + g;
  d.dt = (double)expf(p.log_dt[gi]); d.are = p.a_re[gi * 64 + pp]; d.aim = p.a_im[gi * 64 + pp];
  const float mag = __expf((float)(d.dt * (double)d.are)); float sn, cs; sincos_d(d.dt * (double)d.aim, sn, cs);
  const float abr = mag * cs, abi = mag * sn, den = d.are * d.are + d.aim * d.aim, nr = abr - 1.0f, ni = abi;
  d.fre = (nr * d.are + ni * d.aim) / den; d.fim = (ni * d.are - nr * d.aim) / den;
  return d;
}
DEV float2 cpow(const Disc& d, int e) {
  const float mag = __expf((float)((double)e * d.dt * (double)d.are)); float sn, cs; sincos_d((double)e * d.dt * (double)d.aim, sn, cs);
  return make_float2(mag * cs, mag * sn);
}
DEV float2 cmulf(float2 a, float2 b) { return make_float2(a.x * b.x - a.y * b.y, a.x * b.y + a.y * b.x); }

DEV void ktab_item(const P& p, int l, int it, char* smem) {
  const int tid = get_tid();
  const int lb = it & 7, dir = (it >> 3) & 1, g = it >> 4, gi = (l * 2 + dir) * 32 + g;
  smem += vboff();
  float2* CW = (float2*)smem;
  float2* BB = (float2*)(smem + 32768);
  float2* WL = (float2*)(smem + 40960);
  float2* FL = (float2*)(smem + 43008);
  {
    const int li = tid >> 6, pp = tid & 63;
    const Disc d = s5_disc(p, l, dir, g, pp);
    WL[tid] = cpow(d, lb * 4 + li);
    if (li == 0) FL[pp] = make_float2(d.fre, d.fim);
  }
  __syncthreads();
  for (int e = tid; e < 4096; e += 256) {
    const int li = e >> 10, co = (e >> 6) & 15, pp = e & 63;
    const float2 c = make_float2(p.c_re[((size_t)gi * 16 + co) * 64 + pp], p.c_im[((size_t)gi * 16 + co) * 64 + pp]);
    CW[e] = cmulf(c, WL[li * 64 + pp]);
  }
  for (int e = tid; e < 1024; e += 256) {
    const int pp = e >> 4;
    const float2 b = make_float2(p.b_re[(size_t)gi * 1024 + e], p.b_im[(size_t)gi * 1024 + e]);
    BB[e] = cmulf(FL[pp], b);
  }
  __syncthreads();
  float* ktab = (float*)(p.ws + OFF_KTAB);
  const int co = tid >> 4, ci = tid & 15;
#pragma unroll
  for (int li = 0; li < 4; ++li) {
    float acc = 0.f;
    for (int pp = 0; pp < 64; ++pp) { const float2 cw = CW[(li * 16 + co) * 64 + pp], bb = BB[pp * 16 + ci]; acc += cw.x * bb.x - cw.y * bb.y; }
    ktab[(((size_t)g * 2 + dir) * 32 + lb * 4 + li) * 256 + co * 16 + ci] = acc;
  }
  __syncthreads();
}
DEV void ef_item(const P& p, int l, int it) {
  const int g = it >> 4, id = (it & 15) * 256 + get_tid();
  const int t = id & 31, pp = (id >> 5) & 63, dir = id >> 11, gi = (l * 2 + dir) * 32 + g;
  const Disc d = s5_disc(p, l, dir, g, pp);
  const float2 we = cpow(d, dir == 0 ? t + 1 : 32 - t), wf = cpow(d, dir == 0 ? 31 - t : t);
  unsigned* Et = (unsigned*)(p.ws + OFF_ET) + (size_t)g * 512 * 128;
  bf16_t* Ft = (bf16_t*)(p.ws + OFF_FT) + (size_t)g * 256 * 512;
#pragma unroll
  for (int c = 0; c < 16; ++c) {
    const float2 cc = make_float2(p.c_re[((size_t)gi * 16 + c) * 64 + pp], p.c_im[((size_t)gi * 16 + c) * 64 + pp]);
    const float2 cw = cmulf(cc, we);
    Et[(size_t)(t * 16 + c) * 128 + dir * 64 + pp] = pk_bf16(cw.x, -cw.y);
  }
  const float2 f = make_float2(d.fre, d.fim);
  unsigned fr[8], fi[8];
#pragma unroll
  for (int c2 = 0; c2 < 8; ++c2) {
    const size_t bi = ((size_t)gi * 64 + pp) * 16 + c2 * 2;
    const float2 v0 = cmulf(wf, cmulf(f, make_float2(p.b_re[bi], p.b_im[bi])));
    const float2 v1 = cmulf(wf, cmulf(f, make_float2(p.b_re[bi + 1], p.b_im[bi + 1])));
    fr[c2] = pk_bf16(v0.x, v1.x); fi[c2] = pk_bf16(v0.y, v1.y);
  }
  u32x4* r0 = (u32x4*)(Ft + (size_t)(dir * 128 + pp * 2) * 512 + t * 16);
  u32x4* r1 = (u32x4*)(Ft + (size_t)(dir * 128 + pp * 2 + 1) * 512 + t * 16);
  r0[0] = (u32x4){fr[0], fr[1], fr[2], fr[3]}; r0[1] = (u32x4){fr[4], fr[5], fr[6], fr[7]};
  r1[0] = (u32x4){fi[0], fi[1], fi[2], fi[3]}; r1[1] = (u32x4){fi[4], fi[5], fi[6], fi[7]};
}
DEV void mt_item(const P& p, int l, int it) {
  const int g = it >> 7, id = (it & 127) * 256 + get_tid();
  const int k8 = id & 63, n = id >> 6, ti = k8 >> 1, ci0 = (k8 & 1) * 8, to = n >> 4, co = n & 15;
  const float* ktab = (const float*)(p.ws + OFF_KTAB);
  float v[8];
  if (to != ti) {
    const int dir = to > ti ? 0 : 1, lag = to > ti ? to - ti : ti - to;
    const f32x4* s = (const f32x4*)(ktab + (((size_t)g * 2 + dir) * 32 + lag) * 256 + co * 16 + ci0);
    const f32x4 a = s[0], b = s[1];
    v[0] = a[0]; v[1] = a[1]; v[2] = a[2]; v[3] = a[3]; v[4] = b[0]; v[5] = b[1]; v[6] = b[2]; v[7] = b[3];
  } else {
    const f32x4* s0 = (const f32x4*)(ktab + (((size_t)g * 2 + 0) * 32) * 256 + co * 16 + ci0);
    const f32x4* s1 = (const f32x4*)(ktab + (((size_t)g * 2 + 1) * 32) * 256 + co * 16 + ci0);
    const f32x4 a = s0[0] + s1[0], b = s0[1] + s1[1];
    v[0] = a[0]; v[1] = a[1]; v[2] = a[2]; v[3] = a[3]; v[4] = b[0]; v[5] = b[1]; v[6] = b[2]; v[7] = b[3];
    const float dd = p.s5_d[l * 512 + g * 16 + co];
#pragma unroll
    for (int e = 0; e < 8; ++e) if (ci0 + e == co) v[e] += dd;
  }
  u32x4 w; w.x = pk_bf16(v[0], v[1]); w.y = pk_bf16(v[2], v[3]); w.z = pk_bf16(v[4], v[5]); w.w = pk_bf16(v[6], v[7]);
  *(u32x4*)((bf16_t*)(p.ws + OFF_MT) + ((size_t)g * 512 + n) * 512 + k8 * 8) = w;
}

DEV void norm_rows(const P& p, const float* lat, const float* ctxp, int nrows, const float* gain, const float* modl, int ishift, int iscale) {
  const int lane = get_tid() & 63, wid = get_tid() >> 6;
  bf16_t* XN = (bf16_t*)(p.ws + OFF_XN);
  for (int item = vbid(); item < nrows / 8; item += vgrid()) {
    const int row0 = item * 8 + wid * 2;
    f32x4 v[2][4]; float ss[2];
#pragma unroll
    for (int q = 0; q < 2; ++q) {
      const int row = row0 + q;
      const float* src = row < MLAT ? lat + (size_t)row * 1024 : ctxp + (size_t)(row - MLAT) * 1024;
#pragma unroll
      for (int i = 0; i < 4; ++i) v[q][i] = ((const f32x4*)src)[lane + 64 * i];
    }
#pragma unroll
    for (int q = 0; q < 2; ++q) {
      float s = 0.f;
#pragma unroll
      for (int i = 0; i < 4; ++i) s += v[q][i][0] * v[q][i][0] + v[q][i][1] * v[q][i][1] + v[q][i][2] * v[q][i][2] + v[q][i][3] * v[q][i][3];
      ss[q] = wave_sum(s);
    }
#pragma unroll
    for (int q = 0; q < 2; ++q) {
      const int row = row0 + q, bi = row < MLAT ? row >> 12 : 8;
      const float rstd = rsqrtf(ss[q] * (1.0f / 1024.0f) + EPSN);
      const float* msh = modl + ((size_t)bi * 6 + ishift) * 1024; const float* msc = modl + ((size_t)bi * 6 + iscale) * 1024;
#pragma unroll
      for (int i = 0; i < 4; ++i) {
        const int col = (lane + 64 * i) * 4;
        const f32x4 g = *(const f32x4*)(gain + col), sh = *(const f32x4*)(msh + col), sc = *(const f32x4*)(msc + col);
        const f32x4 y = v[q][i] * rstd * g * (sc + 1.0f) + sh;
        *(u32x2*)(XN + (size_t)row * 1024 + col) = (u32x2){pk_bf16(y[0], y[1]), pk_bf16(y[2], y[3])};
      }
    }
  }
}
DEV void ph_final(const P& p) {
  const int lane = get_tid() & 63, wid = get_tid() >> 6;
  for (int item = vbid(); item < MLAT / 8; item += vgrid()) {
    const int row0 = item * 8 + wid * 2;
    f32x4 v[2][4]; float ss[2];
#pragma unroll
    for (int q = 0; q < 2; ++q)
#pragma unroll
      for (int i = 0; i < 4; ++i) v[q][i] = ((const f32x4*)(p.out + (size_t)(row0 + q) * 1024))[lane + 64 * i];
#pragma unroll
    for (int q = 0; q < 2; ++q) {
      float s = 0.f;
#pragma unroll
      for (int i = 0; i < 4; ++i) s += v[q][i][0] * v[q][i][0] + v[q][i][1] * v[q][i][1] + v[q][i][2] * v[q][i][2] + v[q][i][3] * v[q][i][3];
      ss[q] = wave_sum(s);
    }
#pragma unroll
    for (int q = 0; q < 2; ++q) {
      const float rstd = rsqrtf(ss[q] * (1.0f / 1024.0f) + EPSN);
#pragma unroll
      for (int i = 0; i < 4; ++i) { const int col = (lane + 64 * i) * 4; const f32x4 g = *(const f32x4*)(p.norm_final + col); ((f32x4*)(p.out + (size_t)(row0 + q) * 1024))[lane + 64 * i] = v[q][i] * rstd * g; }
    }
  }
}

DEV void ph_prep(const P& p, int l, char* smem) {
  for (int r_ = 0, nr_ = rounds_of(N_CVT); r_ < nr_; ++r_) { int it = vbid() + r_ * vgrid(); it = it < N_CVT ? it : N_CVT - 1; cvt_item(p, l, it, smem); }
  for (int r_ = 0, nr_ = rounds_of(512); r_ < nr_; ++r_) { int it = vbid() + r_ * vgrid(); it = it < 512 ? it : 511; ktab_item(p, l, it, smem); }
  for (int it = vbid(); it < 512; it += vgrid()) ef_item(p, l, it);
  { float* ssq = (float*)(p.ws + OFF_SSQ); const int step = vgrid() * 256; int i = vbid() * 256 + get_tid();
#pragma unroll
    for (int e = 0; e < 4; ++e) { if (i < MALL * 2) ssq[i] = 0.f; i += step; } }
  const float* modl = (const float*)(p.ws + OFF_MOD) + (size_t)l * 9 * 6144;
  if (l == 0) norm_rows(p, p.x, p.ctx, MALL, p.norm_mix, modl, 0, 1);
  else norm_rows(p, p.out, (const float*)(p.ws + OFF_XC), MALL, p.norm_mix + 1024, modl, 0, 1);
}

DEV void ph_in(const P& p, int l, char* smem) {
  for (int it = vbid(); it < 4096; it += vgrid()) mt_item(p, l, it);
}

DEV void rms_rows(const bf16_t* zb, int row0, int rmax, float* srstd) {
  const int tid = get_tid(), r = tid >> 1, half = tid & 1;
  int row = row0 + r; row = row < rmax ? row : rmax - 1;
  const u32x4* q = (const u32x4*)(zb + (size_t)row * LDZ + half * 128);
  float ss = 0.f;
#pragma unroll 4
  for (int i = 0; i < 16; ++i) {
    const u32x4 w = q[i];
    ss += bflo(w.x) * bflo(w.x) + bfhi(w.x) * bfhi(w.x) + bflo(w.y) * bflo(w.y) + bfhi(w.y) * bfhi(w.y) + bflo(w.z) * bflo(w.z) + bfhi(w.z) * bfhi(w.z) + bflo(w.w) * bflo(w.w) + bfhi(w.w) * bfhi(w.w);
  }
  ss += __shfl_xor(ss, 1);
  if (!half) srstd[r] = rsqrtf(ss * (1.0f / 256.0f) + EPSN);
  __syncthreads();
}

DEV void ph_mid(const P& p, int l, bool need, char* smem) {
  const int tid = get_tid(), lane = tid & 63, wid = tid >> 6, wm = wid >> 1, wn = wid & 1, l15 = lane & 15, lq = lane >> 4;
  bf16_t* Z = (bf16_t*)(p.ws + OFF_Z);
  bf16_t* Qb = (bf16_t*)(p.ws + OFF_Q); bf16_t* Kb = (bf16_t*)(p.ws + OFF_K); bf16_t* Vt = (bf16_t*)(p.ws + OFF_VT);
  float* srstd = (float*)(smem + 65536) + (vboff() >> 2);
  const float2* rope = (const float2*)(p.ws + OFF_ROPE);
  for (int it = vbid(); it < MALL / 16; it += vgrid()) {
    const int row = it * 16 + (tid >> 4), e = tid & 15, a = e >> 3, f = e & 7;
    const bf16_t* zp = Z + (size_t)row * LDZ + ZPE + a * 16 + f;
    float x0 = __uint_as_float((unsigned)zp[0] << 16), x1 = __uint_as_float((unsigned)zp[8] << 16);
    int b, key;
    if (row < MLAT) {
      b = row >> 12; const int n = row & 4095; key = 256 + n;
      const float2 cs = rope[(a ? (n & 63) : (n >> 6)) * 8 + f];
      const float t0 = x0 * cs.x - x1 * cs.y, t1 = x1 * cs.x + x0 * cs.y; x0 = t0; x1 = t1;
    } else { const int cr = row - MLAT; b = cr >> 8; key = cr & 255; }
    const unsigned w = pk_bf16(x0, x1);
#pragma unroll
    for (int h = 0; h < 8; ++h) *(unsigned*)(Kb + ((size_t)(b * 8 + h) * NKEY + key) * 96 + 64 + a * 16 + f * 2) = w;
  }
}

DEV void ph_carry(const P& p, int l, bool need) {
  const int tid = get_tid();
  bf16_t* Z = (bf16_t*)(p.ws + OFF_Z);
  for (int it = vbid(); it < 128; it += vgrid()) {
    const int idx = it * 256 + tid, pp = idx & 63, dir = (idx >> 6) & 1, g = (idx >> 7) & 31, b = idx >> 12;
    const Disc d = s5_disc(p, l, dir, g, pp);
    const float2 at = cpow(d, 32);
    unsigned* S = (unsigned*)(p.ws + OFF_S) + (g * 256 + dir * 128 + pp * 2) / 2;
    float sr = 0.f, si = 0.f;
    for (int blk = 0; blk < 17; ++blk) {
      unsigned v[8]; int rows[8];
#pragma unroll
      for (int e = 0; e < 8; ++e) {
        int r;
        if (blk == 0) r = 1024 + b * 8 + (dir ? 7 - e : e);
        else { const int j = (blk - 1) * 8 + e; r = b * 128 + (dir ? 127 - j : j); }
        rows[e] = r; v[e] = S[(size_t)r * 4096];
      }
#pragma unroll
      for (int e = 0; e < 8; ++e) {
        S[(size_t)rows[e] * 4096] = pk_bf16(sr, si);
        const float nr = at.x * sr - at.y * si + bflo(v[e]), ni = at.x * si + at.y * sr + bfhi(v[e]);
        sr = nr; si = ni;
      }
    }
  }
  {
    const int Mc = need ? MALL : MLAT;
    const int ch = (tid & 63) * 8, rsub = tid >> 6;
    const float* cw = p.conv_w + (size_t)l * 3 * 512 + ch;
    float w0[8], w1[8], w2[8];
#pragma unroll
    for (int e = 0; e < 8; ++e) { w0[e] = cw[e]; w1[e] = cw[512 + e]; w2[e] = cw[1024 + e]; }
    for (int it = vbid(); it < Mc / 32; it += vgrid()) {
      const int rbase = it * 32 + rsub * 8;
      float up[8], uc[8], un[8];
      auto loadu = [&](int row, bool valid, float (&u)[8]) {
        if (valid) {
          const u32x4 c = *(const u32x4*)(Z + (size_t)row * LDZ + ZCC + ch), x = *(const u32x4*)(Z + (size_t)row * LDZ + ZCX + ch);
          u[0] = bflo(c.x) * bflo(x.x); u[1] = bfhi(c.x) * bfhi(x.x); u[2] = bflo(c.y) * bflo(x.y); u[3] = bfhi(c.y) * bfhi(x.y);
          u[4] = bflo(c.z) * bflo(x.z); u[5] = bfhi(c.z) * bfhi(x.z); u[6] = bflo(c.w) * bflo(x.w); u[7] = bfhi(c.w) * bfhi(x.w);
        } else {
#pragma unroll
          for (int e = 0; e < 8; ++e) u[e] = 0.f;
        }
      };
      auto tpos = [&](int row, int& t, int& len) { if (row < MLAT) { t = row & 4095; len = 4096; } else { t = (row - MLAT) & 255; len = 256; } };
      int t0, len0; tpos(rbase, t0, len0);
      loadu(rbase - 1, t0 > 0, up); loadu(rbase, true, uc);
#pragma unroll
      for (int rr = 0; rr < 8; ++rr) {
        const int row = rbase + rr; int t, len; tpos(row, t, len);
        loadu(row + 1, t < len - 1, un);
        const u32x4 zb = *(const u32x4*)(Z + (size_t)row * LDZ + ZCB + ch);
        float y[8];
#pragma unroll
        for (int e = 0; e < 8; ++e) y[e] = w0[e] * up[e] + w1[e] * uc[e] + w2[e] * un[e];
        u32x4 o;
        o.x = pk_bf16(bflo(zb.x) * y[0], bfhi(zb.x) * y[1]); o.y = pk_bf16(bflo(zb.y) * y[2], bfhi(zb.y) * y[3]);
        o.z = pk_bf16(bflo(zb.z) * y[4], bfhi(zb.z) * y[5]); o.w = pk_bf16(bflo(zb.w) * y[6], bfhi(zb.w) * y[7]);
        *(u32x4*)(Z + (size_t)row * LDZ + ZCV + ch) = o;
#pragma unroll
        for (int e = 0; e < 8; ++e) { up[e] = uc[e]; uc[e] = un[e]; }
      }
    }
  }
}

DEV float max3a(float a, float b, float c) { float r; asm("v_max3_f32 %0, %1, %2, %3" : "=v"(r) : "v"(a), "v"(b), "v"(c)); return r; }
DEV void attn_item(const P& p, int bh, int qrow0, int nkt, int outrow0, char* smem) {
  int tid; asm volatile("v_mov_b32 %0, %1" : "=v"(tid) : "v"((int)threadIdx.x));
  const int lane = tid & 63, wid = __builtin_amdgcn_readfirstlane(tid >> 6), l15 = lane & 15, lq = lane >> 4;
  const bf16_t* Qb = (const bf16_t*)(p.ws + OFF_Q) + (size_t)bh * NKEY * 96;
  const bf16_t* Kb = (const bf16_t*)(p.ws + OFF_K) + (size_t)bh * NKEY * 96;
  const bf16_t* Vt = (const bf16_t*)(p.ws + OFF_VT) + (size_t)bh * 64 * NKEY;
  bf16_t* Z = (bf16_t*)(p.ws + OFF_Z);
  constexpr int KB = 16384, VB = 8192, VBASE = 6 * KB;
  int vo = 0; asm volatile("" : "+v"(vo));
  bf16x8 qf[2][3];
#pragma unroll
  for (int qt = 0; qt < 2; ++qt)
#pragma unroll
    for (int ks = 0; ks < 3; ++ks) qf[qt][ks] = *(const bf16x8*)(Qb + (size_t)(qrow0 + wid * 32 + qt * 16 + l15) * 96 + ks * 32 + lq * 8);
  f32x4 o[4][2];
#pragma unroll
  for (int vt = 0; vt < 4; ++vt)
#pragma unroll
    for (int qt = 0; qt < 2; ++qt) o[vt][qt] = (f32x4){0.f, 0.f, 0.f, 0.f};
  float mused[2] = {0.f, 0.f};
  f32x4 osum[2] = {(f32x4){0.f, 0.f, 0.f, 0.f}, (f32x4){0.f, 0.f, 0.f, 0.f}};
  const bf16x8 ones = __builtin_bit_cast(bf16x8, (u32x4){0x3f803f80u, 0x3f803f80u, 0x3f803f80u, 0x3f803f80u});
  u32x4 kr[4], vr[2];
  const int krow = tid >> 4, kc = tid & 15;
  const int vrow = tid >> 3, vc = tid & 7;
  const int kwo = vo + krow * 256 + ((kc ^ (krow & 15)) << 4), vwo = vo + VBASE + vrow * 128 + ((vc ^ ((vrow >> 1) & 7)) << 4);
  const int kro = vo + l15 * 256, vro = vo + VBASE + l15 * 128;
  f32x4 st[4][2];
  bf16x8 pf[2][2], vf[2][4];
#define ALOAD(kt) { const int key0_ = (kt) * 128; \
    if (kc < 12) { _Pragma("unroll") for (int i = 0; i < 4; ++i) kr[i] = *(const u32x4*)(Kb + (size_t)(key0_ + krow + 32 * i) * 96 + kc * 8); } \
    _Pragma("unroll") for (int i = 0; i < 2; ++i) vr[i] = *(const u32x4*)(Vt + (size_t)vrow * NKEY + key0_ + i * 64 + vc * 8); }
#define ASTORE(slot) { char* sk_ = smem + (slot) * KB; char* sv_ = smem + (slot) * VB; \
    if (kc < 12) { _Pragma("unroll") for (int i = 0; i < 4; ++i) *(u32x4*)(sk_ + kwo + i * 8192) = kr[i]; } \
    _Pragma("unroll") for (int i = 0; i < 2; ++i) *(u32x4*)(sv_ + vwo + i * VB) = vr[i]; }
#define LDK(dst, s_, ks_) { _Pragma("unroll") for (int kk = 0; kk < 4; ++kk) dst[kk] = *(const bf16x8*)((s_) + kk * 4096 + kro + ((((ks_) * 4 + lq) ^ l15) << 4)); }
#define MMK(src_, ks_) { _Pragma("unroll") for (int kk = 0; kk < 4; ++kk) _Pragma("unroll") for (int qt = 0; qt < 2; ++qt) st[kk][qt] = __builtin_amdgcn_mfma_f32_16x16x32_bf16(src_[kk], qf[qt][ks_], st[kk][qt], 0, 0, 0); }
#define QK(slot) { const char* s = smem + (slot) * KB; bf16x8 kfa[4], kfb[4]; \
    LDK(kfa, s, 0); LDK(kfb, s, 1); \
    _Pragma("unroll") for (int kk = 0; kk < 4; ++kk) _Pragma("unroll") for (int qt = 0; qt < 2; ++qt) { const float nm = -mused[qt]; st[kk][qt] = (f32x4){nm, nm, nm, nm}; } \
    __builtin_amdgcn_s_setprio(1); MMK(kfa, 0); LDK(kfa, s, 2); MMK(kfb, 1); MMK(kfa, 2); __builtin_amdgcn_s_setprio(0); }
#define SM(first) { _Pragma("unroll") for (int qt = 0; qt < 2; ++qt) { \
      float mx = max3a(st[0][qt][0], st[0][qt][1], st[0][qt][2]); \
      mx = max3a(mx, st[0][qt][3], st[1][qt][0]); mx = max3a(mx, st[1][qt][1], st[1][qt][2]); mx = max3a(mx, st[1][qt][3], st[2][qt][0]); \
      mx = max3a(mx, st[2][qt][1], st[2][qt][2]); mx = max3a(mx, st[2][qt][3], st[3][qt][0]); mx = max3a(mx, st[3][qt][1], st[3][qt][2]); mx = max3a(mx, st[3][qt][3], st[3][qt][3]); \
      if ((first) || __builtin_amdgcn_ballot_w64(mx > 8.0f) != 0) {     \
        mx = fmaxf(mx, __shfl_xor(mx, 16)); mx = fmaxf(mx, __shfl_xor(mx, 32)); \
        const float sc = __builtin_amdgcn_exp2f(-mx); \
        mused[qt] += mx; \
        _Pragma("unroll") for (int vt = 0; vt < 4; ++vt) o[vt][qt] = o[vt][qt] * sc; \
        osum[qt] = osum[qt] * sc; \
        _Pragma("unroll") for (int kk = 0; kk < 4; ++kk) _Pragma("unroll") for (int r = 0; r < 4; ++r) st[kk][qt][r] = __builtin_amdgcn_exp2f(st[kk][qt][r] - mx); \
      } else { \
        _Pragma("unroll") for (int kk = 0; kk < 4; ++kk) _Pragma("unroll") for (int r = 0; r < 4; ++r) st[kk][qt][r] = __builtin_amdgcn_exp2f(st[kk][qt][r]); \
      } \
      _Pragma("unroll") for (int k2 = 0; k2 < 2; ++k2) { \
        u32x4 w; \
        w.x = pk_bf16(st[2 * k2][qt][0], st[2 * k2][qt][1]); w.y = pk_bf16(st[2 * k2][qt][2], st[2 * k2][qt][3]); \
        w.z = pk_bf16(st[2 * k2 + 1][qt][0], st[2 * k2 + 1][qt][1]); w.w = pk_bf16(st[2 * k2 + 1][qt][2], st[2 * k2 + 1][qt][3]); \
        pf[qt][k2] = __builtin_bit_cast(bf16x8, w); } } }
#define PVLOAD(slot) { const char* s = smem + (slot) * VB; \
    _Pragma("unroll") for (int vt = 0; vt < 4; ++vt) vf[0][vt] = *(const bf16x8*)(s + vt * 2048 + vro + (((0 * 4 + lq) ^ (l15 >> 1)) << 4)); }
#define PVMMA(slot) { const char* s = smem + (slot) * VB; \
    _Pragma("unroll") for (int vt = 0; vt < 4; ++vt) vf[1][vt] = *(const bf16x8*)(s + vt * 2048 + vro + (((1 * 4 + lq) ^ (l15 >> 1)) << 4)); \
    __builtin_amdgcn_s_setprio(1); \
    _Pragma("unroll") for (int k2 = 0; k2 < 2; ++k2) _Pragma("unroll") for (int vt = 0; vt < 4; ++vt) \
      _Pragma("unroll") for (int qt = 0; qt < 2; ++qt) o[vt][qt] = __builtin_amdgcn_mfma_f32_16x16x32_bf16(vf[k2][vt], pf[qt][k2], o[vt][qt], 0, 0, 0); \
    _Pragma("unroll") for (int k2 = 0; k2 < 2; ++k2) _Pragma("unroll") for (int qt = 0; qt < 2; ++qt) osum[qt] = __builtin_amdgcn_mfma_f32_16x16x32_bf16(ones, pf[qt][k2], osum[qt], 0, 0, 0); \
    __builtin_amdgcn_s_setprio(0); }
  const bool skew = vbsel() != 0;
  asm volatile("" : "+s"(nkt));
#define ABAR() { asm volatile("s_waitcnt lgkmcnt(0)" ::: "memory"); __builtin_amdgcn_s_barrier(); asm volatile("" ::: "memory"); }
  const int npair = nkt >> 1;
  ALOAD(0); ASTORE(0); if (npair > 1) ALOAD(1); ABAR();
  int s0 = 0;
#pragma nounroll
  for (int kp = 0; kp < npair; ++kp) {
    const int sn = (s0 == 4) ? 0 : s0 + 2;
    if (kp + 1 < npair) ASTORE(sn);
    if (kp + 2 < npair) ALOAD(kp + 2);
    if (!skew) {
      QK(s0); PVLOAD(s0); __builtin_amdgcn_sched_barrier(0); SM(kp == 0); PVMMA(s0);
      QK(s0 + 1); PVLOAD(s0 + 1); __builtin_amdgcn_sched_barrier(0); SM(false); PVMMA(s0 + 1);
    } else {
      if (kp > 0) { const int sp = (s0 == 0) ? 5 : s0 - 1; PVLOAD(sp); __builtin_amdgcn_sched_barrier(0); SM(false); PVMMA(sp); }
      QK(s0);
      PVLOAD(s0); __builtin_amdgcn_sched_barrier(0); SM(kp == 0); PVMMA(s0);
      QK(s0 + 1);
    }
    ABAR();
    s0 = sn;
  }
  if (skew) { const int sp = (s0 == 0) ? 5 : s0 - 1; PVLOAD(sp); SM(false); PVMMA(sp); }
  ABAR();
#undef ABAR
#undef ALOAD
#undef ASTORE
#undef QK
#undef SM
#undef PVLOAD
#undef PVMMA
#undef LDK
#undef MMK
  const int h = bh & 7;
#pragma unroll
  for (int qt = 0; qt < 2; ++qt) {
    const float inv = 1.0f / osum[qt][0];
    const int row = outrow0 + wid * 32 + qt * 16 + l15;
#pragma unroll
    for (int vt = 0; vt < 4; ++vt) {
      const f32x4 v = o[vt][qt] * inv;
      *(u32x2*)(Z + (size_t)row * LDZ + ZAO + h * 64 + vt * 16 + lq * 4) = (u32x2){pk_bf16(v[0], v[1]), pk_bf16(v[2], v[3])};
    }
  }
}

DEV float gelu_t(float x) { const float z = 0.7978845608028654f * (x + 0.044715f * x * x * x); const float e = __expf(2.0f * z); return 0.5f * x * (2.0f - 2.0f / (1.0f + e)); }

DEV void ph_attn(const P& p, int l, bool need, char* smem) {
  const int tid = get_tid(), lane = tid & 63, wid = tid >> 6, wm = wid >> 1, wn = wid & 1, l15 = lane & 15, lq = lane >> 4;
  bf16_t* Z = (bf16_t*)(p.ws + OFF_Z);
  {
    const bf16_t* Mt = (const bf16_t*)(p.ws + OFF_MT); const bf16_t* Et = (const bf16_t*)(p.ws + OFF_ET); const bf16_t* S = (const bf16_t*)(p.ws + OFF_S);
    const int nmt = need ? 9 : 8, rmax = need ? NCH : 1024;
    for (int r_ = 0, nr_ = rounds_of(32 * nmt * 4); r_ < nr_; ++r_) { int t = vbid() + r_ * vgrid(); t = t < (32 * nmt * 4) ? t : (32 * nmt * 4) - 1;
      const int g = t / (nmt * 4), mt = (t % (nmt * 4)) >> 2, nt = t & 3;
      f32x4 acc[4][4]; zero_acc<4>(acc);
      ASrc a; a.p = Z + ZS5 + g * 16; a.lda = 32 * LDZ; a.row0 = mt * 128; a.rmax = rmax; a.segshift = 4; a.segstride = LDZ;
      gemm_core<4, true>(acc, a, Mt + ((size_t)g * 512 + nt * 128) * 512, 512, 512, smem);
      gemm_core<4, true>(acc, asrc(S + g * 256, 8192, mt * 128, rmax), Et + ((size_t)g * 512 + nt * 128) * 256, 256, 256, smem);
#pragma unroll
      for (int i = 0; i < 4; ++i) {
        const int crow = mt * 128 + wm * 64 + i * 16 + l15;
        if (crow < rmax) {
#pragma unroll
          for (int j = 0; j < 4; ++j) {
            const int n = nt * 128 + wn * 64 + j * 16 + lq * 4, tt = n >> 4, c = n & 15;
            *(u32x2*)(Z + (size_t)(crow * 32 + tt) * LDZ + ZS5A + g * 16 + c) =
                (u32x2){pk_bf16(gelu_t(acc[i][j][0]), gelu_t(acc[i][j][1])), pk_bf16(gelu_t(acc[i][j][2]), gelu_t(acc[i][j][3]))};
          }
        }
      }
    }
  }
  for (int it = blockIdx.x; it < 1024; it += gridDim.x) {
    const int r = it >> 8, w = it & 255, xcd = w & 7, slot = w >> 3;
    const int bh = r * 16 + xcd * 2 + (slot >> 4), qb = slot & 15;
    attn_item(p, bh, qb * 256, 68, (bh >> 3) * 4096 + qb * 256, smem);
  }
  if (need) for (int it = blockIdx.x; it < 64; it += gridDim.x) attn_item(p, it, 4096, 4, MLAT + (it >> 3) * 256, smem);
}

DEV int n_jobs(int ph) { return ph == 2 ? 1 : ph == 3 ? 3 : ph == 6 ? 7 : (ph == 7 || ph == 9 || ph == 10) ? 1 : 0; }
DEV pg8::Job get_job(KP kp, int ph, int l, int j) {
  const P p = ldp(kp);
  const bool need = (l == 0); const int M = need ? MALL : MLAT;
  char* ws = p.ws;
  const bf16_t* Z = (const bf16_t*)(ws + OFF_Z); const bf16_t* XN = (const bf16_t*)(ws + OFF_XN);
  const bf16_t* Wg = (const bf16_t*)(ws + OFF_WIN) + (size_t)LDZ * 1024;
  bf16_t* T = (bf16_t*)(ws + OFF_T); bf16_t* MG = (bf16_t*)(ws + OFF_MG);
  float* xc = (float*)(ws + OFF_XC);
  pg8::Job b; b.lda = 1024; b.M = M; b.N = 1024; b.K = 1024; b.mode = 0; b.O = T; b.ldc = 1024; b.T = T; b.slat = p.out; b.sctx = xc; b.dlat = p.out; b.dctx = xc;
  b.modg = (const float*)(ws + OFF_MOD) + (size_t)l * 9 * 6144; b.A = XN; b.Bt = Wg;
  b.segstride = 0; b.pnstrideA = 0; b.rows = M; b.ssq = nullptr; b.O2 = nullptr;
  if (ph == 2) { b.M = MALL; b.rows = MALL; b.N = LDZ; b.Bt = (const bf16_t*)(ws + OFF_WIN); b.O = (bf16_t*)(ws + OFF_Z); b.ldc = LDZ; b.ssq = (float*)(ws + OFF_SSQ); }
  else if (ph == 3) {
    b.ssq = (float*)(ws + OFF_SSQ); b.K = 256; b.lda = LDZ; b.modg = (const float*)(ws + OFF_ROPE);
    if (j == 0) { b.A = Z + ZQ; b.Bt = (const bf16_t*)(ws + OFF_WUQ); b.N = 768; b.mode = 6; b.O = (bf16_t*)(ws + OFF_Q); }
    else if (j == 1) { b.A = Z + ZKV; b.Bt = (const bf16_t*)(ws + OFF_WUKV); b.M = MALL; b.rows = MALL; b.N = 1024; b.mode = 7; b.O = (bf16_t*)(ws + OFF_K); b.O2 = (bf16_t*)(ws + OFF_VT); }
    else { b.ssq = nullptr; b.A = Z + ZS5; b.lda = 32 * LDZ; b.segstride = LDZ; b.pnstrideA = 16; b.Bt = (const bf16_t*)(ws + OFF_FT); b.M = 1280; b.rows = NCH; b.N = 8192; b.K = 512; b.mode = 0; b.O = (bf16_t*)(ws + OFF_S); b.ldc = 8192; }
  }
  else if (ph == 6) {
    if (j == 0) { b.A = Z + ZAO; b.lda = LDZ; b.Bt = (const bf16_t*)(ws + OFF_WO); b.K = 512; }
    else if (j == 1) { b.mode = 2; b.O = MG; }
    else if (j == 2) { b.A = Z + ZCV; b.lda = LDZ; b.Bt = (const bf16_t*)(ws + OFF_WC); b.K = 512; }
    else if (j == 3) { b.mode = 3; b.O = MG; b.Bt = Wg + (size_t)1024 * 1024; }
    else if (j == 4) { b.A = Z + ZS5A; b.lda = LDZ; b.Bt = (const bf16_t*)(ws + OFF_WGLU); b.K = 512; }
    else if (j == 5) { b.A = Z + ZS5A; b.lda = LDZ; b.Bt = (const bf16_t*)(ws + OFF_WGLU) + (size_t)1024 * 512; b.K = 512; b.mode = 1; }
    else { b.mode = 3; b.O = MG; b.Bt = Wg + (size_t)2048 * 1024; }
  } else if (ph == 7) {
    b.A = MG; b.Bt = (const bf16_t*)(ws + OFF_WOUT); b.mode = 5; b.modg += 2 * 1024;
    if (l == 0) { b.slat = p.x; b.sctx = p.ctx; }
  } else if (ph == 9) { b.Bt = (const bf16_t*)(ws + OFF_W1); b.N = 4096; b.mode = 4; b.O = (bf16_t*)(ws + OFF_Z); b.ldc = 4096; }
  else { b.A = Z; b.lda = 4096; b.K = 4096; b.Bt = (const bf16_t*)(ws + OFF_W2); b.mode = 5; b.modg += 5 * 1024; }
  return b;
}

#define LAS __attribute__((address_space(3)))
#define XB_TMO      128
#define XB_XCNT(j)  (256  + 64 * (j))
#define XB_XSUB(j)  (1280 + 64 * (j))
#define XB_XGEN(j)  (2304 + 64 * (j))
#define XB_TOP      3328
#define XB_TOPGEN   3392
#define XCD_BAR_WORDS 3456
#define XB_SPIN_CAP (1u << 18)

__device__ __forceinline__ unsigned xb_ld(unsigned* p)              { return __hip_atomic_load(p, __ATOMIC_RELAXED, __HIP_MEMORY_SCOPE_AGENT); }
__device__ __forceinline__ unsigned xb_add(unsigned* p, unsigned v) { return __hip_atomic_fetch_add(p, v, __ATOMIC_RELAXED, __HIP_MEMORY_SCOPE_AGENT); }
__device__ __forceinline__ unsigned xb_xcc_id() { return (unsigned)__builtin_amdgcn_s_getreg((3 << 11) | 20) & 0xFu; }
#define XB_SPIN(cond, bar) do { unsigned _sp = 0; while (cond) { __builtin_amdgcn_s_sleep(1); \
    if ((++_sp & 255u) == 0u) { if (xb_ld(&(bar)[XB_TMO])) break; if (_sp > XB_SPIN_CAP) { atomicAdd(&(bar)[XB_TMO], 1u); break; } } } } while (0)

struct XcdBarrier {
    unsigned* bar; unsigned x;
    volatile LAS unsigned* st;
};

__device__ __forceinline__ XcdBarrier xcd_barrier_post(unsigned* bar, volatile LAS unsigned* st) {
    XcdBarrier b; b.bar = bar; b.x = xb_xcc_id(); b.st = st;
    if (threadIdx.x == 0) (void)xb_add(&bar[XB_XCNT(b.x)], 1u);
    return b;
}
__device__ __forceinline__ void xcd_barrier_complete(unsigned* bar, unsigned x, unsigned& nloc, unsigned& nx) {
    const unsigned G = gridDim.x * gridDim.y * gridDim.z;
    unsigned sum, cnt, mine, sp = 0u;
    for (;;) {
        sum = 0u; cnt = 0u; mine = 0u;
#pragma unroll
        for (unsigned j = 0; j < 16; ++j) { const unsigned c = xb_ld(&bar[XB_XCNT(j)]); sum += c; cnt += (c > 0u) ? 1u : 0u; mine = (j == x) ? c : mine; }
        if (sum == G) break;
        __builtin_amdgcn_s_sleep(1);
        if ((++sp & 255u) == 0u) { if (xb_ld(&bar[XB_TMO])) break; if (sp > XB_SPIN_CAP) { atomicAdd(&bar[XB_TMO], 1u); break; } }
    }
    nloc = mine > 0u ? mine : 1u; nx = cnt > 0u ? cnt : 1u;
}

__device__ __forceinline__ void xcd_barrier(const XcdBarrier& b) {
    asm volatile("s_waitcnt vmcnt(0)" ::: "memory");
    __syncthreads();
    if (threadIdx.x == 0) {
        unsigned* bar = b.bar;
        __builtin_amdgcn_s_waitcnt(0);
        unsigned nloc = b.st[0], nx = b.st[1];
        if (nloc == 0u) { xcd_barrier_complete(bar, b.x, nloc, nx); b.st[0] = nloc; b.st[1] = nx; }
        const unsigned old = xb_add(&bar[XB_XSUB(b.x)], 1u);
        const unsigned gen = old / nloc;
        if (old + 1u == (gen + 1u) * nloc) {
            __builtin_amdgcn_fence(__ATOMIC_RELEASE, "agent");
            asm volatile("s_waitcnt vmcnt(0)" ::: "memory");
            const unsigned og = xb_add(&bar[XB_TOP], 1u);
            const unsigned tg = og / nx;
            if (og + 1u == (tg + 1u) * nx) xb_add(&bar[XB_TOPGEN], 1u);
            else XB_SPIN(xb_ld(&bar[XB_TOPGEN]) == tg, bar);
            __builtin_amdgcn_fence(__ATOMIC_ACQUIRE, "agent");
            xb_add(&bar[XB_XGEN(b.x)], 1u);
            asm volatile("s_waitcnt vmcnt(0)" ::: "memory");
        } else {
            XB_SPIN(xb_ld(&bar[XB_XGEN(b.x)]) == gen, bar);
            __builtin_amdgcn_fence(__ATOMIC_ACQUIRE, "agent");
            asm volatile("s_waitcnt vmcnt(0)" ::: "memory");
        }
    }
    __syncthreads();
}

DEV void run_phase(KP kp, int ph, int l, char* smem) {
  const bool need = (l == 0);
  switch (ph) {
    case 0: { const P p = ldp(kp); ph_ada(p, smem); } break;
    case 1: { const P p = ldp(kp); ph_prep(p, l, smem); } break;
    case 2: { const P p = ldp(kp); ph_in(p, l, smem); } break;
    case 3: { const P p = ldp(kp); ph_mid(p, l, need, smem); } break;
    case 4: { const P p = ldp(kp); ph_carry(p, l, need); } break;
    case 5: { const P p = ldp(kp); ph_attn(p, l, need, smem); } break;
    case 8: { const P p = ldp(kp); norm_rows(p, p.out, (const float*)(p.ws + OFF_XC), need ? MALL : MLAT, p.norm_mlp + l * 1024, (const float*)(p.ws + OFF_MOD) + (size_t)l * 9 * 6144, 3, 4); } break;
    case 11: { const P p = ldp(kp); ph_final(p); } break;
    default: break;
  }
}

__global__ void __launch_bounds__(512) mega(P p_unused) {
  __shared__ __attribute__((aligned(16))) char smem_all[163840];
  char* smem = smem_all;
  KP kp = (KP)__builtin_amdgcn_kernarg_segment_ptr();
  cg::grid_group grid = cg::this_grid();
  unsigned* xb_st = (unsigned*)(smem_all + 163824);
  if (threadIdx.x == 0) { xb_st[0] = 0u; xb_st[1] = 0u; }
  __syncthreads();
  unsigned* barw; { const P p0 = ldp(kp); barw = (unsigned*)(p0.ws + OFF_BAR); }
  const XcdBarrier XB = xcd_barrier_post(barw, (volatile LAS unsigned*)xb_st);
  run_phase(kp, 0, 0, smem);
  grid.sync();
  for (int l = 0; l < 2; ++l)
    for (int ph = 1; ph <= 10; ++ph) {
      for (int rep_ = 0; rep_ < 1 + DUPN(ph); ++rep_) {
        const int nj = n_jobs(ph);
        if (nj == 0 || ph == 2 || ph == 3) run_phase(kp, ph, l, smem);
        for (int j = 0; j < nj; ++j) { const pg8::Job jb = get_job(kp, ph, l, j); run_job(smem, jb); }
        xcd_barrier(XB);
      }
    }
  run_phase(kp, 11, 0, smem);
}

extern "C" void kernel_launch(void* const* d_in, const int* in_sizes, int n_in, void* d_out, int out_size, void* d_ws, size_t ws_size, hipStream_t stream) {
  static int grid_blocks = 0;
  if (!grid_blocks) {
    int dev = 0, cus = 0, per_cu = 0;
    hipGetDevice(&dev);
    hipDeviceGetAttribute(&cus, hipDeviceAttributeMultiprocessorCount, dev);
    hipOccupancyMaxActiveBlocksPerMultiprocessor(&per_cu, mega, 512, 0);
    if (per_cu > 1) per_cu = 1;
    grid_blocks = cus * per_cu;
  }
  if (ws_size < WS_TOTAL) fprintf(stderr, "workspace too small: %zu < %zu\n", ws_size, (size_t)WS_TOTAL);
  (void)hipMemsetAsync((char*)d_ws + OFF_BAR, 0, BAR_BYTES, stream);
  P p{};
  const float** f = (const float**)&p;
  for (int i = 0; i < 29; ++i) f[i] = (const float*)d_in[i];
  p.out = (float*)d_out; p.ws = (char*)d_ws;
  void* args[] = {&p};
  hipError_t e = hipLaunchCooperativeKernel((void*)mega, dim3(grid_blocks), dim3(512), args, 0, stream);
  if (e != hipSuccess) fprintf(stderr, "cooperative launch failed: %s (grid %d)\n", hipGetErrorString(e), grid_blocks);
}
```

```cpp
#include <hip/hip_runtime.h>
#include <hip/hip_cooperative_groups.h>
#include <stdint.h>
#include <cstdio>
namespace cg = cooperative_groups;

typedef unsigned short bf16_t;
typedef short bf16x8 __attribute__((ext_vector_type(8)));
typedef float f32x4 __attribute__((ext_vector_type(4)));
typedef unsigned u32x4 __attribute__((ext_vector_type(4)));
typedef unsigned u32x2 __attribute__((ext_vector_type(2)));
#define DEV __device__ __forceinline__

constexpr int MLAT = 32768, MCTX = 2048, MALL = 34816;
constexpr int LDZ = 2816, ZQ = 0, ZKV = 256, ZCB = 512, ZCC = 1024, ZCX = 1536, ZS5 = 2048, ZPE = 2560;
constexpr int ZCV = 0, ZAO = 512, ZS5A = 1024, ZMG = 1536;
constexpr int NKEY = 4352;
constexpr int NCH = 1088;
constexpr float EPSN = 1e-6f;

constexpr size_t OFF_MOD  = 0;
constexpr size_t OFF_ROPE = OFF_MOD + 2ull * 9 * 6144 * 4;
constexpr size_t OFF_KTAB = OFF_ROPE + 4096;
constexpr size_t OFF_XC   = OFF_KTAB + 32ull * 2 * 32 * 256 * 4;
constexpr size_t OFF_S    = OFF_XC + 2048ull * 1024 * 4;
constexpr size_t OFF_WIN  = OFF_S + (size_t)NCH * 8192 * 2;
constexpr size_t OFF_WUQ  = OFF_WIN + 5888ull * 1024 * 2;
constexpr size_t OFF_WUKV = OFF_WUQ + 768ull * 256 * 2;
constexpr size_t OFF_WO   = OFF_WUKV + 1024ull * 256 * 2;
constexpr size_t OFF_WC   = OFF_WO + 1024ull * 512 * 2;
constexpr size_t OFF_WGLU = OFF_WC + 1024ull * 512 * 2;
constexpr size_t OFF_WOUT = OFF_WGLU + 2048ull * 512 * 2;
constexpr size_t OFF_W1   = OFF_WOUT + 1024ull * 1024 * 2;
constexpr size_t OFF_W2   = OFF_W1 + 4096ull * 1024 * 2;
constexpr size_t OFF_MT   = OFF_W2 + 1024ull * 4096 * 2;
constexpr size_t OFF_ET   = OFF_MT + 32ull * 512 * 512 * 2;
constexpr size_t OFF_FT   = OFF_ET + 32ull * 512 * 256 * 2;
constexpr size_t OFF_XN   = OFF_FT + 32ull * 256 * 512 * 2;
constexpr size_t OFF_Z    = OFF_XN + (size_t)MALL * 1024 * 2;
constexpr size_t OFF_Q    = OFF_Z + (size_t)MALL * LDZ * 2;
constexpr size_t OFF_K    = OFF_Q + 64ull * NKEY * 96 * 2;
constexpr size_t OFF_VT   = OFF_K + 64ull * NKEY * 96 * 2;
constexpr size_t WS_NEED  = OFF_VT + 64ull * 64 * NKEY * 2;
constexpr size_t OFF_T    = OFF_Q;
constexpr size_t OFF_MG   = OFF_T + (size_t)MALL * 1024 * 2;
static_assert(OFF_MG + (size_t)MALL * 1024 * 2 <= WS_NEED, "merge temporaries overflow");
constexpr size_t OFF_BAR  = WS_NEED;
constexpr size_t BAR_BYTES = 3456 * 4;
constexpr size_t OFF_SSQ  = OFF_BAR + 16384;
constexpr size_t WS_TOTAL = OFF_SSQ + (size_t)MALL * 2 * 4;
static_assert((size_t)MALL * 4096 * 2 <= OFF_VT - OFF_Z, "H alias too big");

#ifdef DUP_PH
#define DUPN(ph) ((ph) == DUP_PH ? 1 : 0)
#else
#define DUPN(ph) 0
#endif
struct P {
  const float *x, *c, *ctx, *c_ctx, *ada_w, *ada_b, *norm_mix, *w_in, *q_norm, *w_uq, *kv_norm, *w_ukv, *w_o, *conv_w, *conv_w_out,
      *a_re, *a_im, *log_dt, *b_re, *b_im, *c_re, *c_im, *s5_d, *w_glu, *w_out, *norm_mlp, *w1, *w2, *norm_final;
  float* out; char* ws;
};

DEV int get_tid() { int t; asm volatile("v_mov_b32 %0, %1" : "=v"(t) : "v"((int)(threadIdx.x & 255))); return t; }
DEV int vbsel() { return __builtin_amdgcn_readfirstlane((int)(threadIdx.x >> 8)); }
DEV int vbid() { return (int)blockIdx.x * 2 + vbsel(); }
DEV int vgrid() { return (int)gridDim.x * 2; }
DEV int vboff() { return vbsel() * 81920; }
DEV int rounds_of(int total) { const int vg = vgrid(); int r = 0; for (int t = 0; t < total; t += vg) ++r; return r; }
typedef const __attribute__((address_space(4))) P* KP;
#if defined(__HIP_DEVICE_COMPILE__)
DEV P ldp(KP k) { asm volatile("" : "+s"(k)); return *k; }
#else
DEV P ldp(KP k) { return P{}; }
#endif
DEV unsigned pk_bf16(float lo, float hi) { unsigned r; asm("v_cvt_pk_bf16_f32 %0, %1, %2" : "=v"(r) : "v"(lo), "v"(hi)); return r; }
DEV float bflo(unsigned w) { return __uint_as_float(w << 16); }
DEV float bfhi(unsigned w) { return __uint_as_float(w & 0xffff0000u); }
DEV float sigm(float x) { return __builtin_amdgcn_rcpf(1.0f + __builtin_amdgcn_exp2f(x * -1.4426950408889634f)); }
DEV float wave_sum(float v) {
#pragma unroll
  for (int o = 32; o > 0; o >>= 1) v += __shfl_xor(v, o);
  return v;
}
DEV void sincos_d(double th, float& s, float& c) {
  double n = rint(th * 0.15915494309189535);
  double r = fma(-n, 6.283185307179586, th);
  float rev = (float)(r * 0.15915494309189535);
  s = __builtin_amdgcn_sinf(rev); c = __builtin_amdgcn_cosf(rev);
}

struct ASrc { const bf16_t* p; long lda; int row0, rmax, segshift; long segstride; };

template <int WN, bool SWAP>
DEV void gemm_core(f32x4 (&acc)[4][WN], const ASrc& a, const bf16_t* __restrict__ Bt, long ldb, int K, char* smem) {
  constexpr int BN = 32 * WN, NBL = BN / 32;
  constexpr int ABYTES = 16384, STAGE = ABYTES + BN * 128;
  const int tid = get_tid(), lane = tid & 63, wid = tid >> 6, wm = wid >> 1, wn = wid & 1;
  const int l15 = lane & 15, lq = lane >> 4;
  const int lrow = tid >> 3, lc = tid & 7;
  const int segmask = (1 << a.segshift) - 1;
  const bf16_t* ap[4];
#pragma unroll
  for (int i = 0; i < 4; ++i) { int r = a.row0 + lrow + 32 * i; r = r < a.rmax ? r : a.rmax - 1; ap[i] = a.p + (long)r * a.lda; }
  const bf16_t* bp = Bt + (long)lrow * ldb + lc * 8;
  const int vo = vboff();
  const int wofs = vo + lrow * 128 + ((lc ^ ((lrow >> 1) & 7)) << 4);
  u32x4 ra0[4], rb0[NBL], ra1[4], rb1[NBL];
  const int aoff = vo + (wm * 64 + l15) * 128, boff = vo + ABYTES + (wn * 16 * WN + l15) * 128, sx = l15 >> 1;
  int nk = K >> 6; asm volatile("" : "+s"(nk));
#define GLOAD(RA, RB, kt) { const int k_ = (kt) * 64 + lc * 8; const long ko_ = (long)(k_ >> a.segshift) * a.segstride + (k_ & segmask); \
    _Pragma("unroll") for (int i = 0; i < 4; ++i) RA[i] = *(const u32x4*)(ap[i] + ko_); \
    _Pragma("unroll") for (int i = 0; i < NBL; ++i) RB[i] = *(const u32x4*)(bp + (long)(32 * i) * ldb + (kt) * 64); }
#define LSTORE(RA, RB, buf) { char* s_ = smem + (buf) * STAGE; \
    _Pragma("unroll") for (int i = 0; i < 4; ++i) *(u32x4*)(s_ + wofs + i * 4096) = RA[i]; \
    _Pragma("unroll") for (int i = 0; i < NBL; ++i) *(u32x4*)(s_ + ABYTES + wofs + i * 4096) = RB[i]; }
#define BAR() { asm volatile("s_waitcnt lgkmcnt(0)" ::: "memory"); __builtin_amdgcn_s_barrier(); asm volatile("" ::: "memory"); }
#define COMPUTE(buf) { const char* s = smem + (buf) * STAGE; \
    _Pragma("unroll") for (int ks = 0; ks < 2; ++ks) { \
      const int co = ((ks * 4 + lq) ^ sx) << 4; \
      bf16x8 af[4], bfr[WN]; \
      _Pragma("unroll") for (int i = 0; i < 4; ++i) af[i] = *(const bf16x8*)(s + aoff + i * 2048 + co); \
      _Pragma("unroll") for (int j = 0; j < WN; ++j) bfr[j] = *(const bf16x8*)(s + boff + j * 2048 + co); \
      _Pragma("unroll") for (int i = 0; i < 4; ++i) \
        _Pragma("unroll") for (int j = 0; j < WN; ++j) \
          acc[i][j] = SWAP ? __builtin_amdgcn_mfma_f32_16x16x32_bf16(bfr[j], af[i], acc[i][j], 0, 0, 0) \
                           : __builtin_amdgcn_mfma_f32_16x16x32_bf16(af[i], bfr[j], acc[i][j], 0, 0, 0); \
    } }
  __builtin_amdgcn_sched_barrier(0);
  GLOAD(ra0, rb0, 0); GLOAD(ra1, rb1, 1); LSTORE(ra0, rb0, 0); BAR();
#pragma nounroll
  for (int kt = 0; kt < nk; kt += 2) {
    if (kt + 2 < nk) GLOAD(ra0, rb0, kt + 2);
    COMPUTE(0);
    LSTORE(ra1, rb1, 1);
    BAR();
    if (kt + 3 < nk) GLOAD(ra1, rb1, kt + 3);
    COMPUTE(1);
    if (kt + 2 < nk) LSTORE(ra0, rb0, 0);
    BAR();
  }
#undef GLOAD
#undef LSTORE
#undef COMPUTE
#undef BAR
  __builtin_amdgcn_sched_barrier(0);
}
template <int WN> DEV void zero_acc(f32x4 (&acc)[4][WN]) {
#pragma unroll
  for (int i = 0; i < 4; ++i)
#pragma unroll
    for (int j = 0; j < WN; ++j) acc[i][j] = (f32x4){0.f, 0.f, 0.f, 0.f};
}
DEV ASrc asrc(const bf16_t* p, long lda, int row0, int rmax) { ASrc a; a.p = p; a.lda = lda; a.row0 = row0; a.rmax = rmax; a.segshift = 30; a.segstride = 0; return a; }

DEV bool tile_get(int r, int nM, int nN, int& mt, int& nt) {
  const int nslots = vgrid() >> 3; int q = (r * 8 + ((int)blockIdx.x & 7)) * nslots + ((int)blockIdx.x >> 3) * 2 + vbsel();
  const bool valid = q < nM * nN; q = valid ? q : nM * nN - 1;
  const int band = q / (8 * nN), rem = q - band * 8 * nN;
  nt = rem >> 3; mt = band * 8 + (rem & 7);
  return valid;
}
DEV int tile_rounds(int total) { return rounds_of(total); }


namespace pg8 {
#define PG8_LAS __attribute__((address_space(3)))
constexpr int BM = 256, BK = 64, HALF = 128, HTB = HALF * BK * 2, STAGE_BYTES = 8 * HTB, NXCD = 8, WGM = 8;
DEV int lds_byte(int r, int c) { const int st = (r >> 4) * 2 + (c >> 5), rr = r & 15, cc = c & 31, ob = rr * 64 + cc * 2; return st * 1024 + (ob ^ (((ob >> 9) & 1) << 5)); }
DEV void stage_rc(int b, int& R, int& C) { const int st = b / 1024, sb = b % 1024, swz = sb ^ (((sb >> 9) & 1) << 5); R = (st >> 1) * 16 + swz / 64; C = (st & 1) * 32 + (swz % 64) / 2; }
DEV int perm32(int rho) { const int n = rho >> 4, i = rho & 15; return 8 * (i >> 2) + 4 * n + (i & 3); }
struct Unit { int pm, pn; };
struct Gemm { const bf16_t* A; const bf16_t* Bt; long lda; int M, N, K; long segstride; long pnstrideA; };
struct StaticOrder {
  int nM, nN, nwg, G, c;
  DEV void init(int M, int N, int G_, int c_) { nM = M / BM; nN = N / BM; nwg = nM * nN; G = G_; c = c_; }
  DEV bool next(int i, Unit& u) const {
    const long L = (long)i * G + c; if (L >= nwg) return false;
    int wgid = (int)L; { const int q = nwg / NXCD, r = nwg % NXCD, xcd = wgid % NXCD, off = wgid / NXCD; wgid = (xcd < r ? xcd * (q + 1) : r * (q + 1) + (xcd - r) * q) + off; }
    const int nig = WGM * nN, gid = wgid / nig, fm = gid * WGM, gsz = (nM - fm) < WGM ? (nM - fm) : WGM;
    u.pm = fm + ((wgid % nig) % gsz); u.pn = (wgid % nig) / gsz; return true;
  }
};
template <class Epi>
DEV void gemm_phase(PG8_LAS unsigned char* lds, const Gemm g, const StaticOrder& S, const Epi& E) {
  int tid; asm volatile("v_mov_b32 %0, %1" : "=v"(tid) : "v"((int)threadIdx.x));
  const int wid = __builtin_amdgcn_readfirstlane(tid >> 6), lane = tid & 63, wr = wid >> 2, wc = wid & 3, fr = lane & 15, fq = lane >> 4;
  const int K = g.K, nt = K / BK;
  unsigned voffA[2], voffB[2];
#pragma unroll
  for (int i = 0; i < 2; ++i) { int R, C; stage_rc(tid * 16 + i * 8192, R, C); const int Rb = Epi::PERM ? ((R & ~31) + perm32(R & 31)) : R;
    voffA[i] = (unsigned)((long)R * g.lda + (g.segstride ? (long)(C >> 4) * g.segstride + (C & 15) : (long)C)) * 2u; voffB[i] = (unsigned)(Rb * K + C) * 2u; }
  const size_t kstep = (size_t)(BK * 2);
  const size_t kstepA = g.segstride ? (size_t)(BK / 16) * g.segstride * 2 : kstep;
  const size_t pnA = (size_t)g.pnstrideA * 2;
  const size_t hstepA = (size_t)HALF * g.lda * 2, hstepB = (size_t)HALF * K * 2;
  const size_t tstepA = 2 * hstepA, tstepB = 2 * hstepB;
  const unsigned ldsw = (unsigned)wid * 1024u;
  const int aoff = lds_byte(wr * 64 + fr, fq * 8), boff = lds_byte(wc * 32 + fr, fq * 8);
#define PG8_SA(b, h) (((b) * 2 + (h)) * HTB)
#define PG8_SB(b, h) ((4 + (b) * 2 + (h)) * HTB)
#define PG8_STAGE(bufoff, gbase, voff) do { _Pragma("unroll") for (int _i = 0; _i < 2; ++_i) \
    __builtin_amdgcn_global_load_lds((const unsigned*)((const char*)(gbase) + (voff)[_i]), (PG8_LAS unsigned*)(lds + (bufoff) + ldsw + _i * 8192), 16, 0, 0); } while (0)
#define PG8_LDA(dst, b, h) do { _Pragma("unroll") for (int m = 0; m < 4; ++m) _Pragma("unroll") for (int k = 0; k < 2; ++k) dst[m][k] = *(const PG8_LAS bf16x8*)(lds + PG8_SA(b, h) + aoff + m * 2048 + k * 1024); } while (0)
#define PG8_LDB(dst, b, h) do { _Pragma("unroll") for (int n = 0; n < 2; ++n) _Pragma("unroll") for (int k = 0; k < 2; ++k) dst[n][k] = *(const PG8_LAS bf16x8*)(lds + PG8_SB(b, h) + boff + n * 2048 + k * 1024); } while (0)
#define PG8_MMA(ai, bj, At, Bt) do { __builtin_amdgcn_s_setprio(1); _Pragma("unroll") for (int m = 0; m < 4; ++m) _Pragma("unroll") for (int n = 0; n < 2; ++n) _Pragma("unroll") for (int k = 0; k < 2; ++k) \
    acc[ai][bj][m][n] = __builtin_amdgcn_mfma_f32_16x16x32_bf16(Bt[n][k], At[m][k], acc[ai][bj][m][n], 0, 0, 0); __builtin_amdgcn_s_setprio(0); } while (0)
#define PG8_WAIT_V(n) asm volatile("s_waitcnt vmcnt(" #n ")" ::: "memory")
#define PG8_WAIT_L(n) asm volatile("s_waitcnt lgkmcnt(" #n ")" ::: "memory")
#define PG8_BAR __builtin_amdgcn_s_barrier()
#define PG8_SCHED __builtin_amdgcn_sched_barrier(0)
  Unit cur, nxt; int ui = 0;
  if (!S.next(0, cur)) return;
  f32x4 acc[2][2][4][2];
#pragma unroll
  for (int a = 0; a < 2; ++a)
#pragma unroll
    for (int b = 0; b < 2; ++b)
#pragma unroll
      for (int m = 0; m < 4; ++m)
#pragma unroll
        for (int n = 0; n < 2; ++n) acc[a][b][m][n] = (f32x4){0.f, 0.f, 0.f, 0.f};
  bf16x8 At[4][2], B0[2][2], B1[2][2];
  const char* cA = (const char*)g.A + (size_t)cur.pm * tstepA + (size_t)cur.pn * pnA; const char* cB = (const char*)g.Bt + (size_t)cur.pn * tstepB;
  PG8_STAGE(PG8_SB(0, 0), cB, voffB); PG8_STAGE(PG8_SB(0, 1), cB + hstepB, voffB); PG8_STAGE(PG8_SA(0, 0), cA, voffA); PG8_STAGE(PG8_SA(0, 1), cA + hstepA, voffA);
  if (wr == 1) PG8_BAR;
  PG8_WAIT_V(2); PG8_BAR;
  PG8_STAGE(PG8_SB(1, 0), cB + kstep, voffB); PG8_STAGE(PG8_SA(1, 0), cA + kstepA, voffA); PG8_STAGE(PG8_SB(1, 1), cB + hstepB + kstep, voffB);
  PG8_WAIT_V(6); PG8_BAR;
  for (;;) {
    const bool has_next = S.next(ui + 1, nxt);
    const char* nA = has_next ? (const char*)g.A + (size_t)nxt.pm * tstepA + (size_t)nxt.pn * pnA : cA; const char* nB = has_next ? (const char*)g.Bt + (size_t)nxt.pn * tstepB : cB;
    for (int t = 0; t < nt; t += 2) {
      const bool last = (t == nt - 2);
      const char* a1 = cA + (size_t)(t + 1) * kstepA;
      const char* a2 = last ? nA : cA + (size_t)(t + 2) * kstepA; const char* b2 = last ? nB : cB + (size_t)(t + 2) * kstep;
      const char* a3 = a2 + kstepA; const char* b3 = b2 + kstep;
      PG8_LDB(B0, 0, 0); PG8_LDB(B1, 0, 1); PG8_SCHED; PG8_LDA(At, 0, 0); PG8_STAGE(PG8_SA(1, 1), a1 + hstepA, voffA);
      PG8_WAIT_V(8); PG8_WAIT_L(0); PG8_BAR; PG8_MMA(0, 0, At, B0); PG8_MMA(0, 1, At, B1); PG8_BAR; PG8_SCHED;
      PG8_LDA(At, 0, 1); PG8_STAGE(PG8_SB(0, 0), b2, voffB); PG8_STAGE(PG8_SB(0, 1), b2 + hstepB, voffB); PG8_STAGE(PG8_SA(0, 0), a2, voffA);
      PG8_WAIT_V(8); PG8_WAIT_L(0); PG8_BAR; PG8_MMA(1, 0, At, B0); PG8_MMA(1, 1, At, B1); PG8_BAR; PG8_SCHED;
      PG8_LDB(B0, 1, 0); PG8_LDB(B1, 1, 1); PG8_SCHED; PG8_LDA(At, 1, 0); PG8_STAGE(PG8_SA(0, 1), a2 + hstepA, voffA);
      PG8_WAIT_V(8); PG8_WAIT_L(0); PG8_BAR; PG8_MMA(0, 0, At, B0); PG8_MMA(0, 1, At, B1); PG8_BAR; PG8_SCHED;
      PG8_LDA(At, 1, 1); PG8_STAGE(PG8_SB(1, 0), b3, voffB); PG8_STAGE(PG8_SB(1, 1), b3 + hstepB, voffB); PG8_STAGE(PG8_SA(1, 0), a3, voffA);
      PG8_WAIT_V(8); PG8_WAIT_L(0); PG8_BAR; PG8_MMA(1, 0, At, B0); PG8_MMA(1, 1, At, B1); PG8_BAR; PG8_SCHED;
    }
    if (wr == 0) PG8_BAR;
    E(acc, cur, wr, wc, fr, fq);
    if (!has_next) break;
#pragma unroll
    for (int a = 0; a < 2; ++a)
#pragma unroll
      for (int b = 0; b < 2; ++b)
#pragma unroll
        for (int m = 0; m < 4; ++m)
#pragma unroll
          for (int n = 0; n < 2; ++n) acc[a][b][m][n] = (f32x4){0.f, 0.f, 0.f, 0.f};
    cur = nxt; cA = nA; cB = nB; ++ui;
    if (wr == 1) PG8_BAR;
  }
  PG8_WAIT_V(0);
  PG8_BAR;
#undef PG8_SA
#undef PG8_SB
#undef PG8_STAGE
#undef PG8_LDA
#undef PG8_LDB
#undef PG8_MMA
#undef PG8_WAIT_V
#undef PG8_WAIT_L
#undef PG8_BAR
#undef PG8_SCHED
}
struct Job { const bf16_t* A; const bf16_t* Bt; long lda; int M, N, K, mode; bf16_t* O; long ldc; const bf16_t* T; const float* slat; const float* sctx; float* dlat; float* dctx; const float* modg;
             long segstride, pnstrideA; int rows; float* ssq; bf16_t* O2; };
struct EpiRT {
  static constexpr bool PERM = true;
  int mode; bf16_t* O; long ldc; const bf16_t* T; const float* slat; const float* sctx; float* dlat; float* dctx; const float* modg; int rows; float* ssq; bf16_t* O2;
  DEV void operator()(const f32x4 (&acc)[2][2][4][2], const Unit& u, int wr, int wc, int fr, int fq) const {
    const int row00 = u.pm * BM + wr * 64 + fr, col00 = u.pn * BM + wc * 32 + 8 * fq;
    if (mode == 5) {
      const bool lat = u.pm * BM < MLAT; const int bi = lat ? (u.pm * BM) >> 12 : 8;
      const float* sb = lat ? slat : sctx - (size_t)MLAT * 1024; float* db = lat ? dlat : dctx - (size_t)MLAT * 1024;
      f32x4 g[2][2];
#pragma unroll
      for (int bj = 0; bj < 2; ++bj) { const float* mg = modg + (size_t)bi * 6144 + col00 + bj * HALF; g[bj][0] = *(const f32x4*)mg; g[bj][1] = *(const f32x4*)(mg + 4); }
#pragma unroll
      for (int ai = 0; ai < 2; ++ai)
#pragma unroll
        for (int mp = 0; mp < 2; ++mp) {
          f32x4 x[4][2];
#pragma unroll
          for (int c = 0; c < 4; ++c) { const float* s = sb + (size_t)(row00 + ai * HALF + (2 * mp + (c >> 1)) * 16) * 1024 + col00 + (c & 1) * HALF; x[c][0] = *(const f32x4*)s; x[c][1] = *(const f32x4*)(s + 4); }
#pragma unroll
          for (int c = 0; c < 4; ++c) { float* d = db + (size_t)(row00 + ai * HALF + (2 * mp + (c >> 1)) * 16) * 1024 + col00 + (c & 1) * HALF;
            *(f32x4*)d = x[c][0] + g[c & 1][0] * acc[ai][c & 1][2 * mp + (c >> 1)][0]; *(f32x4*)(d + 4) = x[c][1] + g[c & 1][1] * acc[ai][c & 1][2 * mp + (c >> 1)][1]; }
        }
      return;
    }
    if (mode >= 1 && mode <= 3) {
#pragma unroll
      for (int b0 = 0; b0 < 16; b0 += 6) {
          u32x4 tv[6], ov[6];
#pragma unroll
          for (int c = 0; c < 6; ++c) if (b0 + c < 16) {
            const int cc = b0 + c, ai = cc >> 3, m = (cc >> 1) & 3, bj = cc & 1;
            const size_t row = (size_t)(row00 + ai * HALF + m * 16); const int col = col00 + bj * HALF;
            if (mode >= 2) tv[c] = *(const u32x4*)(T + row * 1024 + col);
            if (mode != 2) ov[c] = *(const u32x4*)(O + row * ldc + col);
          }
#pragma unroll
          for (int c = 0; c < 6; ++c) if (b0 + c < 16) {
            const int cc = b0 + c, ai = cc >> 3, m = (cc >> 1) & 3, bj = cc & 1;
            const size_t row = (size_t)(row00 + ai * HALF + m * 16); const int col = col00 + bj * HALF;
            f32x4 v0 = acc[ai][bj][m][0], v1 = acc[ai][bj][m][1];
#pragma unroll
            for (int r = 0; r < 4; ++r) { v0[r] = sigm(v0[r]); v1[r] = sigm(v1[r]); }
            if (mode >= 2) { const u32x4 t = tv[c];
              v0[0] *= bflo(t.x); v0[1] *= bfhi(t.x); v0[2] *= bflo(t.y); v0[3] *= bfhi(t.y); v1[0] *= bflo(t.z); v1[1] *= bfhi(t.z); v1[2] *= bflo(t.w); v1[3] *= bfhi(t.w); }
            if (mode == 1) { const u32x4 o = ov[c];
              v0[0] *= bflo(o.x); v0[1] *= bfhi(o.x); v0[2] *= bflo(o.y); v0[3] *= bfhi(o.y); v1[0] *= bflo(o.z); v1[1] *= bfhi(o.z); v1[2] *= bflo(o.w); v1[3] *= bfhi(o.w); }
            if (mode == 3) { const u32x4 o = ov[c];
              v0[0] += bflo(o.x); v0[1] += bfhi(o.x); v0[2] += bflo(o.y); v0[3] += bfhi(o.y); v1[0] += bflo(o.z); v1[1] += bfhi(o.z); v1[2] += bflo(o.w); v1[3] += bfhi(o.w); }
            *(u32x4*)(O + row * ldc + col) = (u32x4){pk_bf16(v0[0], v0[1]), pk_bf16(v0[2], v0[3]), pk_bf16(v1[0], v1[1]), pk_bf16(v1[2], v1[3])};
          }
        }
      return;
    }
    float rsv[2][4];
    if (mode >= 6) {
#pragma unroll
      for (int ai = 0; ai < 2; ++ai)
#pragma unroll
        for (int m = 0; m < 4; ++m) { const int row = row00 + ai * HALF + m * 16; rsv[ai][m] = row < rows ? ssq[(size_t)row * 2 + (mode - 6)] : 1.0f; }
#pragma unroll
      for (int ai = 0; ai < 2; ++ai)
#pragma unroll
        for (int m = 0; m < 4; ++m) rsv[ai][m] = rsqrtf(rsv[ai][m] * (1.0f / 256.0f) + EPSN);
    }
#pragma unroll
    for (int ai = 0; ai < 2; ++ai)
#pragma unroll
      for (int m = 0; m < 4; ++m) {
        const int row = row00 + ai * HALF + m * 16;
#pragma unroll
        for (int bj = 0; bj < 2; ++bj) {
          const int col = col00 + bj * HALF;
          f32x4 v0 = acc[ai][bj][m][0], v1 = acc[ai][bj][m][1];
          if (mode >= 6) {
            if (row < rows) {
              int bb, tok; const bool lat = row < MLAT;
              if (lat) { bb = row >> 12; tok = row & 4095; } else { const int cr = row - MLAT; bb = cr >> 8; tok = cr & 255; }
              if (mode == 6) {
                const float rs = rsv[ai][m] * (0.10206207261596577f * 1.4426950408889634f);
                const int h = col / 96, d = col - h * 96;
                v0 = v0 * rs; v1 = v1 * rs;
                if (d >= 64 && lat) {
                  const int pp = d - 64, a = pp >> 4, f0 = (pp & 15) >> 1, pos = a ? (tok & 63) : (tok >> 6);
                  const float pr = (float)pos * 0.15915494309189535f;
                  const float i0 = f0 ? 0.01f : 1.0f, i1 = f0 ? 0.0031622776601683794f : 0.31622776601683794f, i2 = f0 ? 0.001f : 0.1f, i3 = f0 ? 0.00031622776601683794f : 0.031622776601683794f;
                  const float2 c0 = make_float2(__builtin_amdgcn_cosf(pr * i0), __builtin_amdgcn_sinf(pr * i0)), c1 = make_float2(__builtin_amdgcn_cosf(pr * i1), __builtin_amdgcn_sinf(pr * i1));
                  const float2 c2 = make_float2(__builtin_amdgcn_cosf(pr * i2), __builtin_amdgcn_sinf(pr * i2)), c3 = make_float2(__builtin_amdgcn_cosf(pr * i3), __builtin_amdgcn_sinf(pr * i3));
                  const float t0 = v0[0] * c0.x - v0[1] * c0.y, t1 = v0[1] * c0.x + v0[0] * c0.y, t2 = v0[2] * c1.x - v0[3] * c1.y, t3 = v0[3] * c1.x + v0[2] * c1.y;
                  const float t4 = v1[0] * c2.x - v1[1] * c2.y, t5 = v1[1] * c2.x + v1[0] * c2.y, t6 = v1[2] * c3.x - v1[3] * c3.y, t7 = v1[3] * c3.x + v1[2] * c3.y;
                  v0 = (f32x4){t0, t1, t2, t3}; v1 = (f32x4){t4, t5, t6, t7};
                }
                const int qrow = lat ? tok : 4096 + tok;
                *(u32x4*)(O + ((size_t)(bb * 8 + h) * NKEY + qrow) * 96 + d) = (u32x4){pk_bf16(v0[0], v0[1]), pk_bf16(v0[2], v0[3]), pk_bf16(v1[0], v1[1]), pk_bf16(v1[2], v1[3])};
              } else {
                const float rs = rsv[ai][m];
                const int h = col >> 7, dd = col & 127, key = lat ? 256 + tok : tok;
                v0 = v0 * rs; v1 = v1 * rs;
                const unsigned w0 = pk_bf16(v0[0], v0[1]), w1 = pk_bf16(v0[2], v0[3]), w2 = pk_bf16(v1[0], v1[1]), w3 = pk_bf16(v1[2], v1[3]);
                if (dd < 64) {
                  *(u32x4*)(O + ((size_t)(bb * 8 + h) * NKEY + key) * 96 + dd) = (u32x4){w0, w1, w2, w3};
                } else {
                  const int tt = key & 31, pos = ((tt >> 2) & 3) * 8 + (tt >> 4) * 4 + (tt & 3);
                  bf16_t* vp = O2 + ((size_t)(bb * 8 + h) * 64 + (dd - 64)) * NKEY + (key & ~31) + pos;
                  vp[0] = (bf16_t)(w0 & 0xffff); vp[NKEY] = (bf16_t)(w0 >> 16); vp[2 * NKEY] = (bf16_t)(w1 & 0xffff); vp[3 * NKEY] = (bf16_t)(w1 >> 16);
                  vp[4 * NKEY] = (bf16_t)(w2 & 0xffff); vp[5 * NKEY] = (bf16_t)(w2 >> 16); vp[6 * NKEY] = (bf16_t)(w3 & 0xffff); vp[7 * NKEY] = (bf16_t)(w3 >> 16);
                }
              }
            }
          } else {
            if (mode == 4) {
#pragma unroll
              for (int r = 0; r < 4; ++r) { const float a = fmaxf(v0[r], 0.f), b = fmaxf(v1[r], 0.f); v0[r] = a * a; v1[r] = b * b; }
            }
            if (row < rows) *(u32x4*)(O + (size_t)row * ldc + col) = (u32x4){pk_bf16(v0[0], v0[1]), pk_bf16(v0[2], v0[3]), pk_bf16(v1[0], v1[1]), pk_bf16(v1[2], v1[3])};
          }
        }
        if (mode == 0 && ssq != nullptr && u.pn < 2) {
          float s = 0.f;
#pragma unroll
          for (int bj = 0; bj < 2; ++bj)
#pragma unroll
            for (int n = 0; n < 2; ++n) { const f32x4 v = acc[ai][bj][m][n]; s += v[0] * v[0] + v[1] * v[1] + v[2] * v[2] + v[3] * v[3]; }
          s += __shfl_xor(s, 16); s += __shfl_xor(s, 32);
          if (fq == 0) atomicAdd(ssq + (size_t)row * 2 + u.pn, s);
        }
      }
  }
};
}
DEV void run_job(char* smem_base, const pg8::Job& j) {
  pg8::Gemm g; g.A = j.A; g.Bt = j.Bt; g.lda = j.lda; g.M = j.M; g.N = j.N; g.K = j.K; g.segstride = j.segstride; g.pnstrideA = j.pnstrideA;
  pg8::StaticOrder S; S.init(j.M, j.N, (int)gridDim.x, (int)blockIdx.x);
  pg8::EpiRT E; E.mode = j.mode; E.O = j.O; E.ldc = j.ldc; E.T = j.T; E.slat = j.slat; E.sctx = j.sctx; E.dlat = j.dlat; E.dctx = j.dctx; E.modg = j.modg; E.rows = j.rows; E.ssq = j.ssq; E.O2 = j.O2;
  pg8::gemm_phase<pg8::EpiRT>((PG8_LAS unsigned char*)smem_base, g, S, E);
}

DEV void ph_ada(const P& p, char* smem) {
  const int tid = get_tid();
  float* mod = (float*)(p.ws + OFF_MOD);
  if (vbid() < 192) {
    smem += vboff();
    float* sc = (float*)smem;
    for (int i = tid; i < 9 * 1024; i += 256) { const int bi = i >> 10, k = i & 1023; const float v = bi < 8 ? p.c[bi * 1024 + k] : p.c_ctx[k]; sc[i] = v * sigm(v); }
    __syncthreads();
    float* red = (float*)(smem + 36864);
    for (int item = vbid(); item < 192; item += vgrid()) {
      const int l = item / 96, n0 = (item % 96) * 64, nn = tid & 63, kq = tid >> 6;
      float acc[9];
#pragma unroll
      for (int b = 0; b < 9; ++b) acc[b] = 0.f;
      const float* w = p.ada_w + (size_t)l * 1024 * 6144 + n0 + nn;
      for (int k = kq * 256; k < kq * 256 + 256; ++k) {
        const float wv = w[(size_t)k * 6144];
#pragma unroll
        for (int b = 0; b < 9; ++b) acc[b] += sc[b * 1024 + k] * wv;
      }
#pragma unroll
      for (int b = 0; b < 9; ++b) red[(kq * 9 + b) * 64 + nn] = acc[b];
      __syncthreads();
      for (int e = tid; e < 9 * 64; e += 256) {
        const int b = e >> 6, n = e & 63;
        const float v = red[(0 * 9 + b) * 64 + n] + red[(1 * 9 + b) * 64 + n] + red[(2 * 9 + b) * 64 + n] + red[(3 * 9 + b) * 64 + n];
        mod[((size_t)l * 9 + b) * 6144 + n0 + n] = v + p.ada_b[l * 6144 + n0 + n];
      }
      __syncthreads();
    }
  } else if (vbid() == 192) {
    float2* rope = (float2*)(p.ws + OFF_ROPE);
    for (int e = tid; e < 512; e += 256) {
      const int pos = e >> 3, f = e & 7;
      const float inv = exp2f(-(float)f * 0.125f * 13.287712379549449f);
      float s, c; sincos_d((double)((float)pos * inv), s, c);
      rope[e] = make_float2(c, s);
    }
  }
}

DEV int map_col(int mode, int n) {
  if (mode == 0) return n;
  if (mode == 1) {
    if (n < 512) return n;
    if (n < 2560) return n + 32;
    if (n < 2592) return 512 + (n - 2560);
    if (n < 2816) return -1;
    return 2592 + (n - 2816);
  }
  if (mode == 2) {
    const int tile = n >> 7, nb = n & 127, wn = nb >> 6, j = (nb >> 4) & 3, cc = nb & 15;
    return (j < 2) ? tile * 64 + wn * 32 + j * 16 + cc : 1024 + tile * 64 + wn * 32 + (j - 2) * 16 + cc;
  }
  const int h = n / 96, d = n % 96;
  if (d < 64) return n;
  const int pp = d - 64, a = pp >> 4, f = (pp & 15) >> 1, half = pp & 1;
  return h * 96 + 64 + a * 16 + half * 8 + f;
}
DEV void cvt_tile(const float* __restrict__ src, int K, int Nsrc, bf16_t* __restrict__ dst, int mode, const float* __restrict__ gain, int nt, int kt, char* smem) {
  float* tile = (float*)smem + (vboff() >> 2);
  const int tid = get_tid();
  const int n0 = nt * 64, k0 = kt * 64;
  if (mode == 3) {
    const int r = tid >> 6, c = tid & 63;
    const int sn = map_col(mode, n0 + c);
#pragma unroll 4
    for (int i = 0; i < 16; ++i) {
      const int k = k0 + r + 4 * i;
      float v = sn >= 0 ? src[(size_t)k * Nsrc + sn] : 0.f;
      if (gain) v *= gain[k];
      tile[(r + 4 * i) * 65 + c] = v;
    }
  } else {
    const int r = tid >> 4, c4 = (tid & 15) * 4;
    const int sn = map_col(mode, n0 + c4);
#pragma unroll
    for (int i = 0; i < 4; ++i) {
      const int k = k0 + r + 16 * i;
      f32x4 v = sn >= 0 ? *(const f32x4*)(src + (size_t)k * Nsrc + sn) : (f32x4){0.f, 0.f, 0.f, 0.f};
      if (gain) v = v * gain[k];
      float* t = tile + (r + 16 * i) * 65 + c4;
      t[0] = v[0]; t[1] = v[1]; t[2] = v[2]; t[3] = v[3];
    }
  }
  __syncthreads();
  {
    const int n = tid >> 2, kp = (tid & 3) * 16;
    u32x4 w0, w1;
    w0.x = pk_bf16(tile[(kp + 0) * 65 + n], tile[(kp + 1) * 65 + n]);   w0.y = pk_bf16(tile[(kp + 2) * 65 + n], tile[(kp + 3) * 65 + n]);
    w0.z = pk_bf16(tile[(kp + 4) * 65 + n], tile[(kp + 5) * 65 + n]);   w0.w = pk_bf16(tile[(kp + 6) * 65 + n], tile[(kp + 7) * 65 + n]);
    w1.x = pk_bf16(tile[(kp + 8) * 65 + n], tile[(kp + 9) * 65 + n]);   w1.y = pk_bf16(tile[(kp + 10) * 65 + n], tile[(kp + 11) * 65 + n]);
    w1.z = pk_bf16(tile[(kp + 12) * 65 + n], tile[(kp + 13) * 65 + n]); w1.w = pk_bf16(tile[(kp + 14) * 65 + n], tile[(kp + 15) * 65 + n]);
    u32x4* d = (u32x4*)(dst + (size_t)(n0 + n) * K + k0 + kp);
    d[0] = w0; d[1] = w1;
  }
  __syncthreads();
}
DEV void cvt_item(const P& p, int l, int it, char* smem) {
  char* ws = p.ws;
  if (it < 1472) { cvt_tile(p.w_in + (size_t)l * 1024 * 5664, 1024, 5664, (bf16_t*)(ws + OFF_WIN), 1, nullptr, it / 16, it % 16, smem); return; }
  it -= 1472;
  if (it < 48) { cvt_tile(p.w_uq + (size_t)l * 256 * 768, 256, 768, (bf16_t*)(ws + OFF_WUQ), 3, p.q_norm + l * 256, it / 4, it % 4, smem); return; }
  it -= 48;
  if (it < 64) { cvt_tile(p.w_ukv + (size_t)l * 256 * 1024, 256, 1024, (bf16_t*)(ws + OFF_WUKV), 0, p.kv_norm + l * 256, it / 4, it % 4, smem); return; }
  it -= 64;
  if (it < 128) { cvt_tile(p.w_o + (size_t)l * 512 * 1024, 512, 1024, (bf16_t*)(ws + OFF_WO), 0, nullptr, it / 8, it % 8, smem); return; }
  it -= 128;
  if (it < 128) { cvt_tile(p.conv_w_out + (size_t)l * 512 * 1024, 512, 1024, (bf16_t*)(ws + OFF_WC), 0, nullptr, it / 8, it % 8, smem); return; }
  it -= 128;
  if (it < 256) { cvt_tile(p.w_glu + (size_t)l * 512 * 2048, 512, 2048, (bf16_t*)(ws + OFF_WGLU), 0, nullptr, it / 8, it % 8, smem); return; }
  it -= 256;
  if (it < 256) { cvt_tile(p.w_out + (size_t)l * 1024 * 1024, 1024, 1024, (bf16_t*)(ws + OFF_WOUT), 0, nullptr, it / 16, it % 16, smem); return; }
  it -= 256;
  if (it < 1024) { cvt_tile(p.w1 + (size_t)l * 1024 * 4096, 1024, 4096, (bf16_t*)(ws + OFF_W1), 0, nullptr, it / 16, it % 16, smem); return; }
  it -= 1024;
  cvt_tile(p.w2 + (size_t)l * 4096 * 1024, 4096, 1024, (bf16_t*)(ws + OFF_W2), 0, nullptr, it / 64, it % 64, smem);
}
constexpr int N_CVT = 4400;

struct Disc { double dt; float are, aim, fre, fim; };
DEV Disc s5_disc(const P& p, int l, int dir, int g, int pp) {
  Disc d; const int gi = (l * 2 + dir) * 32 + g;
  d.dt = (double)expf(p.log_dt[gi]); d.are = p.a_re[gi * 64 + pp]; d.aim = p.a_im[gi * 64 + pp];
  const float mag = __expf((float)(d.dt * (double)d.are)); float sn, cs; sincos_d(d.dt * (double)d.aim, sn, cs);
  const float abr = mag * cs, abi = mag * sn, den = d.are * d.are + d.aim * d.aim, nr = abr - 1.0f, ni = abi;
  d.fre = (nr * d.are + ni * d.aim) / den; d.fim = (ni * d.are - nr * d.aim) / den;
  return d;
}
DEV float2 cpow(const Disc& d, int e) {
  const float mag = __expf((float)((double)e * d.dt * (double)d.are)); float sn, cs; sincos_d((double)e * d.dt * (double)d.aim, sn, cs);
  return make_float2(mag * cs, mag * sn);
}
DEV float2 cmulf(float2 a, float2 b) { return make_float2(a.x * b.x - a.y * b.y, a.x * b.y + a.y * b.x); }

DEV void ktab_item(const P& p, int l, int it, char* smem) {
  const int tid = get_tid();
  const int lb = it & 7, dir = (it >> 3) & 1, g = it >> 4, gi = (l * 2 + dir) * 32 + g;
  smem += vboff();
  float2* CW = (float2*)smem;
  float2* BB = (float2*)(smem + 32768);
  float2* WL = (float2*)(smem + 40960);
  float2* FL = (float2*)(smem + 43008);
  {
    const int li = tid >> 6, pp = tid & 63;
    const Disc d = s5_disc(p, l, dir, g, pp);
    WL[tid] = cpow(d, lb * 4 + li);
    if (li == 0) FL[pp] = make_float2(d.fre, d.fim);
  }
  __syncthreads();
  for (int e = tid; e < 4096; e += 256) {
    const int li = e >> 10, co = (e >> 6) & 15, pp = e & 63;
    const float2 c = make_float2(p.c_re[((size_t)gi * 16 + co) * 64 + pp], p.c_im[((size_t)gi * 16 + co) * 64 + pp]);
    CW[e] = cmulf(c, WL[li * 64 + pp]);
  }
  for (int e = tid; e < 1024; e += 256) {
    const int pp = e >> 4;
    const float2 b = make_float2(p.b_re[(size_t)gi * 1024 + e], p.b_im[(size_t)gi * 1024 + e]);
    BB[e] = cmulf(FL[pp], b);
  }
  __syncthreads();
  float* ktab = (float*)(p.ws + OFF_KTAB);
  const int co = tid >> 4, ci = tid & 15;
#pragma unroll
  for (int li = 0; li < 4; ++li) {
    float acc = 0.f;
    for (int pp = 0; pp < 64; ++pp) { const float2 cw = CW[(li * 16 + co) * 64 + pp], bb = BB[pp * 16 + ci]; acc += cw.x * bb.x - cw.y * bb.y; }
    ktab[(((size_t)g * 2 + dir) * 32 + lb * 4 + li) * 256 + co * 16 + ci] = acc;
  }
  __syncthreads();
}
DEV void ef_item(const P& p, int l, int it) {
  const int g = it >> 4, id = (it & 15) * 256 + get_tid();
  const int t = id & 31, pp = (id >> 5) & 63, dir = id >> 11, gi = (l * 2 + dir) * 32 + g;
  const Disc d = s5_disc(p, l, dir, g, pp);
  const float2 we = cpow(d, dir == 0 ? t + 1 : 32 - t), wf = cpow(d, dir == 0 ? 31 - t : t);
  unsigned* Et = (unsigned*)(p.ws + OFF_ET) + (size_t)g * 512 * 128;
  bf16_t* Ft = (bf16_t*)(p.ws + OFF_FT) + (size_t)g * 256 * 512;
#pragma unroll
  for (int c = 0; c < 16; ++c) {
    const float2 cc = make_float2(p.c_re[((size_t)gi * 16 + c) * 64 + pp], p.c_im[((size_t)gi * 16 + c) * 64 + pp]);
    const float2 cw = cmulf(cc, we);
    Et[(size_t)(t * 16 + c) * 128 + dir * 64 + pp] = pk_bf16(cw.x, -cw.y);
  }
  const float2 f = make_float2(d.fre, d.fim);
  unsigned fr[8], fi[8];
#pragma unroll
  for (int c2 = 0; c2 < 8; ++c2) {
    const size_t bi = ((size_t)gi * 64 + pp) * 16 + c2 * 2;
    const float2 v0 = cmulf(wf, cmulf(f, make_float2(p.b_re[bi], p.b_im[bi])));
    const float2 v1 = cmulf(wf, cmulf(f, make_float2(p.b_re[bi + 1], p.b_im[bi + 1])));
    fr[c2] = pk_bf16(v0.x, v1.x); fi[c2] = pk_bf16(v0.y, v1.y);
  }
  u32x4* r0 = (u32x4*)(Ft + (size_t)(dir * 128 + pp * 2) * 512 + t * 16);
  u32x4* r1 = (u32x4*)(Ft + (size_t)(dir * 128 + pp * 2 + 1) * 512 + t * 16);
  r0[0] = (u32x4){fr[0], fr[1], fr[2], fr[3]}; r0[1] = (u32x4){fr[4], fr[5], fr[6], fr[7]};
  r1[0] = (u32x4){fi[0], fi[1], fi[2], fi[3]}; r1[1] = (u32x4){fi[4], fi[5], fi[6], fi[7]};
}
DEV void mt_item(const P& p, int l, int it) {
  const int g = it >> 7, id = (it & 127) * 256 + get_tid();
  const int k8 = id & 63, n = id >> 6, ti = k8 >> 1, ci0 = (k8 & 1) * 8, to = n >> 4, co = n & 15;
  const float* ktab = (const float*)(p.ws + OFF_KTAB);
  float v[8];
  if (to != ti) {
    const int dir = to > ti ? 0 : 1, lag = to > ti ? to - ti : ti - to;
    const f32x4* s = (const f32x4*)(ktab + (((size_t)g * 2 + dir) * 32 + lag) * 256 + co * 16 + ci0);
    const f32x4 a = s[0], b = s[1];
    v[0] = a[0]; v[1] = a[1]; v[2] = a[2]; v[3] = a[3]; v[4] = b[0]; v[5] = b[1]; v[6] = b[2]; v[7] = b[3];
  } else {
    const f32x4* s0 = (const f32x4*)(ktab + (((size_t)g * 2 + 0) * 32) * 256 + co * 16 + ci0);
    const f32x4* s1 = (const f32x4*)(ktab + (((size_t)g * 2 + 1) * 32) * 256 + co * 16 + ci0);
    const f32x4 a = s0[0] + s1[0], b = s0[1] + s1[1];
    v[0] = a[0]; v[1] = a[1]; v[2] = a[2]; v[3] = a[3]; v[4] = b[0]; v[5] = b[1]; v[6] = b[2]; v[7] = b[3];
    const float dd = p.s5_d[l * 512 + g * 16 + co];
#pragma unroll
    for (int e = 0; e < 8; ++e) if (ci0 + e == co) v[e] += dd;
  }
  u32x4 w; w.x = pk_bf16(v[0], v[1]); w.y = pk_bf16(v[2], v[3]); w.z = pk_bf16(v[4], v[5]); w.w = pk_bf16(v[6], v[7]);
  *(u32x4*)((bf16_t*)(p.ws + OFF_MT) + ((size_t)g * 512 + n) * 512 + k8 * 8) = w;
}

DEV void norm_rows(const P& p, const float* lat, const float* ctxp, int nrows, const float* gain, const float* modl, int ishift, int iscale) {
  const int lane = get_tid() & 63, wid = get_tid() >> 6;
  bf16_t* XN = (bf16_t*)(p.ws + OFF_XN);
  for (int item = vbid(); item < nrows / 8; item += vgrid()) {
    const int row0 = item * 8 + wid * 2;
    f32x4 v[2][4]; float ss[2];
#pragma unroll
    for (int q = 0; q < 2; ++q) {
      const int row = row0 + q;
      const float* src = row < MLAT ? lat + (size_t)row * 1024 : ctxp + (size_t)(row - MLAT) * 1024;
#pragma unroll
      for (int i = 0; i < 4; ++i) v[q][i] = ((const f32x4*)src)[lane + 64 * i];
    }
#pragma unroll
    for (int q = 0; q < 2; ++q) {
      float s = 0.f;
#pragma unroll
      for (int i = 0; i < 4; ++i) s += v[q][i][0] * v[q][i][0] + v[q][i][1] * v[q][i][1] + v[q][i][2] * v[q][i][2] + v[q][i][3] * v[q][i][3];
      ss[q] = wave_sum(s);
    }
#pragma unroll
    for (int q = 0; q < 2; ++q) {
      const int row = row0 + q, bi = row < MLAT ? row >> 12 : 8;
      const float rstd = rsqrtf(ss[q] * (1.0f / 1024.0f) + EPSN);
      const float* msh = modl + ((size_t)bi * 6 + ishift) * 1024; const float* msc = modl + ((size_t)bi * 6 + iscale) * 1024;
#pragma unroll
      for (int i = 0; i < 4; ++i) {
        const int col = (lane + 64 * i) * 4;
        const f32x4 g = *(const f32x4*)(gain + col), sh = *(const f32x4*)(msh + col), sc = *(const f32x4*)(msc + col);
        const f32x4 y = v[q][i] * rstd * g * (sc + 1.0f) + sh;
        *(u32x2*)(XN + (size_t)row * 1024 + col) = (u32x2){pk_bf16(y[0], y[1]), pk_bf16(y[2], y[3])};
      }
    }
  }
}
DEV void ph_final(const P& p) {
  const int lane = get_tid() & 63, wid = get_tid() >> 6;
  for (int item = vbid(); item < MLAT / 8; item += vgrid()) {
    const int row0 = item * 8 + wid * 2;
    f32x4 v[2][4]; float ss[2];
#pragma unroll
    for (int q = 0; q < 2; ++q)
#pragma unroll
      for (int i = 0; i < 4; ++i) v[q][i] = ((const f32x4*)(p.out + (size_t)(row0 + q) * 1024))[lane + 64 * i];
#pragma unroll
    for (int q = 0; q < 2; ++q) {
      float s = 0.f;
#pragma unroll
      for (int i = 0; i < 4; ++i) s += v[q][i][0] * v[q][i][0] + v[q][i][1] * v[q][i][1] + v[q][i][2] * v[q][i][2] + v[q][i][3] * v[q][i][3];
      ss[q] = wave_sum(s);
    }
#pragma unroll
    for (int q = 0; q < 2; ++q) {
      const float rstd = rsqrtf(ss[q] * (1.0f / 1024.0f) + EPSN);
#pragma unroll
      for (int i = 0; i < 4; ++i) { const int col = (lane + 64 * i) * 4; const f32x4 g = *(const f32x4*)(p.norm_final + col); ((f32x4*)(p.out + (size_t)(row0 + q) * 1024))[lane + 64 * i] = v[q][i] * rstd * g; }
    }
  }
}

DEV void ph_prep(const P& p, int l, char* smem) {
  for (int r_ = 0, nr_ = rounds_of(N_CVT); r_ < nr_; ++r_) { int it = vbid() + r_ * vgrid(); it = it < N_CVT ? it : N_CVT - 1; cvt_item(p, l, it, smem); }
  for (int r_ = 0, nr_ = rounds_of(512); r_ < nr_; ++r_) { int it = vbid() + r_ * vgrid(); it = it < 512 ? it : 511; ktab_item(p, l, it, smem); }
  for (int it = vbid(); it < 512; it += vgrid()) ef_item(p, l, it);
  { float* ssq = (float*)(p.ws + OFF_SSQ); const int step = vgrid() * 256; int i = vbid() * 256 + get_tid();
#pragma unroll
    for (int e = 0; e < 4; ++e) { if (i < MALL * 2) ssq[i] = 0.f; i += step; } }
  const float* modl = (const float*)(p.ws + OFF_MOD) + (size_t)l * 9 * 6144;
  if (l == 0) norm_rows(p, p.x, p.ctx, MALL, p.norm_mix, modl, 0, 1);
  else norm_rows(p, p.out, (const float*)(p.ws + OFF_XC), MALL, p.norm_mix + 1024, modl, 0, 1);
}

DEV void ph_in(const P& p, int l, char* smem) {
  for (int it = vbid(); it < 4096; it += vgrid()) mt_item(p, l, it);
}

DEV void rms_rows(const bf16_t* zb, int row0, int rmax, float* srstd) {
  const int tid = get_tid(), r = tid >> 1, half = tid & 1;
  int row = row0 + r; row = row < rmax ? row : rmax - 1;
  const u32x4* q = (const u32x4*)(zb + (size_t)row * LDZ + half * 128);
  float ss = 0.f;
#pragma unroll 4
  for (int i = 0; i < 16; ++i) {
    const u32x4 w = q[i];
    ss += bflo(w.x) * bflo(w.x) + bfhi(w.x) * bfhi(w.x) + bflo(w.y) * bflo(w.y) + bfhi(w.y) * bfhi(w.y) + bflo(w.z) * bflo(w.z) + bfhi(w.z) * bfhi(w.z) + bflo(w.w) * bflo(w.w) + bfhi(w.w) * bfhi(w.w);
  }
  ss += __shfl_xor(ss, 1);
  if (!half) srstd[r] = rsqrtf(ss * (1.0f / 256.0f) + EPSN);
  __syncthreads();
}

DEV void ph_mid(const P& p, int l, bool need, char* smem) {
  const int tid = get_tid(), lane = tid & 63, wid = tid >> 6, wm = wid >> 1, wn = wid & 1, l15 = lane & 15, lq = lane >> 4;
  bf16_t* Z = (bf16_t*)(p.ws + OFF_Z);
  bf16_t* Qb = (bf16_t*)(p.ws + OFF_Q); bf16_t* Kb = (bf16_t*)(p.ws + OFF_K); bf16_t* Vt = (bf16_t*)(p.ws + OFF_VT);
  float* srstd = (float*)(smem + 65536) + (vboff() >> 2);
  const float2* rope = (const float2*)(p.ws + OFF_ROPE);
  for (int it = vbid(); it < MALL / 16; it += vgrid()) {
    const int row = it * 16 + (tid >> 4), e = tid & 15, a = e >> 3, f = e & 7;
    const bf16_t* zp = Z + (size_t)row * LDZ + ZPE + a * 16 + f;
    float x0 = __uint_as_float((unsigned)zp[0] << 16), x1 = __uint_as_float((unsigned)zp[8] << 16);
    int b, key;
    if (row < MLAT) {
      b = row >> 12; const int n = row & 4095; key = 256 + n;
      const float2 cs = rope[(a ? (n & 63) : (n >> 6)) * 8 + f];
      const float t0 = x0 * cs.x - x1 * cs.y, t1 = x1 * cs.x + x0 * cs.y; x0 = t0; x1 = t1;
    } else { const int cr = row - MLAT; b = cr >> 8; key = cr & 255; }
    const unsigned w = pk_bf16(x0, x1);
#pragma unroll
    for (int h = 0; h < 8; ++h) *(unsigned*)(Kb + ((size_t)(b * 8 + h) * NKEY + key) * 96 + 64 + a * 16 + f * 2) = w;
  }
}

DEV void ph_carry(const P& p, int l, bool need) {
  const int tid = get_tid();
  bf16_t* Z = (bf16_t*)(p.ws + OFF_Z);
  for (int it = vbid(); it < 128; it += vgrid()) {
    const int idx = it * 256 + tid, pp = idx & 63, dir = (idx >> 6) & 1, g = (idx >> 7) & 31, b = idx >> 12;
    const Disc d = s5_disc(p, l, dir, g, pp);
    const float2 at = cpow(d, 32);
    unsigned* S = (unsigned*)(p.ws + OFF_S) + (g * 256 + dir * 128 + pp * 2) / 2;
    float sr = 0.f, si = 0.f;
    for (int blk = 0; blk < 17; ++blk) {
      unsigned v[8]; int rows[8];
#pragma unroll
      for (int e = 0; e < 8; ++e) {
        int r;
        if (blk == 0) r = 1024 + b * 8 + (dir ? 7 - e : e);
        else { const int j = (blk - 1) * 8 + e; r = b * 128 + (dir ? 127 - j : j); }
        rows[e] = r; v[e] = S[(size_t)r * 4096];
      }
#pragma unroll
      for (int e = 0; e < 8; ++e) {
        S[(size_t)rows[e] * 4096] = pk_bf16(sr, si);
        const float nr = at.x * sr - at.y * si + bflo(v[e]), ni = at.x * si + at.y * sr + bfhi(v[e]);
        sr = nr; si = ni;
      }
    }
  }
  {
    const int Mc = need ? MALL : MLAT;
    const int ch = (tid & 63) * 8, rsub = tid >> 6;
    const float* cw = p.conv_w + (size_t)l * 3 * 512 + ch;
    float w0[8], w1[8], w2[8];
#pragma unroll
    for (int e = 0; e < 8; ++e) { w0[e] = cw[e]; w1[e] = cw[512 + e]; w2[e] = cw[1024 + e]; }
    for (int it = vbid(); it < Mc / 32; it += vgrid()) {
      const int rbase = it * 32 + rsub * 8;
      float up[8], uc[8], un[8];
      auto loadu = [&](int row, bool valid, float (&u)[8]) {
        if (valid) {
          const u32x4 c = *(const u32x4*)(Z + (size_t)row * LDZ + ZCC + ch), x = *(const u32x4*)(Z + (size_t)row * LDZ + ZCX + ch);
          u[0] = bflo(c.x) * bflo(x.x); u[1] = bfhi(c.x) * bfhi(x.x); u[2] = bflo(c.y) * bflo(x.y); u[3] = bfhi(c.y) * bfhi(x.y);
          u[4] = bflo(c.z) * bflo(x.z); u[5] = bfhi(c.z) * bfhi(x.z); u[6] = bflo(c.w) * bflo(x.w); u[7] = bfhi(c.w) * bfhi(x.w);
        } else {
#pragma unroll
          for (int e = 0; e < 8; ++e) u[e] = 0.f;
        }
      };
      auto tpos = [&](int row, int& t, int& len) { if (row < MLAT) { t = row & 4095; len = 4096; } else { t = (row - MLAT) & 255; len = 256; } };
      int t0, len0; tpos(rbase, t0, len0);
      loadu(rbase - 1, t0 > 0, up); loadu(rbase, true, uc);
#pragma unroll
      for (int rr = 0; rr < 8; ++rr) {
        const int row = rbase + rr; int t, len; tpos(row, t, len);
        loadu(row + 1, t < len - 1, un);
        const u32x4 zb = *(const u32x4*)(Z + (size_t)row * LDZ + ZCB + ch);
        float y[8];
#pragma unroll
        for (int e = 0; e < 8; ++e) y[e] = w0[e] * up[e] + w1[e] * uc[e] + w2[e] * un[e];
        u32x4 o;
        o.x = pk_bf16(bflo(zb.x) * y[0], bfhi(zb.x) * y[1]); o.y = pk_bf16(bflo(zb.y) * y[2], bfhi(zb.y) * y[3]);
        o.z = pk_bf16(bflo(zb.z) * y[4], bfhi(zb.z) * y[5]); o.w = pk_bf16(bflo(zb.w) * y[6], bfhi(zb.w) * y[7]);
        *(u32x4*)(Z + (size_t)row * LDZ + ZCV + ch) = o;
#pragma unroll
        for (int e = 0; e < 8; ++e) { up[e] = uc[e]; uc[e] = un[e]; }
      }
    }
  }
}

DEV float max3a(float a, float b, float c) { float r; asm("v_max3_f32 %0, %1, %2, %3" : "=v"(r) : "v"(a), "v"(b), "v"(c)); return r; }
DEV void attn_item(const P& p, int bh, int qrow0, int nkt, int outrow0, char* smem) {
  int tid; asm volatile("v_mov_b32 %0, %1" : "=v"(tid) : "v"((int)threadIdx.x));
  const int lane = tid & 63, wid = __builtin_amdgcn_readfirstlane(tid >> 6), l15 = lane & 15, lq = lane >> 4;
  const bf16_t* Qb = (const bf16_t*)(p.ws + OFF_Q) + (size_t)bh * NKEY * 96;
  const bf16_t* Kb = (const bf16_t*)(p.ws + OFF_K) + (size_t)bh * NKEY * 96;
  const bf16_t* Vt = (const bf16_t*)(p.ws + OFF_VT) + (size_t)bh * 64 * NKEY;
  bf16_t* Z = (bf16_t*)(p.ws + OFF_Z);
  constexpr int KB = 16384, VB = 8192, VBASE = 6 * KB;
  int vo = 0; asm volatile("" : "+v"(vo));
  bf16x8 qf[2][3];
#pragma unroll
  for (int qt = 0; qt < 2; ++qt)
#pragma unroll
    for (int ks = 0; ks < 3; ++ks) qf[qt][ks] = *(const bf16x8*)(Qb + (size_t)(qrow0 + wid * 32 + qt * 16 + l15) * 96 + ks * 32 + lq * 8);
  f32x4 o[4][2];
#pragma unroll
  for (int vt = 0; vt < 4; ++vt)
#pragma unroll
    for (int qt = 0; qt < 2; ++qt) o[vt][qt] = (f32x4){0.f, 0.f, 0.f, 0.f};
  float mused[2] = {0.f, 0.f};
  f32x4 osum[2] = {(f32x4){0.f, 0.f, 0.f, 0.f}, (f32x4){0.f, 0.f, 0.f, 0.f}};
  const bf16x8 ones = __builtin_bit_cast(bf16x8, (u32x4){0x3f803f80u, 0x3f803f80u, 0x3f803f80u, 0x3f803f80u});
  u32x4 kr[4], vr[2];
  const int krow = tid >> 4, kc = tid & 15;
  const int vrow = tid >> 3, vc = tid & 7;
  const int kwo = vo + krow * 256 + ((kc ^ (krow & 15)) << 4), vwo = vo + VBASE + vrow * 128 + ((vc ^ ((vrow >> 1) & 7)) << 4);
  const int kro = vo + l15 * 256, vro = vo + VBASE + l15 * 128;
  f32x4 st[4][2];
  bf16x8 pf[2][2], vf[2][4];
#define ALOAD(kt) { const int key0_ = (kt) * 128; \
    if (kc < 12) { _Pragma("unroll") for (int i = 0; i < 4; ++i) kr[i] = *(const u32x4*)(Kb + (size_t)(key0_ + krow + 32 * i) * 96 + kc * 8); } \
    _Pragma("unroll") for (int i = 0; i < 2; ++i) vr[i] = *(const u32x4*)(Vt + (size_t)vrow * NKEY + key0_ + i * 64 + vc * 8); }
#define ASTORE(slot) { char* sk_ = smem + (slot) * KB; char* sv_ = smem + (slot) * VB; \
    if (kc < 12) { _Pragma("unroll") for (int i = 0; i < 4; ++i) *(u32x4*)(sk_ + kwo + i * 8192) = kr[i]; } \
    _Pragma("unroll") for (int i = 0; i < 2; ++i) *(u32x4*)(sv_ + vwo + i * VB) = vr[i]; }
#define LDK(dst, s_, ks_) { _Pragma("unroll") for (int kk = 0; kk < 4; ++kk) dst[kk] = *(const bf16x8*)((s_) + kk * 4096 + kro + ((((ks_) * 4 + lq) ^ l15) << 4)); }
#define MMK(src_, ks_) { _Pragma("unroll") for (int kk = 0; kk < 4; ++kk) _Pragma("unroll") for (int qt = 0; qt < 2; ++qt) st[kk][qt] = __builtin_amdgcn_mfma_f32_16x16x32_bf16(src_[kk], qf[qt][ks_], st[kk][qt], 0, 0, 0); }
#define QK(slot) { const char* s = smem + (slot) * KB; bf16x8 kfa[4], kfb[4]; \
    LDK(kfa, s, 0); LDK(kfb, s, 1); \
    _Pragma("unroll") for (int kk = 0; kk < 4; ++kk) _Pragma("unroll") for (int qt = 0; qt < 2; ++qt) { const float nm = -mused[qt]; st[kk][qt] = (f32x4){nm, nm, nm, nm}; } \
    __builtin_amdgcn_s_setprio(1); MMK(kfa, 0); LDK(kfa, s, 2); MMK(kfb, 1); MMK(kfa, 2); __builtin_amdgcn_s_setprio(0); }
#define SM(first) { _Pragma("unroll") for (int qt = 0; qt < 2; ++qt) { \
      float mx = max3a(st[0][qt][0], st[0][qt][1], st[0][qt][2]); \
      mx = max3a(mx, st[0][qt][3], st[1][qt][0]); mx = max3a(mx, st[1][qt][1], st[1][qt][2]); mx = max3a(mx, st[1][qt][3], st[2][qt][0]); \
      mx = max3a(mx, st[2][qt][1], st[2][qt][2]); mx = max3a(mx, st[2][qt][3], st[3][qt][0]); mx = max3a(mx, st[3][qt][1], st[3][qt][2]); mx = max3a(mx, st[3][qt][3], st[3][qt][3]); \
      if ((first) || __builtin_amdgcn_ballot_w64(mx > 8.0f) != 0) {     \
        mx = fmaxf(mx, __shfl_xor(mx, 16)); mx = fmaxf(mx, __shfl_xor(mx, 32)); \
        const float sc = __builtin_amdgcn_exp2f(-mx); \
        mused[qt] += mx; \
        _Pragma("unroll") for (int vt = 0; vt < 4; ++vt) o[vt][qt] = o[vt][qt] * sc; \
        osum[qt] = osum[qt] * sc; \
        _Pragma("unroll") for (int kk = 0; kk < 4; ++kk) _Pragma("unroll") for (int r = 0; r < 4; ++r) st[kk][qt][r] = __builtin_amdgcn_exp2f(st[kk][qt][r] - mx); \
      } else { \
        _Pragma("unroll") for (int kk = 0; kk < 4; ++kk) _Pragma("unroll") for (int r = 0; r < 4; ++r) st[kk][qt][r] = __builtin_amdgcn_exp2f(st[kk][qt][r]); \
      } \
      _Pragma("unroll") for (int k2 = 0; k2 < 2; ++k2) { \
        u32x4 w; \
        w.x = pk_bf16(st[2 * k2][qt][0], st[2 * k2][qt][1]); w.y = pk_bf16(st[2 * k2][qt][2], st[2 * k2][qt][3]); \
        w.z = pk_bf16(st[2 * k2 + 1][qt][0], st[2 * k2 + 1][qt][1]); w.w = pk_bf16(st[2 * k2 + 1][qt][2], st[2 * k2 + 1][qt][3]); \
        pf[qt][k2] = __builtin_bit_cast(bf16x8, w); } } }
#define PVLOAD(slot) { const char* s = smem + (slot) * VB; \
    _Pragma("unroll") for (int vt = 0; vt < 4; ++vt) vf[0][vt] = *(const bf16x8*)(s + vt * 2048 + vro + (((0 * 4 + lq) ^ (l15 >> 1)) << 4)); }
#define PVMMA(slot) { const char* s = smem + (slot) * VB; \
    _Pragma("unroll") for (int vt = 0; vt < 4; ++vt) vf[1][vt] = *(const bf16x8*)(s + vt * 2048 + vro + (((1 * 4 + lq) ^ (l15 >> 1)) << 4)); \
    __builtin_amdgcn_s_setprio(1); \
    _Pragma("unroll") for (int k2 = 0; k2 < 2; ++k2) _Pragma("unroll") for (int vt = 0; vt < 4; ++vt) \
      _Pragma("unroll") for (int qt = 0; qt < 2; ++qt) o[vt][qt] = __builtin_amdgcn_mfma_f32_16x16x32_bf16(vf[k2][vt], pf[qt][k2], o[vt][qt], 0, 0, 0); \
    _Pragma("unroll") for (int k2 = 0; k2 < 2; ++k2) _Pragma("unroll") for (int qt = 0; qt < 2; ++qt) osum[qt] = __builtin_amdgcn_mfma_f32_16x16x32_bf16(ones, pf[qt][k2], osum[qt], 0, 0, 0); \
    __builtin_amdgcn_s_setprio(0); }
  const bool skew = vbsel() != 0;
  asm volatile("" : "+s"(nkt));
#define ABAR() { asm volatile("s_waitcnt lgkmcnt(0)" ::: "memory"); __builtin_amdgcn_s_barrier(); asm volatile("" ::: "memory"); }
  const int npair = nkt >> 1;
  ALOAD(0); ASTORE(0); if (npair > 1) ALOAD(1); ABAR();
  int s0 = 0;
#pragma nounroll
  for (int kp = 0; kp < npair; ++kp) {
    const int sn = (s0 == 4) ? 0 : s0 + 2;
    if (kp + 1 < npair) ASTORE(sn);
    if (kp + 2 < npair) ALOAD(kp + 2);
    if (!skew) {
      QK(s0); PVLOAD(s0); __builtin_amdgcn_sched_barrier(0); SM(kp == 0); PVMMA(s0);
      QK(s0 + 1); PVLOAD(s0 + 1); __builtin_amdgcn_sched_barrier(0); SM(false); PVMMA(s0 + 1);
    } else {
      if (kp > 0) { const int sp = (s0 == 0) ? 5 : s0 - 1; PVLOAD(sp); __builtin_amdgcn_sched_barrier(0); SM(false); PVMMA(sp); }
      QK(s0);
      PVLOAD(s0); __builtin_amdgcn_sched_barrier(0); SM(kp == 0); PVMMA(s0);
      QK(s0 + 1);
    }
    ABAR();
    s0 = sn;
  }
  if (skew) { const int sp = (s0 == 0) ? 5 : s0 - 1; PVLOAD(sp); SM(false); PVMMA(sp); }
  ABAR();
#undef ABAR
#undef ALOAD
#undef ASTORE
#undef QK
#undef SM
#undef PVLOAD
#undef PVMMA
#undef LDK
#undef MMK
  const int h = bh & 7;
#pragma unroll
  for (int qt = 0; qt < 2; ++qt) {
    const float inv = 1.0f / osum[qt][0];
    const int row = outrow0 + wid * 32 + qt * 16 + l15;
#pragma unroll
    for (int vt = 0; vt < 4; ++vt) {
      const f32x4 v = o[vt][qt] * inv;
      *(u32x2*)(Z + (size_t)row * LDZ + ZAO + h * 64 + vt * 16 + lq * 4) = (u32x2){pk_bf16(v[0], v[1]), pk_bf16(v[2], v[3])};
    }
  }
}

DEV float gelu_t(float x) { const float z = 0.7978845608028654f * (x + 0.044715f * x * x * x); const float e = __builtin_amdgcn_exp2f(z * 2.8853900817779268f); return x * (1.0f - __builtin_amdgcn_rcpf(1.0f + e)); }

DEV void ph_attn(const P& p, int l, bool need, char* smem) {
  const int tid = get_tid(), lane = tid & 63, wid = tid >> 6, wm = wid >> 1, wn = wid & 1, l15 = lane & 15, lq = lane >> 4;
  bf16_t* Z = (bf16_t*)(p.ws + OFF_Z);
  {
    const bf16_t* Mt = (const bf16_t*)(p.ws + OFF_MT); const bf16_t* Et = (const bf16_t*)(p.ws + OFF_ET); const bf16_t* S = (const bf16_t*)(p.ws + OFF_S);
    const int nmt = need ? 9 : 8, rmax = need ? NCH : 1024;
    for (int r_ = 0, nr_ = rounds_of(32 * nmt * 4); r_ < nr_; ++r_) { int t = vbid() + r_ * vgrid(); t = t < (32 * nmt * 4) ? t : (32 * nmt * 4) - 1;
      const int g = t / (nmt * 4), mt = (t % (nmt * 4)) >> 2, nt = t & 3;
      f32x4 acc[4][4]; zero_acc<4>(acc);
      ASrc a; a.p = Z + ZS5 + g * 16; a.lda = 32 * LDZ; a.row0 = mt * 128; a.rmax = rmax; a.segshift = 4; a.segstride = LDZ;
      gemm_core<4, true>(acc, a, Mt + ((size_t)g * 512 + nt * 128) * 512, 512, 512, smem);
      gemm_core<4, true>(acc, asrc(S + g * 256, 8192, mt * 128, rmax), Et + ((size_t)g * 512 + nt * 128) * 256, 256, 256, smem);
#pragma unroll
      for (int i = 0; i < 4; ++i) {
        const int crow = mt * 128 + wm * 64 + i * 16 + l15;
        if (crow < rmax) {
#pragma unroll
          for (int j = 0; j < 4; ++j) {
            const int n = nt * 128 + wn * 64 + j * 16 + lq * 4, tt = n >> 4, c = n & 15;
            *(u32x2*)(Z + (size_t)(crow * 32 + tt) * LDZ + ZS5A + g * 16 + c) =
                (u32x2){pk_bf16(gelu_t(acc[i][j][0]), gelu_t(acc[i][j][1])), pk_bf16(gelu_t(acc[i][j][2]), gelu_t(acc[i][j][3]))};
          }
        }
      }
    }
  }
  for (int it = blockIdx.x; it < 1024; it += gridDim.x) {
    const int r = it >> 8, w = it & 255, xcd = w & 7, slot = w >> 3;
    const int bh = r * 16 + xcd * 2 + (slot >> 4), qb = slot & 15;
    attn_item(p, bh, qb * 256, 68, (bh >> 3) * 4096 + qb * 256, smem);
  }
  if (need) for (int it = blockIdx.x; it < 64; it += gridDim.x) attn_item(p, it, 4096, 4, MLAT + (it >> 3) * 256, smem);
}

DEV int n_jobs(int ph) { return ph == 2 ? 1 : ph == 3 ? 3 : ph == 6 ? 7 : (ph == 7 || ph == 9 || ph == 10) ? 1 : 0; }
DEV pg8::Job get_job(KP kp, int ph, int l, int j) {
  const P p = ldp(kp);
  const bool need = (l == 0); const int M = need ? MALL : MLAT;
  char* ws = p.ws;
  const bf16_t* Z = (const bf16_t*)(ws + OFF_Z); const bf16_t* XN = (const bf16_t*)(ws + OFF_XN);
  const bf16_t* Wg = (const bf16_t*)(ws + OFF_WIN) + (size_t)LDZ * 1024;
  bf16_t* T = (bf16_t*)(ws + OFF_T); bf16_t* MG = (bf16_t*)(ws + OFF_MG);
  float* xc = (float*)(ws + OFF_XC);
  pg8::Job b; b.lda = 1024; b.M = M; b.N = 1024; b.K = 1024; b.mode = 0; b.O = T; b.ldc = 1024; b.T = T; b.slat = p.out; b.sctx = xc; b.dlat = p.out; b.dctx = xc;
  b.modg = (const float*)(ws + OFF_MOD) + (size_t)l * 9 * 6144; b.A = XN; b.Bt = Wg;
  b.segstride = 0; b.pnstrideA = 0; b.rows = M; b.ssq = nullptr; b.O2 = nullptr;
  if (ph == 2) { b.M = MALL; b.rows = MALL; b.N = LDZ; b.Bt = (const bf16_t*)(ws + OFF_WIN); b.O = (bf16_t*)(ws + OFF_Z); b.ldc = LDZ; b.ssq = (float*)(ws + OFF_SSQ); }
  else if (ph == 3) {
    b.ssq = (float*)(ws + OFF_SSQ); b.K = 256; b.lda = LDZ; b.modg = (const float*)(ws + OFF_ROPE);
    if (j == 0) { b.A = Z + ZQ; b.Bt = (const bf16_t*)(ws + OFF_WUQ); b.N = 768; b.mode = 6; b.O = (bf16_t*)(ws + OFF_Q); }
    else if (j == 1) { b.A = Z + ZKV; b.Bt = (const bf16_t*)(ws + OFF_WUKV); b.M = MALL; b.rows = MALL; b.N = 1024; b.mode = 7; b.O = (bf16_t*)(ws + OFF_K); b.O2 = (bf16_t*)(ws + OFF_VT); }
    else { b.ssq = nullptr; b.A = Z + ZS5; b.lda = 32 * LDZ; b.segstride = LDZ; b.pnstrideA = 16; b.Bt = (const bf16_t*)(ws + OFF_FT); b.M = 1280; b.rows = NCH; b.N = 8192; b.K = 512; b.mode = 0; b.O = (bf16_t*)(ws + OFF_S); b.ldc = 8192; }
  }
  else if (ph == 6) {
    if (j == 0) { b.A = Z + ZAO; b.lda = LDZ; b.Bt = (const bf16_t*)(ws + OFF_WO); b.K = 512; }
    else if (j == 1) { b.mode = 2; b.O = MG; }
    else if (j == 2) { b.A = Z + ZCV; b.lda = LDZ; b.Bt = (const bf16_t*)(ws + OFF_WC); b.K = 512; }
    else if (j == 3) { b.mode = 3; b.O = MG; b.Bt = Wg + (size_t)1024 * 1024; }
    else if (j == 4) { b.A = Z + ZS5A; b.lda = LDZ; b.Bt = (const bf16_t*)(ws + OFF_WGLU); b.K = 512; }
    else if (j == 5) { b.A = Z + ZS5A; b.lda = LDZ; b.Bt = (const bf16_t*)(ws + OFF_WGLU) + (size_t)1024 * 512; b.K = 512; b.mode = 1; }
    else { b.mode = 3; b.O = MG; b.Bt = Wg + (size_t)2048 * 1024; }
  } else if (ph == 7) {
    b.A = MG; b.Bt = (const bf16_t*)(ws + OFF_WOUT); b.mode = 5; b.modg += 2 * 1024;
    if (l == 0) { b.slat = p.x; b.sctx = p.ctx; }
  } else if (ph == 9) { b.Bt = (const bf16_t*)(ws + OFF_W1); b.N = 4096; b.mode = 4; b.O = (bf16_t*)(ws + OFF_Z); b.ldc = 4096; }
  else { b.A = Z; b.lda = 4096; b.K = 4096; b.Bt = (const bf16_t*)(ws + OFF_W2); b.mode = 5; b.modg += 5 * 1024; }
  return b;
}

#define LAS __attribute__((address_space(3)))
#define XB_TMO      128
#define XB_XCNT(j)  (256  + 64 * (j))
#define XB_XSUB(j)  (1280 + 64 * (j))
#define XB_XGEN(j)  (2304 + 64 * (j))
#define XB_TOP      3328
#define XB_TOPGEN   3392
#define XCD_BAR_WORDS 3456
#define XB_SPIN_CAP (1u << 18)

__device__ __forceinline__ unsigned xb_ld(unsigned* p)              { return __hip_atomic_load(p, __ATOMIC_RELAXED, __HIP_MEMORY_SCOPE_AGENT); }
__device__ __forceinline__ unsigned xb_add(unsigned* p, unsigned v) { return __hip_atomic_fetch_add(p, v, __ATOMIC_RELAXED, __HIP_MEMORY_SCOPE_AGENT); }
__device__ __forceinline__ unsigned xb_xcc_id() { return (unsigned)__builtin_amdgcn_s_getreg((3 << 11) | 20) & 0xFu; }
#define XB_SPIN(cond, bar) do { unsigned _sp = 0; while (cond) { __builtin_amdgcn_s_sleep(1); \
    if ((++_sp & 255u) == 0u) { if (xb_ld(&(bar)[XB_TMO])) break; if (_sp > XB_SPIN_CAP) { atomicAdd(&(bar)[XB_TMO], 1u); break; } } } } while (0)

struct XcdBarrier {
    unsigned* bar; unsigned x;
    volatile LAS unsigned* st;
};

__device__ __forceinline__ XcdBarrier xcd_barrier_post(unsigned* bar, volatile LAS unsigned* st) {
    XcdBarrier b; b.bar = bar; b.x = xb_xcc_id(); b.st = st;
    if (threadIdx.x == 0) (void)xb_add(&bar[XB_XCNT(b.x)], 1u);
    return b;
}
__device__ __forceinline__ void xcd_barrier_complete(unsigned* bar, unsigned x, unsigned& nloc, unsigned& nx) {
    const unsigned G = gridDim.x * gridDim.y * gridDim.z;
    unsigned sum, cnt, mine, sp = 0u;
    for (;;) {
        sum = 0u; cnt = 0u; mine = 0u;
#pragma unroll
        for (unsigned j = 0; j < 16; ++j) { const unsigned c = xb_ld(&bar[XB_XCNT(j)]); sum += c; cnt += (c > 0u) ? 1u : 0u; mine = (j == x) ? c : mine; }
        if (sum == G) break;
        __builtin_amdgcn_s_sleep(1);
        if ((++sp & 255u) == 0u) { if (xb_ld(&bar[XB_TMO])) break; if (sp > XB_SPIN_CAP) { atomicAdd(&bar[XB_TMO], 1u); break; } }
    }
    nloc = mine > 0u ? mine : 1u; nx = cnt > 0u ? cnt : 1u;
}

__device__ __forceinline__ void xcd_barrier(const XcdBarrier& b) {
    asm volatile("s_waitcnt vmcnt(0)" ::: "memory");
    __syncthreads();
    if (threadIdx.x == 0) {
        unsigned* bar = b.bar;
        __builtin_amdgcn_s_waitcnt(0);
        unsigned nloc = b.st[0], nx = b.st[1];
        if (nloc == 0u) { xcd_barrier_complete(bar, b.x, nloc, nx); b.st[0] = nloc; b.st[1] = nx; }
        const unsigned old = xb_add(&bar[XB_XSUB(b.x)], 1u);
        const unsigned gen = old / nloc;
        if (old + 1u == (gen + 1u) * nloc) {
            __builtin_amdgcn_fence(__ATOMIC_RELEASE, "agent");
            asm volatile("s_waitcnt vmcnt(0)" ::: "memory");
            const unsigned og = xb_add(&bar[XB_TOP], 1u);
            const unsigned tg = og / nx;
            if (og + 1u == (tg + 1u) * nx) xb_add(&bar[XB_TOPGEN], 1u);
            else XB_SPIN(xb_ld(&bar[XB_TOPGEN]) == tg, bar);
            __builtin_amdgcn_fence(__ATOMIC_ACQUIRE, "agent");
            xb_add(&bar[XB_XGEN(b.x)], 1u);
            asm volatile("s_waitcnt vmcnt(0)" ::: "memory");
        } else {
            XB_SPIN(xb_ld(&bar[XB_XGEN(b.x)]) == gen, bar);
            __builtin_amdgcn_fence(__ATOMIC_ACQUIRE, "agent");
            asm volatile("s_waitcnt vmcnt(0)" ::: "memory");
        }
    }
    __syncthreads();
}

DEV void run_phase(KP kp, int ph, int l, char* smem) {
  const bool need = (l == 0);
  switch (ph) {
    case 0: { const P p = ldp(kp); ph_ada(p, smem); } break;
    case 1: { const P p = ldp(kp); ph_prep(p, l, smem); } break;
    case 2: { const P p = ldp(kp); ph_in(p, l, smem); } break;
    case 3: { const P p = ldp(kp); ph_mid(p, l, need, smem); } break;
    case 4: { const P p = ldp(kp); ph_carry(p, l, need); } break;
    case 5: { const P p = ldp(kp); ph_attn(p, l, need, smem); } break;
    case 8: { const P p = ldp(kp); norm_rows(p, p.out, (const float*)(p.ws + OFF_XC), need ? MALL : MLAT, p.norm_mlp + l * 1024, (const float*)(p.ws + OFF_MOD) + (size_t)l * 9 * 6144, 3, 4); } break;
    case 11: { const P p = ldp(kp); ph_final(p); } break;
    default: break;
  }
}

__global__ void __launch_bounds__(512) mega(P p_unused) {
  __shared__ __attribute__((aligned(16))) char smem_all[163840];
  char* smem = smem_all;
  KP kp = (KP)__builtin_amdgcn_kernarg_segment_ptr();
  cg::grid_group grid = cg::this_grid();
  unsigned* xb_st = (unsigned*)(smem_all + 163824);
  if (threadIdx.x == 0) { xb_st[0] = 0u; xb_st[1] = 0u; }
  __syncthreads();
  unsigned* barw; { const P p0 = ldp(kp); barw = (unsigned*)(p0.ws + OFF_BAR); }
  const XcdBarrier XB = xcd_barrier_post(barw, (volatile LAS unsigned*)xb_st);
  run_phase(kp, 0, 0, smem);
  grid.sync();
  for (int l = 0; l < 2; ++l)
    for (int ph = 1; ph <= 10; ++ph) {
      for (int rep_ = 0; rep_ < 1 + DUPN(ph); ++rep_) {
        const int nj = n_jobs(ph);
        if (nj == 0 || ph == 2 || ph == 3) run_phase(kp, ph, l, smem);
        for (int j = 0; j < nj; ++j) { const pg8::Job jb = get_job(kp, ph, l, j); run_job(smem, jb); }
        xcd_barrier(XB);
      }
    }
  run_phase(kp, 11, 0, smem);
}

extern "C" void kernel_launch(void* const* d_in, const int* in_sizes, int n_in, void* d_out, int out_size, void* d_ws, size_t ws_size, hipStream_t stream) {
  static int grid_blocks = 0;
  if (!grid_blocks) {
    int dev = 0, cus = 0, per_cu = 0;
    hipGetDevice(&dev);
    hipDeviceGetAttribute(&cus, hipDeviceAttributeMultiprocessorCount, dev);
    hipOccupancyMaxActiveBlocksPerMultiprocessor(&per_cu, mega, 512, 0);
    if (per_cu > 1) per_cu = 1;
    grid_blocks = cus * per_cu;
  }
  if (ws_size < WS_TOTAL) fprintf(stderr, "workspace too small: %zu < %zu\n", ws_size, (size_t)WS_TOTAL);
  (void)hipMemsetAsync((char*)d_ws + OFF_BAR, 0, BAR_BYTES, stream);
  P p{};
  const float** f = (const float**)&p;
  for (int i = 0; i < 29; ++i) f[i] = (const float*)d_in[i];
  p.out = (float*)d_out; p.ws = (char*)d_ws;
  void* args[] = {&p};
  hipError_t e = hipLaunchCooperativeKernel((void*)mega, dim3(grid_blocks), dim3(512), args, 0, stream);
  if (e != hipSuccess) fprintf(stderr, "cooperative launch failed: %s (grid %d)\n", hipGetErrorString(e), grid_blocks);
}
```

```cpp
#include <hip/hip_runtime.h>
#include <hip/hip_cooperative_groups.h>
#include <stdint.h>
#include <cstdio>
namespace cg = cooperative_groups;

typedef unsigned short bf16_t;
typedef short bf16x8 __attribute__((ext_vector_type(8)));
typedef float f32x4 __attribute__((ext_vector_type(4)));
typedef unsigned u32x4 __attribute__((ext_vector_type(4)));
typedef unsigned u32x2 __attribute__((ext_vector_type(2)));
#define DEV __device__ __forceinline__

constexpr int MLAT = 32768, MCTX = 2048, MALL = 34816;
constexpr int LDZ = 2816, ZQ = 0, ZKV = 256, ZCB = 512, ZCC = 1024, ZCX = 1536, ZS5 = 2048, ZPE = 2560;
constexpr int ZCV = 0, ZAO = 512, ZS5A = 1024, ZMG = 1536;
constexpr int NKEY = 4352;
constexpr int NCH = 1088;
constexpr float EPSN = 1e-6f;

constexpr size_t OFF_MOD  = 0;
constexpr size_t OFF_ROPE = OFF_MOD + 2ull * 9 * 6144 * 4;
constexpr size_t OFF_KTAB = OFF_ROPE + 4096;
constexpr size_t OFF_XC   = OFF_KTAB + 32ull * 2 * 32 * 256 * 4;
constexpr size_t OFF_S    = OFF_XC + 2048ull * 1024 * 4;
constexpr size_t OFF_WIN  = OFF_S + (size_t)NCH * 8192 * 2;
constexpr size_t OFF_WUQ  = OFF_WIN + 5888ull * 1024 * 2;
constexpr size_t OFF_WUKV = OFF_WUQ + 768ull * 256 * 2;
constexpr size_t OFF_WO   = OFF_WUKV + 1024ull * 256 * 2;
constexpr size_t OFF_WC   = OFF_WO + 1024ull * 512 * 2;
constexpr size_t OFF_WGLU = OFF_WC + 1024ull * 512 * 2;
constexpr size_t OFF_WOUT = OFF_WGLU + 2048ull * 512 * 2;
constexpr size_t OFF_W1   = OFF_WOUT + 1024ull * 1024 * 2;
constexpr size_t OFF_W2   = OFF_W1 + 4096ull * 1024 * 2;
constexpr size_t OFF_MT   = OFF_W2 + 1024ull * 4096 * 2;
constexpr size_t OFF_ET   = OFF_MT + 32ull * 512 * 512 * 2;
constexpr size_t OFF_FT   = OFF_ET + 32ull * 512 * 256 * 2;
constexpr size_t OFF_XN   = OFF_FT + 32ull * 256 * 512 * 2;
constexpr size_t OFF_Z    = OFF_XN + (size_t)MALL * 1024 * 2;
constexpr size_t OFF_Q    = OFF_Z + (size_t)MALL * LDZ * 2;
constexpr size_t OFF_K    = OFF_Q + 64ull * NKEY * 96 * 2;
constexpr size_t OFF_VT   = OFF_K + 64ull * NKEY * 96 * 2;
constexpr size_t WS_NEED  = OFF_VT + 64ull * 64 * NKEY * 2;
constexpr size_t OFF_T    = OFF_Q;
constexpr size_t OFF_MG   = OFF_T + (size_t)MALL * 1024 * 2;
static_assert(OFF_MG + (size_t)MALL * 1024 * 2 <= WS_NEED, "merge temporaries overflow");
constexpr size_t OFF_BAR  = WS_NEED;
constexpr size_t BAR_BYTES = 3456 * 4;
constexpr size_t OFF_SSQ  = OFF_BAR + 16384;
constexpr size_t WS_TOTAL = OFF_SSQ + (size_t)MALL * 2 * 4 * 4;
static_assert((size_t)MALL * 4096 * 2 <= OFF_VT - OFF_Z, "H alias too big");

#ifdef DUP_PH
#define DUPN(ph) ((ph) == DUP_PH ? 1 : 0)
#else
#define DUPN(ph) 0
#endif
struct P {
  const float *x, *c, *ctx, *c_ctx, *ada_w, *ada_b, *norm_mix, *w_in, *q_norm, *w_uq, *kv_norm, *w_ukv, *w_o, *conv_w, *conv_w_out,
      *a_re, *a_im, *log_dt, *b_re, *b_im, *c_re, *c_im, *s5_d, *w_glu, *w_out, *norm_mlp, *w1, *w2, *norm_final;
  float* out; char* ws;
};

DEV int get_tid() { int t; asm volatile("v_mov_b32 %0, %1" : "=v"(t) : "v"((int)(threadIdx.x & 255))); return t; }
DEV int vbsel() { return __builtin_amdgcn_readfirstlane((int)(threadIdx.x >> 8)); }
DEV int vbid() { return (int)blockIdx.x * 2 + vbsel(); }
DEV int vgrid() { return (int)gridDim.x * 2; }
DEV int vboff() { return vbsel() * 81920; }
DEV int rounds_of(int total) { const int vg = vgrid(); int r = 0; for (int t = 0; t < total; t += vg) ++r; return r; }
typedef const __attribute__((address_space(4))) P* KP;
#if defined(__HIP_DEVICE_COMPILE__)
DEV P ldp(KP k) { asm volatile("" : "+s"(k)); return *k; }
#else
DEV P ldp(KP k) { return P{}; }
#endif
DEV unsigned pk_bf16(float lo, float hi) { unsigned r; asm("v_cvt_pk_bf16_f32 %0, %1, %2" : "=v"(r) : "v"(lo), "v"(hi)); return r; }
DEV float bflo(unsigned w) { return __uint_as_float(w << 16); }
DEV float bfhi(unsigned w) { return __uint_as_float(w & 0xffff0000u); }
DEV float sigm(float x) { return __builtin_amdgcn_rcpf(1.0f + __builtin_amdgcn_exp2f(x * -1.4426950408889634f)); }
DEV float wave_sum(float v) {
#pragma unroll
  for (int o = 32; o > 0; o >>= 1) v += __shfl_xor(v, o);
  return v;
}
DEV void sincos_d(double th, float& s, float& c) {
  double n = rint(th * 0.15915494309189535);
  double r = fma(-n, 6.283185307179586, th);
  float rev = (float)(r * 0.15915494309189535);
  s = __builtin_amdgcn_sinf(rev); c = __builtin_amdgcn_cosf(rev);
}

struct ASrc { const bf16_t* p; long lda; int row0, rmax, segshift; long segstride; };

template <int WN, bool SWAP>
DEV void gemm_core(f32x4 (&acc)[4][WN], const ASrc& a, const bf16_t* __restrict__ Bt, long ldb, int K, char* smem) {
  constexpr int BN = 32 * WN, NBL = BN / 32;
  constexpr int ABYTES = 16384, STAGE = ABYTES + BN * 128;
  const int tid = get_tid(), lane = tid & 63, wid = tid >> 6, wm = wid >> 1, wn = wid & 1;
  const int l15 = lane & 15, lq = lane >> 4;
  const int lrow = tid >> 3, lc = tid & 7;
  const int segmask = (1 << a.segshift) - 1;
  const bf16_t* ap[4];
#pragma unroll
  for (int i = 0; i < 4; ++i) { int r = a.row0 + lrow + 32 * i; r = r < a.rmax ? r : a.rmax - 1; ap[i] = a.p + (long)r * a.lda; }
  const bf16_t* bp = Bt + (long)lrow * ldb + lc * 8;
  const int vo = vboff();
  const int wofs = vo + lrow * 128 + ((lc ^ ((lrow >> 1) & 7)) << 4);
  u32x4 ra0[4], rb0[NBL], ra1[4], rb1[NBL];
  const int aoff = vo + (wm * 64 + l15) * 128, boff = vo + ABYTES + (wn * 16 * WN + l15) * 128, sx = l15 >> 1;
  int nk = K >> 6; asm volatile("" : "+s"(nk));
#define GLOAD(RA, RB, kt) { const int k_ = (kt) * 64 + lc * 8; const long ko_ = (long)(k_ >> a.segshift) * a.segstride + (k_ & segmask); \
    _Pragma("unroll") for (int i = 0; i < 4; ++i) RA[i] = *(const u32x4*)(ap[i] + ko_); \
    _Pragma("unroll") for (int i = 0; i < NBL; ++i) RB[i] = *(const u32x4*)(bp + (long)(32 * i) * ldb + (kt) * 64); }
#define LSTORE(RA, RB, buf) { char* s_ = smem + (buf) * STAGE; \
    _Pragma("unroll") for (int i = 0; i < 4; ++i) *(u32x4*)(s_ + wofs + i * 4096) = RA[i]; \
    _Pragma("unroll") for (int i = 0; i < NBL; ++i) *(u32x4*)(s_ + ABYTES + wofs + i * 4096) = RB[i]; }
#define BAR() { asm volatile("s_waitcnt lgkmcnt(0)" ::: "memory"); __builtin_amdgcn_s_barrier(); asm volatile("" ::: "memory"); }
#define COMPUTE(buf) { const char* s = smem + (buf) * STAGE; \
    _Pragma("unroll") for (int ks = 0; ks < 2; ++ks) { \
      const int co = ((ks * 4 + lq) ^ sx) << 4; \
      bf16x8 af[4], bfr[WN]; \
      _Pragma("unroll") for (int i = 0; i < 4; ++i) af[i] = *(const bf16x8*)(s + aoff + i * 2048 + co); \
      _Pragma("unroll") for (int j = 0; j < WN; ++j) bfr[j] = *(const bf16x8*)(s + boff + j * 2048 + co); \
      _Pragma("unroll") for (int i = 0; i < 4; ++i) \
        _Pragma("unroll") for (int j = 0; j < WN; ++j) \
          acc[i][j] = SWAP ? __builtin_amdgcn_mfma_f32_16x16x32_bf16(bfr[j], af[i], acc[i][j], 0, 0, 0) \
                           : __builtin_amdgcn_mfma_f32_16x16x32_bf16(af[i], bfr[j], acc[i][j], 0, 0, 0); \
    } }
  __builtin_amdgcn_sched_barrier(0);
  GLOAD(ra0, rb0, 0); GLOAD(ra1, rb1, 1); LSTORE(ra0, rb0, 0); BAR();
#pragma nounroll
  for (int kt = 0; kt < nk; kt += 2) {
    if (kt + 2 < nk) GLOAD(ra0, rb0, kt + 2);
    COMPUTE(0);
    LSTORE(ra1, rb1, 1);
    BAR();
    if (kt + 3 < nk) GLOAD(ra1, rb1, kt + 3);
    COMPUTE(1);
    if (kt + 2 < nk) LSTORE(ra0, rb0, 0);
    BAR();
  }
#undef GLOAD
#undef LSTORE
#undef COMPUTE
#undef BAR
  __builtin_amdgcn_sched_barrier(0);
}
template <int WN> DEV void zero_acc(f32x4 (&acc)[4][WN]) {
#pragma unroll
  for (int i = 0; i < 4; ++i)
#pragma unroll
    for (int j = 0; j < WN; ++j) acc[i][j] = (f32x4){0.f, 0.f, 0.f, 0.f};
}
DEV ASrc asrc(const bf16_t* p, long lda, int row0, int rmax) { ASrc a; a.p = p; a.lda = lda; a.row0 = row0; a.rmax = rmax; a.segshift = 30; a.segstride = 0; return a; }

DEV bool tile_get(int r, int nM, int nN, int& mt, int& nt) {
  const int nslots = vgrid() >> 3; int q = (r * 8 + ((int)blockIdx.x & 7)) * nslots + ((int)blockIdx.x >> 3) * 2 + vbsel();
  const bool valid = q < nM * nN; q = valid ? q : nM * nN - 1;
  const int band = q / (8 * nN), rem = q - band * 8 * nN;
  nt = rem >> 3; mt = band * 8 + (rem & 7);
  return valid;
}
DEV int tile_rounds(int total) { return rounds_of(total); }


namespace pg8 {
#define PG8_LAS __attribute__((address_space(3)))
constexpr int BM = 256, BK = 64, HALF = 128, HTB = HALF * BK * 2, STAGE_BYTES = 8 * HTB, NXCD = 8, WGM = 8;
DEV int lds_byte(int r, int c) { const int st = (r >> 4) * 2 + (c >> 5), rr = r & 15, cc = c & 31, ob = rr * 64 + cc * 2; return st * 1024 + (ob ^ (((ob >> 9) & 1) << 5)); }
DEV void stage_rc(int b, int& R, int& C) { const int st = b / 1024, sb = b % 1024, swz = sb ^ (((sb >> 9) & 1) << 5); R = (st >> 1) * 16 + swz / 64; C = (st & 1) * 32 + (swz % 64) / 2; }
DEV int perm32(int rho) { const int n = rho >> 4, i = rho & 15; return 8 * (i >> 2) + 4 * n + (i & 3); }
struct Unit { int pm, pn; };
struct Gemm { const bf16_t* A; const bf16_t* Bt; long lda; int M, N, K; long segstride; long pnstrideA; };
struct StaticOrder {
  int nM, nN, nwg, G, c;
  DEV void init(int M, int N, int G_, int c_) { nM = M / BM; nN = N / BM; nwg = nM * nN; G = G_; c = c_; }
  DEV bool next(int i, Unit& u) const {
    const long L = (long)i * G + c; if (L >= nwg) return false;
    int wgid = (int)L; { const int q = nwg / NXCD, r = nwg % NXCD, xcd = wgid % NXCD, off = wgid / NXCD; wgid = (xcd < r ? xcd * (q + 1) : r * (q + 1) + (xcd - r) * q) + off; }
    const int nig = WGM * nN, gid = wgid / nig, fm = gid * WGM, gsz = (nM - fm) < WGM ? (nM - fm) : WGM;
    u.pm = fm + ((wgid % nig) % gsz); u.pn = (wgid % nig) / gsz; return true;
  }
};
template <class Epi>
DEV void gemm_phase(PG8_LAS unsigned char* lds, const Gemm g, const StaticOrder& S, const Epi& E) {
  int tid; asm volatile("v_mov_b32 %0, %1" : "=v"(tid) : "v"((int)threadIdx.x));
  const int wid = __builtin_amdgcn_readfirstlane(tid >> 6), lane = tid & 63, wr = wid >> 2, wc = wid & 3, fr = lane & 15, fq = lane >> 4;
  const int K = g.K, nt = K / BK;
  unsigned voffA[2], voffB[2];
#pragma unroll
  for (int i = 0; i < 2; ++i) { int R, C; stage_rc(tid * 16 + i * 8192, R, C); const int Rb = Epi::PERM ? ((R & ~31) + perm32(R & 31)) : R;
    voffA[i] = (unsigned)((long)R * g.lda + (g.segstride ? (long)(C >> 4) * g.segstride + (C & 15) : (long)C)) * 2u; voffB[i] = (unsigned)(Rb * K + C) * 2u; }
  const size_t kstep = (size_t)(BK * 2);
  const size_t kstepA = g.segstride ? (size_t)(BK / 16) * g.segstride * 2 : kstep;
  const size_t pnA = (size_t)g.pnstrideA * 2;
  const size_t hstepA = (size_t)HALF * g.lda * 2, hstepB = (size_t)HALF * K * 2;
  const size_t tstepA = 2 * hstepA, tstepB = 2 * hstepB;
  const unsigned ldsw = (unsigned)wid * 1024u;
  const int aoff = lds_byte(wr * 64 + fr, fq * 8), boff = lds_byte(wc * 32 + fr, fq * 8);
#define PG8_SA(b, h) (((b) * 2 + (h)) * HTB)
#define PG8_SB(b, h) ((4 + (b) * 2 + (h)) * HTB)
#define PG8_STAGE(bufoff, gbase, voff) do { _Pragma("unroll") for (int _i = 0; _i < 2; ++_i) \
    __builtin_amdgcn_global_load_lds((const unsigned*)((const char*)(gbase) + (voff)[_i]), (PG8_LAS unsigned*)(lds + (bufoff) + ldsw + _i * 8192), 16, 0, 0); } while (0)
#define PG8_LDA(dst, b, h) do { _Pragma("unroll") for (int m = 0; m < 4; ++m) _Pragma("unroll") for (int k = 0; k < 2; ++k) dst[m][k] = *(const PG8_LAS bf16x8*)(lds + PG8_SA(b, h) + aoff + m * 2048 + k * 1024); } while (0)
#define PG8_LDB(dst, b, h) do { _Pragma("unroll") for (int n = 0; n < 2; ++n) _Pragma("unroll") for (int k = 0; k < 2; ++k) dst[n][k] = *(const PG8_LAS bf16x8*)(lds + PG8_SB(b, h) + boff + n * 2048 + k * 1024); } while (0)
#define PG8_MMA(ai, bj, At, Bt) do { __builtin_amdgcn_s_setprio(1); _Pragma("unroll") for (int m = 0; m < 4; ++m) _Pragma("unroll") for (int n = 0; n < 2; ++n) _Pragma("unroll") for (int k = 0; k < 2; ++k) \
    acc[ai][bj][m][n] = __builtin_amdgcn_mfma_f32_16x16x32_bf16(Bt[n][k], At[m][k], acc[ai][bj][m][n], 0, 0, 0); __builtin_amdgcn_s_setprio(0); } while (0)
#define PG8_WAIT_V(n) asm volatile("s_waitcnt vmcnt(" #n ")" ::: "memory")
#define PG8_WAIT_L(n) asm volatile("s_waitcnt lgkmcnt(" #n ")" ::: "memory")
#define PG8_BAR __builtin_amdgcn_s_barrier()
#define PG8_SCHED __builtin_amdgcn_sched_barrier(0)
  Unit cur, nxt; int ui = 0;
  if (!S.next(0, cur)) return;
  f32x4 acc[2][2][4][2];
#pragma unroll
  for (int a = 0; a < 2; ++a)
#pragma unroll
    for (int b = 0; b < 2; ++b)
#pragma unroll
      for (int m = 0; m < 4; ++m)
#pragma unroll
        for (int n = 0; n < 2; ++n) acc[a][b][m][n] = (f32x4){0.f, 0.f, 0.f, 0.f};
  bf16x8 At[4][2], B0[2][2], B1[2][2];
  const char* cA = (const char*)g.A + (size_t)cur.pm * tstepA + (size_t)cur.pn * pnA; const char* cB = (const char*)g.Bt + (size_t)cur.pn * tstepB;
  PG8_STAGE(PG8_SB(0, 0), cB, voffB); PG8_STAGE(PG8_SB(0, 1), cB + hstepB, voffB); PG8_STAGE(PG8_SA(0, 0), cA, voffA); PG8_STAGE(PG8_SA(0, 1), cA + hstepA, voffA);
  if (wr == 1) PG8_BAR;
  PG8_WAIT_V(2); PG8_BAR;
  PG8_STAGE(PG8_SB(1, 0), cB + kstep, voffB); PG8_STAGE(PG8_SA(1, 0), cA + kstepA, voffA); PG8_STAGE(PG8_SB(1, 1), cB + hstepB + kstep, voffB);
  PG8_WAIT_V(6); PG8_BAR;
  for (;;) {
    const bool has_next = S.next(ui + 1, nxt);
    const char* nA = has_next ? (const char*)g.A + (size_t)nxt.pm * tstepA + (size_t)nxt.pn * pnA : cA; const char* nB = has_next ? (const char*)g.Bt + (size_t)nxt.pn * tstepB : cB;
    for (int t = 0; t < nt; t += 2) {
      const bool last = (t == nt - 2);
      const char* a1 = cA + (size_t)(t + 1) * kstepA;
      const char* a2 = last ? nA : cA + (size_t)(t + 2) * kstepA; const char* b2 = last ? nB : cB + (size_t)(t + 2) * kstep;
      const char* a3 = a2 + kstepA; const char* b3 = b2 + kstep;
      PG8_LDB(B0, 0, 0); PG8_LDB(B1, 0, 1); PG8_SCHED; PG8_LDA(At, 0, 0); PG8_STAGE(PG8_SA(1, 1), a1 + hstepA, voffA);
      PG8_WAIT_V(8); PG8_WAIT_L(0); PG8_BAR; PG8_MMA(0, 0, At, B0); PG8_MMA(0, 1, At, B1); PG8_BAR; PG8_SCHED;
      PG8_LDA(At, 0, 1); PG8_STAGE(PG8_SB(0, 0), b2, voffB); PG8_STAGE(PG8_SB(0, 1), b2 + hstepB, voffB); PG8_STAGE(PG8_SA(0, 0), a2, voffA);
      PG8_WAIT_V(8); PG8_WAIT_L(0); PG8_BAR; PG8_MMA(1, 0, At, B0); PG8_MMA(1, 1, At, B1); PG8_BAR; PG8_SCHED;
      PG8_LDB(B0, 1, 0); PG8_LDB(B1, 1, 1); PG8_SCHED; PG8_LDA(At, 1, 0); PG8_STAGE(PG8_SA(0, 1), a2 + hstepA, voffA);
      PG8_WAIT_V(8); PG8_WAIT_L(0); PG8_BAR; PG8_MMA(0, 0, At, B0); PG8_MMA(0, 1, At, B1); PG8_BAR; PG8_SCHED;
      PG8_LDA(At, 1, 1); PG8_STAGE(PG8_SB(1, 0), b3, voffB); PG8_STAGE(PG8_SB(1, 1), b3 + hstepB, voffB); PG8_STAGE(PG8_SA(1, 0), a3, voffA);
      PG8_WAIT_V(8); PG8_WAIT_L(0); PG8_BAR; PG8_MMA(1, 0, At, B0); PG8_MMA(1, 1, At, B1); PG8_BAR; PG8_SCHED;
    }
    if (wr == 0) PG8_BAR;
    E(acc, cur, wr, wc, fr, fq);
    if (!has_next) break;
#pragma unroll
    for (int a = 0; a < 2; ++a)
#pragma unroll
      for (int b = 0; b < 2; ++b)
#pragma unroll
        for (int m = 0; m < 4; ++m)
#pragma unroll
          for (int n = 0; n < 2; ++n) acc[a][b][m][n] = (f32x4){0.f, 0.f, 0.f, 0.f};
    cur = nxt; cA = nA; cB = nB; ++ui;
    if (wr == 1) PG8_BAR;
  }
  PG8_WAIT_V(0);
  PG8_BAR;
#undef PG8_SA
#undef PG8_SB
#undef PG8_STAGE
#undef PG8_LDA
#undef PG8_LDB
#undef PG8_MMA
#undef PG8_WAIT_V
#undef PG8_WAIT_L
#undef PG8_BAR
#undef PG8_SCHED
}
struct Job { const bf16_t* A; const bf16_t* Bt; long lda; int M, N, K, mode; bf16_t* O; long ldc; const bf16_t* T; const float* slat; const float* sctx; bf16_t* xb; const float* modg;
             long segstride, pnstrideA; int rows; float* ssq; bf16_t* O2; };
struct EpiRT {
  static constexpr bool PERM = true;
  int mode; bf16_t* O; long ldc; const bf16_t* T; const float* slat; const float* sctx; bf16_t* xb; const float* modg; int rows; float* ssq; bf16_t* O2;
  DEV void operator()(const f32x4 (&acc)[2][2][4][2], const Unit& u, int wr, int wc, int fr, int fq) const {
    const int row00 = u.pm * BM + wr * 64 + fr, col00 = u.pn * BM + wc * 32 + 8 * fq;
    if (mode == 5) {
      const bool lat = u.pm * BM < MLAT; const int bi = lat ? (u.pm * BM) >> 12 : 8;
      f32x4 g[2][2];
#pragma unroll
      for (int bj = 0; bj < 2; ++bj) { const float* mg = modg + (size_t)bi * 6144 + col00 + bj * HALF; g[bj][0] = *(const f32x4*)mg; g[bj][1] = *(const f32x4*)(mg + 4); }
      if (slat != nullptr) {
        const float* sb = lat ? slat : sctx - (size_t)MLAT * 1024;
#pragma unroll
        for (int ai = 0; ai < 2; ++ai)
#pragma unroll
          for (int mp = 0; mp < 2; ++mp) {
            f32x4 x[4][2];
#pragma unroll
            for (int c = 0; c < 4; ++c) { const float* s = sb + (size_t)(row00 + ai * HALF + (2 * mp + (c >> 1)) * 16) * 1024 + col00 + (c & 1) * HALF; x[c][0] = *(const f32x4*)s; x[c][1] = *(const f32x4*)(s + 4); }
#pragma unroll
            for (int c = 0; c < 4; ++c) {
              const f32x4 y0 = x[c][0] + g[c & 1][0] * acc[ai][c & 1][2 * mp + (c >> 1)][0], y1 = x[c][1] + g[c & 1][1] * acc[ai][c & 1][2 * mp + (c >> 1)][1];
              *(u32x4*)(xb + (size_t)(row00 + ai * HALF + (2 * mp + (c >> 1)) * 16) * 1024 + col00 + (c & 1) * HALF) = (u32x4){pk_bf16(y0[0], y0[1]), pk_bf16(y0[2], y0[3]), pk_bf16(y1[0], y1[1]), pk_bf16(y1[2], y1[3])};
            }
          }
      } else {
#pragma unroll
        for (int ai = 0; ai < 2; ++ai)
#pragma unroll
          for (int mp = 0; mp < 2; ++mp) {
            u32x4 x[4];
#pragma unroll
            for (int c = 0; c < 4; ++c) x[c] = *(const u32x4*)(xb + (size_t)(row00 + ai * HALF + (2 * mp + (c >> 1)) * 16) * 1024 + col00 + (c & 1) * HALF);
#pragma unroll
            for (int c = 0; c < 4; ++c) {
              const f32x4 a0 = acc[ai][c & 1][2 * mp + (c >> 1)][0], a1 = acc[ai][c & 1][2 * mp + (c >> 1)][1], g0 = g[c & 1][0], g1 = g[c & 1][1];
              const u32x4 w = x[c];
              *(u32x4*)(xb + (size_t)(row00 + ai * HALF + (2 * mp + (c >> 1)) * 16) * 1024 + col00 + (c & 1) * HALF) =
                  (u32x4){pk_bf16(bflo(w.x) + g0[0] * a0[0], bfhi(w.x) + g0[1] * a0[1]), pk_bf16(bflo(w.y) + g0[2] * a0[2], bfhi(w.y) + g0[3] * a0[3]),
                          pk_bf16(bflo(w.z) + g1[0] * a1[0], bfhi(w.z) + g1[1] * a1[1]), pk_bf16(bflo(w.w) + g1[2] * a1[2], bfhi(w.w) + g1[3] * a1[3])};
            }
          }
      }
      return;
    }
    if (mode >= 1 && mode <= 3) {
#pragma unroll
      for (int b0 = 0; b0 < 16; b0 += 6) {
          u32x4 tv[6], ov[6];
#pragma unroll
          for (int c = 0; c < 6; ++c) if (b0 + c < 16) {
            const int cc = b0 + c, ai = cc >> 3, m = (cc >> 1) & 3, bj = cc & 1;
            const size_t row = (size_t)(row00 + ai * HALF + m * 16); const int col = col00 + bj * HALF;
            if (mode >= 2) tv[c] = *(const u32x4*)(T + row * 1024 + col);
            if (mode != 2) ov[c] = *(const u32x4*)(O + row * ldc + col);
          }
#pragma unroll
          for (int c = 0; c < 6; ++c) if (b0 + c < 16) {
            const int cc = b0 + c, ai = cc >> 3, m = (cc >> 1) & 3, bj = cc & 1;
            const size_t row = (size_t)(row00 + ai * HALF + m * 16); const int col = col00 + bj * HALF;
            f32x4 v0 = acc[ai][bj][m][0], v1 = acc[ai][bj][m][1];
#pragma unroll
            for (int r = 0; r < 4; ++r) { v0[r] = sigm(v0[r]); v1[r] = sigm(v1[r]); }
            if (mode >= 2) { const u32x4 t = tv[c];
              v0[0] *= bflo(t.x); v0[1] *= bfhi(t.x); v0[2] *= bflo(t.y); v0[3] *= bfhi(t.y); v1[0] *= bflo(t.z); v1[1] *= bfhi(t.z); v1[2] *= bflo(t.w); v1[3] *= bfhi(t.w); }
            if (mode == 1) { const u32x4 o = ov[c];
              v0[0] *= bflo(o.x); v0[1] *= bfhi(o.x); v0[2] *= bflo(o.y); v0[3] *= bfhi(o.y); v1[0] *= bflo(o.z); v1[1] *= bfhi(o.z); v1[2] *= bflo(o.w); v1[3] *= bfhi(o.w); }
            if (mode == 3) { const u32x4 o = ov[c];
              v0[0] += bflo(o.x); v0[1] += bfhi(o.x); v0[2] += bflo(o.y); v0[3] += bfhi(o.y); v1[0] += bflo(o.z); v1[1] += bfhi(o.z); v1[2] += bflo(o.w); v1[3] += bfhi(o.w); }
            *(u32x4*)(O + row * ldc + col) = (u32x4){pk_bf16(v0[0], v0[1]), pk_bf16(v0[2], v0[3]), pk_bf16(v1[0], v1[1]), pk_bf16(v1[2], v1[3])};
          }
        }
      return;
    }
    float rsv[2][4];
    if (mode >= 6) {
#pragma unroll
      for (int ai = 0; ai < 2; ++ai)
#pragma unroll
        for (int m = 0; m < 4; ++m) { const int row = row00 + ai * HALF + m * 16; f32x4 q4 = (f32x4){0.25f, 0.25f, 0.25f, 0.25f}; if (row < rows) q4 = *(const f32x4*)(ssq + ((size_t)row * 2 + (mode - 6)) * 4); rsv[ai][m] = (q4[0] + q4[1]) + (q4[2] + q4[3]); }
#pragma unroll
      for (int ai = 0; ai < 2; ++ai)
#pragma unroll
        for (int m = 0; m < 4; ++m) rsv[ai][m] = rsqrtf(rsv[ai][m] * (1.0f / 256.0f) + EPSN);
    }
#pragma unroll
    for (int ai = 0; ai < 2; ++ai)
#pragma unroll
      for (int m = 0; m < 4; ++m) {
        const int row = row00 + ai * HALF + m * 16;
#pragma unroll
        for (int bj = 0; bj < 2; ++bj) {
          const int col = col00 + bj * HALF;
          f32x4 v0 = acc[ai][bj][m][0], v1 = acc[ai][bj][m][1];
          if (mode >= 6) {
            if (row < rows) {
              int bb, tok; const bool lat = row < MLAT;
              if (lat) { bb = row >> 12; tok = row & 4095; } else { const int cr = row - MLAT; bb = cr >> 8; tok = cr & 255; }
              if (mode == 6) {
                const float rs = rsv[ai][m] * (0.10206207261596577f * 1.4426950408889634f);
                const int h = col / 96, d = col - h * 96;
                v0 = v0 * rs; v1 = v1 * rs;
                if (d >= 64 && lat) {
                  const int pp = d - 64, a = pp >> 4, f0 = (pp & 15) >> 1, pos = a ? (tok & 63) : (tok >> 6);
                  const float pr = (float)pos * 0.15915494309189535f;
                  const float i0 = f0 ? 0.01f : 1.0f, i1 = f0 ? 0.0031622776601683794f : 0.31622776601683794f, i2 = f0 ? 0.001f : 0.1f, i3 = f0 ? 0.00031622776601683794f : 0.031622776601683794f;
                  const float2 c0 = make_float2(__builtin_amdgcn_cosf(pr * i0), __builtin_amdgcn_sinf(pr * i0)), c1 = make_float2(__builtin_amdgcn_cosf(pr * i1), __builtin_amdgcn_sinf(pr * i1));
                  const float2 c2 = make_float2(__builtin_amdgcn_cosf(pr * i2), __builtin_amdgcn_sinf(pr * i2)), c3 = make_float2(__builtin_amdgcn_cosf(pr * i3), __builtin_amdgcn_sinf(pr * i3));
                  const float t0 = v0[0] * c0.x - v0[1] * c0.y, t1 = v0[1] * c0.x + v0[0] * c0.y, t2 = v0[2] * c1.x - v0[3] * c1.y, t3 = v0[3] * c1.x + v0[2] * c1.y;
                  const float t4 = v1[0] * c2.x - v1[1] * c2.y, t5 = v1[1] * c2.x + v1[0] * c2.y, t6 = v1[2] * c3.x - v1[3] * c3.y, t7 = v1[3] * c3.x + v1[2] * c3.y;
                  v0 = (f32x4){t0, t1, t2, t3}; v1 = (f32x4){t4, t5, t6, t7};
                }
                const int qrow = lat ? tok : 4096 + tok;
                *(u32x4*)(O + ((size_t)(bb * 8 + h) * NKEY + qrow) * 96 + d) = (u32x4){pk_bf16(v0[0], v0[1]), pk_bf16(v0[2], v0[3]), pk_bf16(v1[0], v1[1]), pk_bf16(v1[2], v1[3])};
              } else {
                const float rs = rsv[ai][m];
                const int h = col >> 7, dd = col & 127, key = lat ? 256 + tok : tok;
                v0 = v0 * rs; v1 = v1 * rs;
                const unsigned w0 = pk_bf16(v0[0], v0[1]), w1 = pk_bf16(v0[2], v0[3]), w2 = pk_bf16(v1[0], v1[1]), w3 = pk_bf16(v1[2], v1[3]);
                if (dd < 64) {
                  *(u32x4*)(O + ((size_t)(bb * 8 + h) * NKEY + key) * 96 + dd) = (u32x4){w0, w1, w2, w3};
                } else {
                  const int tt = key & 31, pos = ((tt >> 2) & 3) * 8 + (tt >> 4) * 4 + (tt & 3);
                  bf16_t* vp = O2 + ((size_t)(bb * 8 + h) * 64 + (dd - 64)) * NKEY + (key & ~31) + pos;
                  vp[0] = (bf16_t)(w0 & 0xffff); vp[NKEY] = (bf16_t)(w0 >> 16); vp[2 * NKEY] = (bf16_t)(w1 & 0xffff); vp[3 * NKEY] = (bf16_t)(w1 >> 16);
                  vp[4 * NKEY] = (bf16_t)(w2 & 0xffff); vp[5 * NKEY] = (bf16_t)(w2 >> 16); vp[6 * NKEY] = (bf16_t)(w3 & 0xffff); vp[7 * NKEY] = (bf16_t)(w3 >> 16);
                }
              }
            }
          } else {
            if (mode == 4) {
#pragma unroll
              for (int r = 0; r < 4; ++r) { const float a = fmaxf(v0[r], 0.f), b = fmaxf(v1[r], 0.f); v0[r] = a * a; v1[r] = b * b; }
            }
            if (row < rows) *(u32x4*)(O + (size_t)row * ldc + col) = (u32x4){pk_bf16(v0[0], v0[1]), pk_bf16(v0[2], v0[3]), pk_bf16(v1[0], v1[1]), pk_bf16(v1[2], v1[3])};
          }
        }
        if (mode == 0 && ssq != nullptr && u.pn < 2) {
          float s = 0.f;
#pragma unroll
          for (int bj = 0; bj < 2; ++bj)
#pragma unroll
            for (int n = 0; n < 2; ++n) { const f32x4 v = acc[ai][bj][m][n]; s += v[0] * v[0] + v[1] * v[1] + v[2] * v[2] + v[3] * v[3]; }
          s += __shfl_xor(s, 16); s += __shfl_xor(s, 32);
          if (fq == 0) ssq[((size_t)row * 2 + u.pn) * 4 + wc] = s;
        }
      }
  }
};
}
DEV void run_job(char* smem_base, const pg8::Job& j) {
  pg8::Gemm g; g.A = j.A; g.Bt = j.Bt; g.lda = j.lda; g.M = j.M; g.N = j.N; g.K = j.K; g.segstride = j.segstride; g.pnstrideA = j.pnstrideA;
  pg8::StaticOrder S; S.init(j.M, j.N, (int)gridDim.x, (int)blockIdx.x);
  pg8::EpiRT E; E.mode = j.mode; E.O = j.O; E.ldc = j.ldc; E.T = j.T; E.slat = j.slat; E.sctx = j.sctx; E.xb = j.xb; E.modg = j.modg; E.rows = j.rows; E.ssq = j.ssq; E.O2 = j.O2;
  pg8::gemm_phase<pg8::EpiRT>((PG8_LAS unsigned char*)smem_base, g, S, E);
}

DEV void ph_ada(const P& p, char* smem) {
  const int tid = get_tid();
  float* mod = (float*)(p.ws + OFF_MOD);
  if (vbid() < 192) {
    smem += vboff();
    float* sc = (float*)smem;
    for (int i = tid; i < 9 * 1024; i += 256) { const int bi = i >> 10, k = i & 1023; const float v = bi < 8 ? p.c[bi * 1024 + k] : p.c_ctx[k]; sc[i] = v * sigm(v); }
    __syncthreads();
    float* red = (float*)(smem + 36864);
    for (int item = vbid(); item < 192; item += vgrid()) {
      const int l = item / 96, n0 = (item % 96) * 64, nn = tid & 63, kq = tid >> 6;
      float acc[9];
#pragma unroll
      for (int b = 0; b < 9; ++b) acc[b] = 0.f;
      const float* w = p.ada_w + (size_t)l * 1024 * 6144 + n0 + nn;
      for (int k = kq * 256; k < kq * 256 + 256; ++k) {
        const float wv = w[(size_t)k * 6144];
#pragma unroll
        for (int b = 0; b < 9; ++b) acc[b] += sc[b * 1024 + k] * wv;
      }
#pragma unroll
      for (int b = 0; b < 9; ++b) red[(kq * 9 + b) * 64 + nn] = acc[b];
      __syncthreads();
      for (int e = tid; e < 9 * 64; e += 256) {
        const int b = e >> 6, n = e & 63;
        const float v = red[(0 * 9 + b) * 64 + n] + red[(1 * 9 + b) * 64 + n] + red[(2 * 9 + b) * 64 + n] + red[(3 * 9 + b) * 64 + n];
        mod[((size_t)l * 9 + b) * 6144 + n0 + n] = v + p.ada_b[l * 6144 + n0 + n];
      }
      __syncthreads();
    }
  } else if (vbid() == 192) {
    float2* rope = (float2*)(p.ws + OFF_ROPE);
    for (int e = tid; e < 512; e += 256) {
      const int pos = e >> 3, f = e & 7;
      const float inv = exp2f(-(float)f * 0.125f * 13.287712379549449f);
      float s, c; sincos_d((double)((float)pos * inv), s, c);
      rope[e] = make_float2(c, s);
    }
  }
}

DEV int map_col(int mode, int n) {
  if (mode == 0) return n;
  if (mode == 1) {
    if (n < 512) return n;
    if (n < 2560) return n + 32;
    if (n < 2592) return 512 + (n - 2560);
    if (n < 2816) return -1;
    return 2592 + (n - 2816);
  }
  if (mode == 2) {
    const int tile = n >> 7, nb = n & 127, wn = nb >> 6, j = (nb >> 4) & 3, cc = nb & 15;
    return (j < 2) ? tile * 64 + wn * 32 + j * 16 + cc : 1024 + tile * 64 + wn * 32 + (j - 2) * 16 + cc;
  }
  const int h = n / 96, d = n % 96;
  if (d < 64) return n;
  const int pp = d - 64, a = pp >> 4, f = (pp & 15) >> 1, half = pp & 1;
  return h * 96 + 64 + a * 16 + half * 8 + f;
}
DEV void cvt_tile(const float* __restrict__ src, int K, int Nsrc, bf16_t* __restrict__ dst, int mode, const float* __restrict__ gain, int nt, int kt, char* smem) {
  float* tile = (float*)smem + (vboff() >> 2);
  const int tid = get_tid();
  const int n0 = nt * 64, k0 = kt * 64;
  if (mode == 3) {
    const int r = tid >> 6, c = tid & 63;
    const int sn = map_col(mode, n0 + c);
#pragma unroll 4
    for (int i = 0; i < 16; ++i) {
      const int k = k0 + r + 4 * i;
      float v = sn >= 0 ? src[(size_t)k * Nsrc + sn] : 0.f;
      if (gain) v *= gain[k];
      tile[(r + 4 * i) * 65 + c] = v;
    }
  } else {
    const int r = tid >> 4, c4 = (tid & 15) * 4;
    const int sn = map_col(mode, n0 + c4);
#pragma unroll
    for (int i = 0; i < 4; ++i) {
      const int k = k0 + r + 16 * i;
      f32x4 v = sn >= 0 ? *(const f32x4*)(src + (size_t)k * Nsrc + sn) : (f32x4){0.f, 0.f, 0.f, 0.f};
      if (gain) v = v * gain[k];
      float* t = tile + (r + 16 * i) * 65 + c4;
      t[0] = v[0]; t[1] = v[1]; t[2] = v[2]; t[3] = v[3];
    }
  }
  __syncthreads();
  {
    const int n = tid >> 2, kp = (tid & 3) * 16;
    u32x4 w0, w1;
    w0.x = pk_bf16(tile[(kp + 0) * 65 + n], tile[(kp + 1) * 65 + n]);   w0.y = pk_bf16(tile[(kp + 2) * 65 + n], tile[(kp + 3) * 65 + n]);
    w0.z = pk_bf16(tile[(kp + 4) * 65 + n], tile[(kp + 5) * 65 + n]);   w0.w = pk_bf16(tile[(kp + 6) * 65 + n], tile[(kp + 7) * 65 + n]);
    w1.x = pk_bf16(tile[(kp + 8) * 65 + n], tile[(kp + 9) * 65 + n]);   w1.y = pk_bf16(tile[(kp + 10) * 65 + n], tile[(kp + 11) * 65 + n]);
    w1.z = pk_bf16(tile[(kp + 12) * 65 + n], tile[(kp + 13) * 65 + n]); w1.w = pk_bf16(tile[(kp + 14) * 65 + n], tile[(kp + 15) * 65 + n]);
    u32x4* d = (u32x4*)(dst + (size_t)(n0 + n) * K + k0 + kp);
    d[0] = w0; d[1] = w1;
  }
  __syncthreads();
}
DEV void cvt_item(const P& p, int l, int it, char* smem) {
  char* ws = p.ws;
  if (it < 1472) { cvt_tile(p.w_in + (size_t)l * 1024 * 5664, 1024, 5664, (bf16_t*)(ws + OFF_WIN), 1, nullptr, it / 16, it % 16, smem); return; }
  it -= 1472;
  if (it < 48) { cvt_tile(p.w_uq + (size_t)l * 256 * 768, 256, 768, (bf16_t*)(ws + OFF_WUQ), 3, p.q_norm + l * 256, it / 4, it % 4, smem); return; }
  it -= 48;
  if (it < 64) { cvt_tile(p.w_ukv + (size_t)l * 256 * 1024, 256, 1024, (bf16_t*)(ws + OFF_WUKV), 0, p.kv_norm + l * 256, it / 4, it % 4, smem); return; }
  it -= 64;
  if (it < 128) { cvt_tile(p.w_o + (size_t)l * 512 * 1024, 512, 1024, (bf16_t*)(ws + OFF_WO), 0, nullptr, it / 8, it % 8, smem); return; }
  it -= 128;
  if (it < 128) { cvt_tile(p.conv_w_out + (size_t)l * 512 * 1024, 512, 1024, (bf16_t*)(ws + OFF_WC), 0, nullptr, it / 8, it % 8, smem); return; }
  it -= 128;
  if (it < 256) { cvt_tile(p.w_glu + (size_t)l * 512 * 2048, 512, 2048, (bf16_t*)(ws + OFF_WGLU), 0, nullptr, it / 8, it % 8, smem); return; }
  it -= 256;
  if (it < 256) { cvt_tile(p.w_out + (size_t)l * 1024 * 1024, 1024, 1024, (bf16_t*)(ws + OFF_WOUT), 0, nullptr, it / 16, it % 16, smem); return; }
  it -= 256;
  if (it < 1024) { cvt_tile(p.w1 + (size_t)l * 1024 * 4096, 1024, 4096, (bf16_t*)(ws + OFF_W1), 0, nullptr, it / 16, it % 16, smem); return; }
  it -= 1024;
  cvt_tile(p.w2 + (size_t)l * 4096 * 1024, 4096, 1024, (bf16_t*)(ws + OFF_W2), 0, nullptr, it / 64, it % 64, smem);
}
constexpr int N_CVT = 4400;

struct Disc { double dt; float are, aim, fre, fim; };
DEV Disc s5_disc(const P& p, int l, int dir, int g, int pp) {
  Disc d; const int gi = (l * 2 + dir) * 32 + g;
  d.dt = (double)expf(p.log_dt[gi]); d.are = p.a_re[gi * 64 + pp]; d.aim = p.a_im[gi * 64 + pp];
  const float mag = __expf((float)(d.dt * (double)d.are)); float sn, cs; sincos_d(d.dt * (double)d.aim, sn, cs);
  const float abr = mag * cs, abi = mag * sn, den = d.are * d.are + d.aim * d.aim, nr = abr - 1.0f, ni = abi;
  d.fre = (nr * d.are + ni * d.aim) / den; d.fim = (ni * d.are - nr * d.aim) / den;
  return d;
}
DEV float2 cpow(const Disc& d, int e) {
  const float mag = __expf((float)((double)e * d.dt * (double)d.are)); float sn, cs; sincos_d((double)e * d.dt * (double)d.aim, sn, cs);
  return make_float2(mag * cs, mag * sn);
}
DEV float2 cmulf(float2 a, float2 b) { return make_float2(a.x * b.x - a.y * b.y, a.x * b.y + a.y * b.x); }

DEV void ktab_item(const P& p, int l, int it, char* smem) {
  const int tid = get_tid();
  const int lb = it & 7, dir = (it >> 3) & 1, g = it >> 4, gi = (l * 2 + dir) * 32 + g;
  smem += vboff();
  float2* CW = (float2*)smem;
  float2* BB = (float2*)(smem + 32768);
  float2* WL = (float2*)(smem + 40960);
  float2* FL = (float2*)(smem + 43008);
  {
    const int li = tid >> 6, pp = tid & 63;
    const Disc d = s5_disc(p, l, dir, g, pp);
    WL[tid] = cpow(d, lb * 4 + li);
    if (li == 0) FL[pp] = make_float2(d.fre, d.fim);
  }
  __syncthreads();
  for (int e = tid; e < 4096; e += 256) {
    const int li = e >> 10, co = (e >> 6) & 15, pp = e & 63;
    const float2 c = make_float2(p.c_re[((size_t)gi * 16 + co) * 64 + pp], p.c_im[((size_t)gi * 16 + co) * 64 + pp]);
    CW[e] = cmulf(c, WL[li * 64 + pp]);
  }
  for (int e = tid; e < 1024; e += 256) {
    const int pp = e >> 4;
    const float2 b = make_float2(p.b_re[(size_t)gi * 1024 + e], p.b_im[(size_t)gi * 1024 + e]);
    BB[e] = cmulf(FL[pp], b);
  }
  __syncthreads();
  float* ktab = (float*)(p.ws + OFF_KTAB);
  const int co = tid >> 4, ci = tid & 15;
#pragma unroll
  for (int li = 0; li < 4; ++li) {
    float acc = 0.f;
    for (int pp = 0; pp < 64; ++pp) { const float2 cw = CW[(li * 16 + co) * 64 + pp], bb = BB[pp * 16 + ci]; acc += cw.x * bb.x - cw.y * bb.y; }
    ktab[(((size_t)g * 2 + dir) * 32 + lb * 4 + li) * 256 + co * 16 + ci] = acc;
  }
  __syncthreads();
}
DEV void ef_item(const P& p, int l, int it) {
  const int g = it >> 4, id = (it & 15) * 256 + get_tid();
  const int t = id & 31, pp = (id >> 5) & 63, dir = id >> 11, gi = (l * 2 + dir) * 32 + g;
  const Disc d = s5_disc(p, l, dir, g, pp);
  const float2 we = cpow(d, dir == 0 ? t + 1 : 32 - t), wf = cpow(d, dir == 0 ? 31 - t : t);
  unsigned* Et = (unsigned*)(p.ws + OFF_ET) + (size_t)g * 512 * 128;
  bf16_t* Ft = (bf16_t*)(p.ws + OFF_FT) + (size_t)g * 256 * 512;
#pragma unroll
  for (int c = 0; c < 16; ++c) {
    const float2 cc = make_float2(p.c_re[((size_t)gi * 16 + c) * 64 + pp], p.c_im[((size_t)gi * 16 + c) * 64 + pp]);
    const float2 cw = cmulf(cc, we);
    Et[(size_t)(t * 16 + c) * 128 + dir * 64 + pp] = pk_bf16(cw.x, -cw.y);
  }
  const float2 f = make_float2(d.fre, d.fim);
  unsigned fr[8], fi[8];
#pragma unroll
  for (int c2 = 0; c2 < 8; ++c2) {
    const size_t bi = ((size_t)gi * 64 + pp) * 16 + c2 * 2;
    const float2 v0 = cmulf(wf, cmulf(f, make_float2(p.b_re[bi], p.b_im[bi])));
    const float2 v1 = cmulf(wf, cmulf(f, make_float2(p.b_re[bi + 1], p.b_im[bi + 1])));
    fr[c2] = pk_bf16(v0.x, v1.x); fi[c2] = pk_bf16(v0.y, v1.y);
  }
  u32x4* r0 = (u32x4*)(Ft + (size_t)(dir * 128 + pp * 2) * 512 + t * 16);
  u32x4* r1 = (u32x4*)(Ft + (size_t)(dir * 128 + pp * 2 + 1) * 512 + t * 16);
  r0[0] = (u32x4){fr[0], fr[1], fr[2], fr[3]}; r0[1] = (u32x4){fr[4], fr[5], fr[6], fr[7]};
  r1[0] = (u32x4){fi[0], fi[1], fi[2], fi[3]}; r1[1] = (u32x4){fi[4], fi[5], fi[6], fi[7]};
}
DEV void mt_item(const P& p, int l, int it) {
  const int g = it >> 7, id = (it & 127) * 256 + get_tid();
  const int k8 = id & 63, n = id >> 6, ti = k8 >> 1, ci0 = (k8 & 1) * 8, to = n >> 4, co = n & 15;
  const float* ktab = (const float*)(p.ws + OFF_KTAB);
  float v[8];
  if (to != ti) {
    const int dir = to > ti ? 0 : 1, lag = to > ti ? to - ti : ti - to;
    const f32x4* s = (const f32x4*)(ktab + (((size_t)g * 2 + dir) * 32 + lag) * 256 + co * 16 + ci0);
    const f32x4 a = s[0], b = s[1];
    v[0] = a[0]; v[1] = a[1]; v[2] = a[2]; v[3] = a[3]; v[4] = b[0]; v[5] = b[1]; v[6] = b[2]; v[7] = b[3];
  } else {
    const f32x4* s0 = (const f32x4*)(ktab + (((size_t)g * 2 + 0) * 32) * 256 + co * 16 + ci0);
    const f32x4* s1 = (const f32x4*)(ktab + (((size_t)g * 2 + 1) * 32) * 256 + co * 16 + ci0);
    const f32x4 a = s0[0] + s1[0], b = s0[1] + s1[1];
    v[0] = a[0]; v[1] = a[1]; v[2] = a[2]; v[3] = a[3]; v[4] = b[0]; v[5] = b[1]; v[6] = b[2]; v[7] = b[3];
    const float dd = p.s5_d[l * 512 + g * 16 + co];
#pragma unroll
    for (int e = 0; e < 8; ++e) if (ci0 + e == co) v[e] += dd;
  }
  u32x4 w; w.x = pk_bf16(v[0], v[1]); w.y = pk_bf16(v[2], v[3]); w.z = pk_bf16(v[4], v[5]); w.w = pk_bf16(v[6], v[7]);
  *(u32x4*)((bf16_t*)(p.ws + OFF_MT) + ((size_t)g * 512 + n) * 512 + k8 * 8) = w;
}

DEV void norm_rows(const P& p, const float* lat, const float* ctxp, const bf16_t* xb, int nrows, const float* gain, const float* modl, int ishift, int iscale) {
  const int lane = get_tid() & 63, wid = get_tid() >> 6;
  bf16_t* XN = (bf16_t*)p.out;
  for (int item = vbid(); item < nrows / 8; item += vgrid()) {
    const int row0 = item * 8 + wid * 2;
    f32x4 v[2][4]; float ss[2];
#pragma unroll
    for (int q = 0; q < 2; ++q) {
      const int row = row0 + q;
      if (xb != nullptr) {
#pragma unroll
        for (int i = 0; i < 4; ++i) { const u32x2 w = ((const u32x2*)(xb + (size_t)row * 1024))[lane + 64 * i]; v[q][i] = (f32x4){bflo(w.x), bfhi(w.x), bflo(w.y), bfhi(w.y)}; }
      } else {
        const float* src = row < MLAT ? lat + (size_t)row * 1024 : ctxp + (size_t)(row - MLAT) * 1024;
#pragma unroll
        for (int i = 0; i < 4; ++i) v[q][i] = ((const f32x4*)src)[lane + 64 * i];
      }
    }
#pragma unroll
    for (int q = 0; q < 2; ++q) {
      float s = 0.f;
#pragma unroll
      for (int i = 0; i < 4; ++i) s += v[q][i][0] * v[q][i][0] + v[q][i][1] * v[q][i][1] + v[q][i][2] * v[q][i][2] + v[q][i][3] * v[q][i][3];
      ss[q] = wave_sum(s);
    }
#pragma unroll
    for (int q = 0; q < 2; ++q) {
      const int row = row0 + q, bi = row < MLAT ? row >> 12 : 8;
      const float rstd = rsqrtf(ss[q] * (1.0f / 1024.0f) + EPSN);
      const float* msh = modl + ((size_t)bi * 6 + ishift) * 1024; const float* msc = modl + ((size_t)bi * 6 + iscale) * 1024;
#pragma unroll
      for (int i = 0; i < 4; ++i) {
        const int col = (lane + 64 * i) * 4;
        const f32x4 g = *(const f32x4*)(gain + col), sh = *(const f32x4*)(msh + col), sc = *(const f32x4*)(msc + col);
        const f32x4 y = v[q][i] * rstd * g * (sc + 1.0f) + sh;
        *(u32x2*)(XN + (size_t)row * 1024 + col) = (u32x2){pk_bf16(y[0], y[1]), pk_bf16(y[2], y[3])};
      }
    }
  }
}
DEV void ph_final(const P& p) {
  const int lane = get_tid() & 63, wid = get_tid() >> 6;
  for (int item = vbid(); item < MLAT / 8; item += vgrid()) {
    const int row0 = item * 8 + wid * 2;
    f32x4 v[2][4]; float ss[2];
#pragma unroll
    for (int q = 0; q < 2; ++q)
#pragma unroll
      for (int i = 0; i < 4; ++i) { const u32x2 w = ((const u32x2*)((const bf16_t*)(p.ws + OFF_XN) + (size_t)(row0 + q) * 1024))[lane + 64 * i]; v[q][i] = (f32x4){bflo(w.x), bfhi(w.x), bflo(w.y), bfhi(w.y)}; }
#pragma unroll
    for (int q = 0; q < 2; ++q) {
      float s = 0.f;
#pragma unroll
      for (int i = 0; i < 4; ++i) s += v[q][i][0] * v[q][i][0] + v[q][i][1] * v[q][i][1] + v[q][i][2] * v[q][i][2] + v[q][i][3] * v[q][i][3];
      ss[q] = wave_sum(s);
    }
#pragma unroll
    for (int q = 0; q < 2; ++q) {
      const float rstd = rsqrtf(ss[q] * (1.0f / 1024.0f) + EPSN);
#pragma unroll
      for (int i = 0; i < 4; ++i) { const int col = (lane + 64 * i) * 4; const f32x4 g = *(const f32x4*)(p.norm_final + col); ((f32x4*)(p.out + (size_t)(row0 + q) * 1024))[lane + 64 * i] = v[q][i] * rstd * g; }
    }
  }
}

DEV void ph_prep(const P& p, int l, char* smem) {
  for (int r_ = 0, nr_ = rounds_of(N_CVT); r_ < nr_; ++r_) { int it = vbid() + r_ * vgrid(); it = it < N_CVT ? it : N_CVT - 1; cvt_item(p, l, it, smem); }
  for (int r_ = 0, nr_ = rounds_of(512); r_ < nr_; ++r_) { int it = vbid() + r_ * vgrid(); it = it < 512 ? it : 511; ktab_item(p, l, it, smem); }
  for (int it = vbid(); it < 512; it += vgrid()) ef_item(p, l, it);
  { float* ssq = (float*)(p.ws + OFF_SSQ); const int step = vgrid() * 256; int i = vbid() * 256 + get_tid();
#pragma unroll
    for (int e = 0; e < 4; ++e) { if (i < MALL * 2) ssq[i] = 0.f; i += step; } }
  const float* modl = (const float*)(p.ws + OFF_MOD) + (size_t)l * 9 * 6144;
  if (l == 0) norm_rows(p, p.x, p.ctx, nullptr, MALL, p.norm_mix, modl, 0, 1);
  else norm_rows(p, nullptr, nullptr, (const bf16_t*)(p.ws + OFF_XN), MALL, p.norm_mix + 1024, modl, 0, 1);
}

DEV void ph_in(const P& p, int l, char* smem) {
  for (int it = vbid(); it < 4096; it += vgrid()) mt_item(p, l, it);
}

DEV void rms_rows(const bf16_t* zb, int row0, int rmax, float* srstd) {
  const int tid = get_tid(), r = tid >> 1, half = tid & 1;
  int row = row0 + r; row = row < rmax ? row : rmax - 1;
  const u32x4* q = (const u32x4*)(zb + (size_t)row * LDZ + half * 128);
  float ss = 0.f;
#pragma unroll 4
  for (int i = 0; i < 16; ++i) {
    const u32x4 w = q[i];
    ss += bflo(w.x) * bflo(w.x) + bfhi(w.x) * bfhi(w.x) + bflo(w.y) * bflo(w.y) + bfhi(w.y) * bfhi(w.y) + bflo(w.z) * bflo(w.z) + bfhi(w.z) * bfhi(w.z) + bflo(w.w) * bflo(w.w) + bfhi(w.w) * bfhi(w.w);
  }
  ss += __shfl_xor(ss, 1);
  if (!half) srstd[r] = rsqrtf(ss * (1.0f / 256.0f) + EPSN);
  __syncthreads();
}

DEV void ph_mid(const P& p, int l, bool need, char* smem) {
  const int tid = get_tid(), lane = tid & 63, wid = tid >> 6, wm = wid >> 1, wn = wid & 1, l15 = lane & 15, lq = lane >> 4;
  bf16_t* Z = (bf16_t*)(p.ws + OFF_Z);
  bf16_t* Qb = (bf16_t*)(p.ws + OFF_Q); bf16_t* Kb = (bf16_t*)(p.ws + OFF_K); bf16_t* Vt = (bf16_t*)(p.ws + OFF_VT);
  float* srstd = (float*)(smem + 65536) + (vboff() >> 2);
  const float2* rope = (const float2*)(p.ws + OFF_ROPE);
  for (int it = vbid(); it < MALL / 16; it += vgrid()) {
    const int row = it * 16 + (tid >> 4), e = tid & 15, a = e >> 3, f = e & 7;
    const bf16_t* zp = Z + (size_t)row * LDZ + ZPE + a * 16 + f;
    float x0 = __uint_as_float((unsigned)zp[0] << 16), x1 = __uint_as_float((unsigned)zp[8] << 16);
    int b, key;
    if (row < MLAT) {
      b = row >> 12; const int n = row & 4095; key = 256 + n;
      const float2 cs = rope[(a ? (n & 63) : (n >> 6)) * 8 + f];
      const float t0 = x0 * cs.x - x1 * cs.y, t1 = x1 * cs.x + x0 * cs.y; x0 = t0; x1 = t1;
    } else { const int cr = row - MLAT; b = cr >> 8; key = cr & 255; }
    const unsigned w = pk_bf16(x0, x1);
#pragma unroll
    for (int h = 0; h < 8; ++h) *(unsigned*)(Kb + ((size_t)(b * 8 + h) * NKEY + key) * 96 + 64 + a * 16 + f * 2) = w;
  }
}

DEV void ph_carry(const P& p, int l, bool need) {
  const int tid = get_tid();
  bf16_t* Z = (bf16_t*)(p.ws + OFF_Z);
  for (int it = vbid(); it < 128; it += vgrid()) {
    const int idx = it * 256 + tid, pp = idx & 63, dir = (idx >> 6) & 1, g = (idx >> 7) & 31, b = idx >> 12;
    const Disc d = s5_disc(p, l, dir, g, pp);
    const float2 at = cpow(d, 32);
    unsigned* S = (unsigned*)(p.ws + OFF_S) + (g * 256 + dir * 128 + pp * 2) / 2;
    float sr = 0.f, si = 0.f;
    for (int blk = 0; blk < 17; ++blk) {
      unsigned v[8]; int rows[8];
#pragma unroll
      for (int e = 0; e < 8; ++e) {
        int r;
        if (blk == 0) r = 1024 + b * 8 + (dir ? 7 - e : e);
        else { const int j = (blk - 1) * 8 + e; r = b * 128 + (dir ? 127 - j : j); }
        rows[e] = r; v[e] = S[(size_t)r * 4096];
      }
#pragma unroll
      for (int e = 0; e < 8; ++e) {
        S[(size_t)rows[e] * 4096] = pk_bf16(sr, si);
        const float nr = at.x * sr - at.y * si + bflo(v[e]), ni = at.x * si + at.y * sr + bfhi(v[e]);
        sr = nr; si = ni;
      }
    }
  }
  {
    const int Mc = need ? MALL : MLAT;
    const int ch = (tid & 63) * 8, rsub = tid >> 6;
    const float* cw = p.conv_w + (size_t)l * 3 * 512 + ch;
    float w0[8], w1[8], w2[8];
#pragma unroll
    for (int e = 0; e < 8; ++e) { w0[e] = cw[e]; w1[e] = cw[512 + e]; w2[e] = cw[1024 + e]; }
    for (int it = vbid(); it < Mc / 32; it += vgrid()) {
      const int rbase = it * 32 + rsub * 8;
      float up[8], uc[8], un[8];
      auto loadu = [&](int row, bool valid, float (&u)[8]) {
        if (valid) {
          const u32x4 c = *(const u32x4*)(Z + (size_t)row * LDZ + ZCC + ch), x = *(const u32x4*)(Z + (size_t)row * LDZ + ZCX + ch);
          u[0] = bflo(c.x) * bflo(x.x); u[1] = bfhi(c.x) * bfhi(x.x); u[2] = bflo(c.y) * bflo(x.y); u[3] = bfhi(c.y) * bfhi(x.y);
          u[4] = bflo(c.z) * bflo(x.z); u[5] = bfhi(c.z) * bfhi(x.z); u[6] = bflo(c.w) * bflo(x.w); u[7] = bfhi(c.w) * bfhi(x.w);
        } else {
#pragma unroll
          for (int e = 0; e < 8; ++e) u[e] = 0.f;
        }
      };
      auto tpos = [&](int row, int& t, int& len) { if (row < MLAT) { t = row & 4095; len = 4096; } else { t = (row - MLAT) & 255; len = 256; } };
      int t0, len0; tpos(rbase, t0, len0);
      loadu(rbase - 1, t0 > 0, up); loadu(rbase, true, uc);
#pragma unroll
      for (int rr = 0; rr < 8; ++rr) {
        const int row = rbase + rr; int t, len; tpos(row, t, len);
        loadu(row + 1, t < len - 1, un);
        const u32x4 zb = *(const u32x4*)(Z + (size_t)row * LDZ + ZCB + ch);
        float y[8];
#pragma unroll
        for (int e = 0; e < 8; ++e) y[e] = w0[e] * up[e] + w1[e] * uc[e] + w2[e] * un[e];
        u32x4 o;
        o.x = pk_bf16(bflo(zb.x) * y[0], bfhi(zb.x) * y[1]); o.y = pk_bf16(bflo(zb.y) * y[2], bfhi(zb.y) * y[3]);
        o.z = pk_bf16(bflo(zb.z) * y[4], bfhi(zb.z) * y[5]); o.w = pk_bf16(bflo(zb.w) * y[6], bfhi(zb.w) * y[7]);
        *(u32x4*)(Z + (size_t)row * LDZ + ZCV + ch) = o;
#pragma unroll
        for (int e = 0; e < 8; ++e) { up[e] = uc[e]; uc[e] = un[e]; }
      }
    }
  }
}

DEV float max3a(float a, float b, float c) { float r; asm("v_max3_f32 %0, %1, %2, %3" : "=v"(r) : "v"(a), "v"(b), "v"(c)); return r; }
DEV void attn_item(const P& p, int bh, int qrow0, int nkt, int outrow0, char* smem) {
  int tid; asm volatile("v_mov_b32 %0, %1" : "=v"(tid) : "v"((int)threadIdx.x));
  const int lane = tid & 63, wid = __builtin_amdgcn_readfirstlane(tid >> 6), l15 = lane & 15, lq = lane >> 4;
  const bf16_t* Qb = (const bf16_t*)(p.ws + OFF_Q) + (size_t)bh * NKEY * 96;
  const bf16_t* Kb = (const bf16_t*)(p.ws + OFF_K) + (size_t)bh * NKEY * 96;
  const bf16_t* Vt = (const bf16_t*)(p.ws + OFF_VT) + (size_t)bh * 64 * NKEY;
  bf16_t* Z = (bf16_t*)(p.ws + OFF_Z);
  constexpr int KB = 16384, VB = 8192, VBASE = 6 * KB;
  int vo = 0; asm volatile("" : "+v"(vo));
  bf16x8 qf[2][3];
#pragma unroll
  for (int qt = 0; qt < 2; ++qt)
#pragma unroll
    for (int ks = 0; ks < 3; ++ks) qf[qt][ks] = *(const bf16x8*)(Qb + (size_t)(qrow0 + wid * 32 + qt * 16 + l15) * 96 + ks * 32 + lq * 8);
  f32x4 o[4][2];
#pragma unroll
  for (int vt = 0; vt < 4; ++vt)
#pragma unroll
    for (int qt = 0; qt < 2; ++qt) o[vt][qt] = (f32x4){0.f, 0.f, 0.f, 0.f};
  float mused[2] = {0.f, 0.f};
  f32x4 osum[2] = {(f32x4){0.f, 0.f, 0.f, 0.f}, (f32x4){0.f, 0.f, 0.f, 0.f}};
  const bf16x8 ones = __builtin_bit_cast(bf16x8, (u32x4){0x3f803f80u, 0x3f803f80u, 0x3f803f80u, 0x3f803f80u});
  u32x4 kr[4], vr[2];
  const int krow = tid >> 4, kc = tid & 15;
  const int vrow = tid >> 3, vc = tid & 7;
  const int kwo = vo + krow * 256 + ((kc ^ (krow & 15)) << 4), vwo = vo + VBASE + vrow * 128 + ((vc ^ ((vrow >> 1) & 7)) << 4);
  const int kro = vo + l15 * 256, vro = vo + VBASE + l15 * 128;
  f32x4 st[4][2];
  bf16x8 pf[2][2], vf[2][4];
#define ALOAD(kt) { const int key0_ = (kt) * 128; \
    if (kc < 12) { _Pragma("unroll") for (int i = 0; i < 4; ++i) kr[i] = *(const u32x4*)(Kb + (size_t)(key0_ + krow + 32 * i) * 96 + kc * 8); } \
    _Pragma("unroll") for (int i = 0; i < 2; ++i) vr[i] = *(const u32x4*)(Vt + (size_t)vrow * NKEY + key0_ + i * 64 + vc * 8); }
#define ASTORE(slot) { char* sk_ = smem + (slot) * KB; char* sv_ = smem + (slot) * VB; \
    if (kc < 12) { _Pragma("unroll") for (int i = 0; i < 4; ++i) *(u32x4*)(sk_ + kwo + i * 8192) = kr[i]; } \
    _Pragma("unroll") for (int i = 0; i < 2; ++i) *(u32x4*)(sv_ + vwo + i * VB) = vr[i]; }
#define LDK(dst, s_, ks_) { _Pragma("unroll") for (int kk = 0; kk < 4; ++kk) dst[kk] = *(const bf16x8*)((s_) + kk * 4096 + kro + ((((ks_) * 4 + lq) ^ l15) << 4)); }
#define MMK(src_, ks_) { _Pragma("unroll") for (int kk = 0; kk < 4; ++kk) _Pragma("unroll") for (int qt = 0; qt < 2; ++qt) st[kk][qt] = __builtin_amdgcn_mfma_f32_16x16x32_bf16(src_[kk], qf[qt][ks_], st[kk][qt], 0, 0, 0); }
#define QK(slot) { const char* s = smem + (slot) * KB; bf16x8 kfa[4], kfb[4]; \
    LDK(kfa, s, 0); LDK(kfb, s, 1); \
    _Pragma("unroll") for (int kk = 0; kk < 4; ++kk) _Pragma("unroll") for (int qt = 0; qt < 2; ++qt) { const float nm = -mused[qt]; st[kk][qt] = (f32x4){nm, nm, nm, nm}; } \
    __builtin_amdgcn_s_setprio(1); MMK(kfa, 0); LDK(kfa, s, 2); MMK(kfb, 1); MMK(kfa, 2); __builtin_amdgcn_s_setprio(0); }
#define SM(first) { _Pragma("unroll") for (int qt = 0; qt < 2; ++qt) { \
      float mx = max3a(st[0][qt][0], st[0][qt][1], st[0][qt][2]); \
      mx = max3a(mx, st[0][qt][3], st[1][qt][0]); mx = max3a(mx, st[1][qt][1], st[1][qt][2]); mx = max3a(mx, st[1][qt][3], st[2][qt][0]); \
      mx = max3a(mx, st[2][qt][1], st[2][qt][2]); mx = max3a(mx, st[2][qt][3], st[3][qt][0]); mx = max3a(mx, st[3][qt][1], st[3][qt][2]); mx = max3a(mx, st[3][qt][3], st[3][qt][3]); \
      if ((first) || __builtin_amdgcn_ballot_w64(mx > 8.0f) != 0) {     \
        mx = fmaxf(mx, __shfl_xor(mx, 16)); mx = fmaxf(mx, __shfl_xor(mx, 32)); \
        const float sc = __builtin_amdgcn_exp2f(-mx); \
        mused[qt] += mx; \
        _Pragma("unroll") for (int vt = 0; vt < 4; ++vt) o[vt][qt] = o[vt][qt] * sc; \
        osum[qt] = osum[qt] * sc; \
        _Pragma("unroll") for (int kk = 0; kk < 4; ++kk) _Pragma("unroll") for (int r = 0; r < 4; ++r) st[kk][qt][r] = __builtin_amdgcn_exp2f(st[kk][qt][r] - mx); \
      } else { \
        _Pragma("unroll") for (int kk = 0; kk < 4; ++kk) _Pragma("unroll") for (int r = 0; r < 4; ++r) st[kk][qt][r] = __builtin_amdgcn_exp2f(st[kk][qt][r]); \
      } \
      _Pragma("unroll") for (int k2 = 0; k2 < 2; ++k2) { \
        u32x4 w; \
        w.x = pk_bf16(st[2 * k2][qt][0], st[2 * k2][qt][1]); w.y = pk_bf16(st[2 * k2][qt][2], st[2 * k2][qt][3]); \
        w.z = pk_bf16(st[2 * k2 + 1][qt][0], st[2 * k2 + 1][qt][1]); w.w = pk_bf16(st[2 * k2 + 1][qt][2], st[2 * k2 + 1][qt][3]); \
        pf[qt][k2] = __builtin_bit_cast(bf16x8, w); } } }
#define PVLOAD(slot) { const char* s = smem + (slot) * VB; \
    _Pragma("unroll") for (int vt = 0; vt < 4; ++vt) vf[0][vt] = *(const bf16x8*)(s + vt * 2048 + vro + (((0 * 4 + lq) ^ (l15 >> 1)) << 4)); }
#define PVMMA(slot) { const char* s = smem + (slot) * VB; \
    _Pragma("unroll") for (int vt = 0; vt < 4; ++vt) vf[1][vt] = *(const bf16x8*)(s + vt * 2048 + vro + (((1 * 4 + lq) ^ (l15 >> 1)) << 4)); \
    __builtin_amdgcn_s_setprio(1); \
    _Pragma("unroll") for (int k2 = 0; k2 < 2; ++k2) _Pragma("unroll") for (int vt = 0; vt < 4; ++vt) \
      _Pragma("unroll") for (int qt = 0; qt < 2; ++qt) o[vt][qt] = __builtin_amdgcn_mfma_f32_16x16x32_bf16(vf[k2][vt], pf[qt][k2], o[vt][qt], 0, 0, 0); \
    _Pragma("unroll") for (int k2 = 0; k2 < 2; ++k2) _Pragma("unroll") for (int qt = 0; qt < 2; ++qt) osum[qt] = __builtin_amdgcn_mfma_f32_16x16x32_bf16(ones, pf[qt][k2], osum[qt], 0, 0, 0); \
    __builtin_amdgcn_s_setprio(0); }
  const bool skew = vbsel() != 0;
  asm volatile("" : "+s"(nkt));
#define ABAR() { asm volatile("s_waitcnt lgkmcnt(0)" ::: "memory"); __builtin_amdgcn_s_barrier(); asm volatile("" ::: "memory"); }
  const int npair = nkt >> 1;
  ALOAD(0); ASTORE(0); if (npair > 1) ALOAD(1); ABAR();
  int s0 = 0;
#pragma nounroll
  for (int kp = 0; kp < npair; ++kp) {
    const int sn = (s0 == 4) ? 0 : s0 + 2;
    if (kp + 1 < npair) ASTORE(sn);
    if (kp + 2 < npair) ALOAD(kp + 2);
    if (!skew) {
      QK(s0); PVLOAD(s0); __builtin_amdgcn_sched_barrier(0); SM(kp == 0); PVMMA(s0);
      QK(s0 + 1); PVLOAD(s0 + 1); __builtin_amdgcn_sched_barrier(0); SM(false); PVMMA(s0 + 1);
    } else {
      if (kp > 0) { const int sp = (s0 == 0) ? 5 : s0 - 1; PVLOAD(sp); __builtin_amdgcn_sched_barrier(0); SM(false); PVMMA(sp); }
      QK(s0);
      PVLOAD(s0); __builtin_amdgcn_sched_barrier(0); SM(kp == 0); PVMMA(s0);
      QK(s0 + 1);
    }
    ABAR();
    s0 = sn;
  }
  if (skew) { const int sp = (s0 == 0) ? 5 : s0 - 1; PVLOAD(sp); SM(false); PVMMA(sp); }
  ABAR();
#undef ABAR
#undef ALOAD
#undef ASTORE
#undef QK
#undef SM
#undef PVLOAD
#undef PVMMA
#undef LDK
#undef MMK
  const int h = bh & 7;
#pragma unroll
  for (int qt = 0; qt < 2; ++qt) {
    const float inv = 1.0f / osum[qt][0];
    const int row = outrow0 + wid * 32 + qt * 16 + l15;
#pragma unroll
    for (int vt = 0; vt < 4; ++vt) {
      const f32x4 v = o[vt][qt] * inv;
      *(u32x2*)(Z + (size_t)row * LDZ + ZAO + h * 64 + vt * 16 + lq * 4) = (u32x2){pk_bf16(v[0], v[1]), pk_bf16(v[2], v[3])};
    }
  }
}

DEV float gelu_t(float x) { const float z = 0.7978845608028654f * (x + 0.044715f * x * x * x); const float e = __builtin_amdgcn_exp2f(z * 2.8853900817779268f); return x * (1.0f - __builtin_amdgcn_rcpf(1.0f + e)); }

DEV void ph_attn(const P& p, int l, bool need, char* smem) {
  const int tid = get_tid(), lane = tid & 63, wid = tid >> 6, wm = wid >> 1, wn = wid & 1, l15 = lane & 15, lq = lane >> 4;
  bf16_t* Z = (bf16_t*)(p.ws + OFF_Z);
  {
    const bf16_t* Mt = (const bf16_t*)(p.ws + OFF_MT); const bf16_t* Et = (const bf16_t*)(p.ws + OFF_ET); const bf16_t* S = (const bf16_t*)(p.ws + OFF_S);
    const int nmt = need ? 9 : 8, rmax = need ? NCH : 1024;
    for (int r_ = 0, nr_ = rounds_of(32 * nmt * 4); r_ < nr_; ++r_) { int t = vbid() + r_ * vgrid(); t = t < (32 * nmt * 4) ? t : (32 * nmt * 4) - 1;
      const int g = t / (nmt * 4), mt = (t % (nmt * 4)) >> 2, nt = t & 3;
      f32x4 acc[4][4]; zero_acc<4>(acc);
      ASrc a; a.p = Z + ZS5 + g * 16; a.lda = 32 * LDZ; a.row0 = mt * 128; a.rmax = rmax; a.segshift = 4; a.segstride = LDZ;
      gemm_core<4, true>(acc, a, Mt + ((size_t)g * 512 + nt * 128) * 512, 512, 512, smem);
      gemm_core<4, true>(acc, asrc(S + g * 256, 8192, mt * 128, rmax), Et + ((size_t)g * 512 + nt * 128) * 256, 256, 256, smem);
#pragma unroll
      for (int i = 0; i < 4; ++i) {
        const int crow = mt * 128 + wm * 64 + i * 16 + l15;
        if (crow < rmax) {
#pragma unroll
          for (int j = 0; j < 4; ++j) {
            const int n = nt * 128 + wn * 64 + j * 16 + lq * 4, tt = n >> 4, c = n & 15;
            *(u32x2*)(Z + (size_t)(crow * 32 + tt) * LDZ + ZS5A + g * 16 + c) =
                (u32x2){pk_bf16(gelu_t(acc[i][j][0]), gelu_t(acc[i][j][1])), pk_bf16(gelu_t(acc[i][j][2]), gelu_t(acc[i][j][3]))};
          }
        }
      }
    }
  }
  for (int it = blockIdx.x; it < 1024; it += gridDim.x) {
    const int r = it >> 8, w = it & 255, xcd = w & 7, slot = w >> 3;
    const int bh = r * 16 + xcd * 2 + (slot >> 4), qb = slot & 15;
    attn_item(p, bh, qb * 256, 68, (bh >> 3) * 4096 + qb * 256, smem);
  }
  if (need) for (int it = blockIdx.x; it < 64; it += gridDim.x) attn_item(p, it, 4096, 4, MLAT + (it >> 3) * 256, smem);
}

DEV int n_jobs(int ph) { return ph == 2 ? 1 : ph == 3 ? 3 : ph == 6 ? 7 : (ph == 7 || ph == 9 || ph == 10) ? 1 : 0; }
DEV pg8::Job get_job(KP kp, int ph, int l, int j) {
  const P p = ldp(kp);
  const bool need = (l == 0); const int M = need ? MALL : MLAT;
  char* ws = p.ws;
  const bf16_t* Z = (const bf16_t*)(ws + OFF_Z); const bf16_t* XN = (const bf16_t*)p.out;
  const bf16_t* Wg = (const bf16_t*)(ws + OFF_WIN) + (size_t)LDZ * 1024;
  bf16_t* T = (bf16_t*)(ws + OFF_T); bf16_t* MG = (bf16_t*)(ws + OFF_MG);
  pg8::Job b; b.lda = 1024; b.M = M; b.N = 1024; b.K = 1024; b.mode = 0; b.O = T; b.ldc = 1024; b.T = T; b.slat = nullptr; b.sctx = nullptr; b.xb = (bf16_t*)(ws + OFF_XN);
  b.modg = (const float*)(ws + OFF_MOD) + (size_t)l * 9 * 6144; b.A = XN; b.Bt = Wg;
  b.segstride = 0; b.pnstrideA = 0; b.rows = M; b.ssq = nullptr; b.O2 = nullptr;
  if (ph == 2) { b.M = MALL; b.rows = MALL; b.N = LDZ; b.Bt = (const bf16_t*)(ws + OFF_WIN); b.O = (bf16_t*)(ws + OFF_Z); b.ldc = LDZ; b.ssq = (float*)(ws + OFF_SSQ); }
  else if (ph == 3) {
    b.ssq = (float*)(ws + OFF_SSQ); b.K = 256; b.lda = LDZ; b.modg = (const float*)(ws + OFF_ROPE);
    if (j == 0) { b.A = Z + ZQ; b.Bt = (const bf16_t*)(ws + OFF_WUQ); b.N = 768; b.mode = 6; b.O = (bf16_t*)(ws + OFF_Q); }
    else if (j == 1) { b.A = Z + ZKV; b.Bt = (const bf16_t*)(ws + OFF_WUKV); b.M = MALL; b.rows = MALL; b.N = 1024; b.mode = 7; b.O = (bf16_t*)(ws + OFF_K); b.O2 = (bf16_t*)(ws + OFF_VT); }
    else { b.ssq = nullptr; b.A = Z + ZS5; b.lda = 32 * LDZ; b.segstride = LDZ; b.pnstrideA = 16; b.Bt = (const bf16_t*)(ws + OFF_FT); b.M = 1280; b.rows = NCH; b.N = 8192; b.K = 512; b.mode = 0; b.O = (bf16_t*)(ws + OFF_S); b.ldc = 8192; }
  }
  else if (ph == 6) {
    if (j == 0) { b.A = Z + ZAO; b.lda = LDZ; b.Bt = (const bf16_t*)(ws + OFF_WO); b.K = 512; }
    else if (j == 1) { b.mode = 2; b.O = MG; }
    else if (j == 2) { b.A = Z + ZCV; b.lda = LDZ; b.Bt = (const bf16_t*)(ws + OFF_WC); b.K = 512; }
    else if (j == 3) { b.mode = 3; b.O = MG; b.Bt = Wg + (size_t)1024 * 1024; }
    else if (j == 4) { b.A = Z + ZS5A; b.lda = LDZ; b.Bt = (const bf16_t*)(ws + OFF_WGLU); b.K = 512; }
    else if (j == 5) { b.A = Z + ZS5A; b.lda = LDZ; b.Bt = (const bf16_t*)(ws + OFF_WGLU) + (size_t)1024 * 512; b.K = 512; b.mode = 1; }
    else { b.mode = 3; b.O = MG; b.Bt = Wg + (size_t)2048 * 1024; }
  } else if (ph == 7) {
    b.A = MG; b.Bt = (const bf16_t*)(ws + OFF_WOUT); b.mode = 5; b.modg += 2 * 1024;
    if (l == 0) { b.slat = p.x; b.sctx = p.ctx; }
  } else if (ph == 9) { b.Bt = (const bf16_t*)(ws + OFF_W1); b.N = 4096; b.mode = 4; b.O = (bf16_t*)(ws + OFF_Z); b.ldc = 4096; }
  else { b.A = Z; b.lda = 4096; b.K = 4096; b.Bt = (const bf16_t*)(ws + OFF_W2); b.mode = 5; b.modg += 5 * 1024; }
  return b;
}

#define LAS __attribute__((address_space(3)))
#define XB_TMO      128
#define XB_XCNT(j)  (256  + 64 * (j))
#define XB_XSUB(j)  (1280 + 64 * (j))
#define XB_XGEN(j)  (2304 + 64 * (j))
#define XB_TOP      3328
#define XB_TOPGEN   3392
#define XCD_BAR_WORDS 3456
#define XB_SPIN_CAP (1u << 18)

__device__ __forceinline__ unsigned xb_ld(unsigned* p)              { return __hip_atomic_load(p, __ATOMIC_RELAXED, __HIP_MEMORY_SCOPE_AGENT); }
__device__ __forceinline__ unsigned xb_add(unsigned* p, unsigned v) { return __hip_atomic_fetch_add(p, v, __ATOMIC_RELAXED, __HIP_MEMORY_SCOPE_AGENT); }
__device__ __forceinline__ unsigned xb_xcc_id() { return (unsigned)__builtin_amdgcn_s_getreg((3 << 11) | 20) & 0xFu; }
#define XB_SPIN(cond, bar) do { unsigned _sp = 0; while (cond) { __builtin_amdgcn_s_sleep(1); \
    if ((++_sp & 255u) == 0u) { if (xb_ld(&(bar)[XB_TMO])) break; if (_sp > XB_SPIN_CAP) { atomicAdd(&(bar)[XB_TMO], 1u); break; } } } } while (0)

struct XcdBarrier {
    unsigned* bar; unsigned x;
    volatile LAS unsigned* st;
};

__device__ __forceinline__ XcdBarrier xcd_barrier_post(unsigned* bar, volatile LAS unsigned* st) {
    XcdBarrier b; b.bar = bar; b.x = xb_xcc_id(); b.st = st;
    if (threadIdx.x == 0) (void)xb_add(&bar[XB_XCNT(b.x)], 1u);
    return b;
}
__device__ __forceinline__ void xcd_barrier_complete(unsigned* bar, unsigned x, unsigned& nloc, unsigned& nx) {
    const unsigned G = gridDim.x * gridDim.y * gridDim.z;
    unsigned sum, cnt, mine, sp = 0u;
    for (;;) {
        sum = 0u; cnt = 0u; mine = 0u;
#pragma unroll
        for (unsigned j = 0; j < 16; ++j) { const unsigned c = xb_ld(&bar[XB_XCNT(j)]); sum += c; cnt += (c > 0u) ? 1u : 0u; mine = (j == x) ? c : mine; }
        if (sum == G) break;
        __builtin_amdgcn_s_sleep(1);
        if ((++sp & 255u) == 0u) { if (xb_ld(&bar[XB_TMO])) break; if (sp > XB_SPIN_CAP) { atomicAdd(&bar[XB_TMO], 1u); break; } }
    }
    nloc = mine > 0u ? mine : 1u; nx = cnt > 0u ? cnt : 1u;
}

__device__ __forceinline__ void xcd_barrier(const XcdBarrier& b) {
    asm volatile("s_waitcnt vmcnt(0)" ::: "memory");
    __syncthreads();
    if (threadIdx.x == 0) {
        unsigned* bar = b.bar;
        __builtin_amdgcn_s_waitcnt(0);
        unsigned nloc = b.st[0], nx = b.st[1];
        if (nloc == 0u) { xcd_barrier_complete(bar, b.x, nloc, nx); b.st[0] = nloc; b.st[1] = nx; }
        const unsigned old = xb_add(&bar[XB_XSUB(b.x)], 1u);
        const unsigned gen = old / nloc;
        if (old + 1u == (gen + 1u) * nloc) {
            __builtin_amdgcn_fence(__ATOMIC_RELEASE, "agent");
            asm volatile("s_waitcnt vmcnt(0)" ::: "memory");
            const unsigned og = xb_add(&bar[XB_TOP], 1u);
            const unsigned tg = og / nx;
            if (og + 1u == (tg + 1u) * nx) xb_add(&bar[XB_TOPGEN], 1u);
            else XB_SPIN(xb_ld(&bar[XB_TOPGEN]) == tg, bar);
            __builtin_amdgcn_fence(__ATOMIC_ACQUIRE, "agent");
            xb_add(&bar[XB_XGEN(b.x)], 1u);
            asm volatile("s_waitcnt vmcnt(0)" ::: "memory");
        } else {
            XB_SPIN(xb_ld(&bar[XB_XGEN(b.x)]) == gen, bar);
            __builtin_amdgcn_fence(__ATOMIC_ACQUIRE, "agent");
            asm volatile("s_waitcnt vmcnt(0)" ::: "memory");
        }
    }
    __syncthreads();
}

DEV void run_phase(KP kp, int ph, int l, char* smem) {
  const bool need = (l == 0);
  switch (ph) {
    case 0: { const P p = ldp(kp); ph_ada(p, smem); } break;
    case 1: { const P p = ldp(kp); ph_prep(p, l, smem); } break;
    case 2: { const P p = ldp(kp); ph_in(p, l, smem); } break;
    case 3: { const P p = ldp(kp); ph_mid(p, l, need, smem); } break;
    case 4: { const P p = ldp(kp); ph_carry(p, l, need); } break;
    case 5: { const P p = ldp(kp); ph_attn(p, l, need, smem); } break;
    case 8: { const P p = ldp(kp); norm_rows(p, nullptr, nullptr, (const bf16_t*)(p.ws + OFF_XN), need ? MALL : MLAT, p.norm_mlp + l * 1024, (const float*)(p.ws + OFF_MOD) + (size_t)l * 9 * 6144, 3, 4); } break;
    case 11: { const P p = ldp(kp); ph_final(p); } break;
    default: break;
  }
}

__global__ void __launch_bounds__(512) mega(P p_unused) {
  __shared__ __attribute__((aligned(16))) char smem_all[163840];
  char* smem = smem_all;
  KP kp = (KP)__builtin_amdgcn_kernarg_segment_ptr();
  cg::grid_group grid = cg::this_grid();
  unsigned* xb_st = (unsigned*)(smem_all + 163824);
  if (threadIdx.x == 0) { xb_st[0] = 0u; xb_st[1] = 0u; }
  __syncthreads();
  unsigned* barw; { const P p0 = ldp(kp); barw = (unsigned*)(p0.ws + OFF_BAR); }
  const XcdBarrier XB = xcd_barrier_post(barw, (volatile LAS unsigned*)xb_st);
  run_phase(kp, 0, 0, smem);
  grid.sync();
  for (int l = 0; l < 2; ++l)
    for (int ph = 1; ph <= 10; ++ph) {
      for (int rep_ = 0; rep_ < 1 + DUPN(ph); ++rep_) {
        const int nj = n_jobs(ph);
        if (nj == 0 || ph == 2 || ph == 3) run_phase(kp, ph, l, smem);
        for (int j = 0; j < nj; ++j) { const pg8::Job jb = get_job(kp, ph, l, j); run_job(smem, jb); }
        xcd_barrier(XB);
      }
    }
  run_phase(kp, 11, 0, smem);
}

extern "C" void kernel_launch(void* const* d_in, const int* in_sizes, int n_in, void* d_out, int out_size, void* d_ws, size_t ws_size, hipStream_t stream) {
  static int grid_blocks = 0;
  if (!grid_blocks) {
    int dev = 0, cus = 0, per_cu = 0;
    hipGetDevice(&dev);
    hipDeviceGetAttribute(&cus, hipDeviceAttributeMultiprocessorCount, dev);
    hipOccupancyMaxActiveBlocksPerMultiprocessor(&per_cu, mega, 512, 0);
    if (per_cu > 1) per_cu = 1;
    grid_blocks = cus * per_cu;
  }
  if (ws_size < WS_TOTAL) fprintf(stderr, "workspace too small: %zu < %zu\n", ws_size, (size_t)WS_TOTAL);
  (void)hipMemsetAsync((char*)d_ws + OFF_BAR, 0, BAR_BYTES, stream);
  P p{};
  const float** f = (const float**)&p;
  for (int i = 0; i < 29; ++i) f[i] = (const float*)d_in[i];
  p.out = (float*)d_out; p.ws = (char*)d_ws;
  void* args[] = {&p};
  hipError_t e = hipLaunchCooperativeKernel((void*)mega, dim3(grid_blocks), dim3(512), args, 0, stream);
  if (e != hipSuccess) fprintf(stderr, "cooperative launch failed: %s (grid %d)\n", hipGetErrorString(e), grid_blocks);
}
```
